# Optimizing an MI355X kernel written in HIP

```python
import math
import jax, jax.numpy as jnp
from jax import lax
import numpy as np

D_MODEL = 1024
BATCH = 32
SEQ = 2048
DEPTH = 2

GRID_W = 64
CTX_LEN = 256

GM_DIM = 256
GM_GROUPS = 4
GM_CHUNK = 128
HY_DIM = 256
HY_EMB = 33
HY_BANDS = (HY_EMB - 1) // 2
HY_FFN = 64
HY_DECAY_FAST = 0.3
HY_DECAY_SLOW = 1.5
HY_DECAY_TARGET = 1e-2
HY_DECAY_SHIFT = 0.05
DA_HEADS = 4
DA_HEAD_DIM = 64
DA_V_DIM = 2 * DA_HEAD_DIM
DA_Q_BLOCK = 128
DA_QK_W = DA_HEADS * 2 * DA_HEAD_DIM
DA_V_W = DA_HEADS * DA_V_DIM
ROPE_BASE = 10000.0
N_BRANCH = 3
OFF_GM = 0
OFF_HY = OFF_GM + 2 * GM_DIM
OFF_Q = OFF_HY + 3 * HY_DIM
OFF_K = OFF_Q + DA_QK_W
OFF_GATE = OFF_K + DA_QK_W + DA_V_W
N_IN = OFF_GATE + N_BRANCH * D_MODEL
MOE_GROUPS = 4
MOE_EXPERTS_PER_GROUP = 8
MOE_N_EXPERTS = MOE_GROUPS * MOE_EXPERTS_PER_GROUP
MOE_TOP_K = 2
MOE_HIDDEN = 512
MOE_BLOCK = 256
DEEPNORM_ALPHA = (2.0 * DEPTH) ** 0.25
DEEPNORM_BETA = (8.0 * DEPTH) ** -0.25
LN_EPS = 1e-5

kernel_name = 'hybrid_gmlp_hyena_diffattn_hmoe_block'


def layer_norm(x, g, b):
    xf = x.astype(jnp.float32)
    mu = jnp.mean(xf, axis=-1, keepdims=True)
    var = jnp.mean(jnp.square(xf - mu), axis=-1, keepdims=True)
    y = (xf - mu) * lax.rsqrt(var + LN_EPS) * g.astype(jnp.float32) + b.astype(jnp.float32)
    return y.astype(x.dtype)


def modulate(x, shift, scale):
    return x * (1 + scale) + shift


def chunk_gmlp(z, ln_g, ln_b, ws, bs):
    u, v = jnp.split(jax.nn.gelu(z), 2, axis=-1)
    v = layer_norm(v, ln_g, ln_b)
    B, L, _ = v.shape
    v = v.reshape(B, L // GM_CHUNK, GM_CHUNK, GM_GROUPS, GM_DIM // GM_GROUPS)
    v = jnp.einsum('gpq,bnqgc->bnpgc', ws, v) + jnp.transpose(bs)[:, :, None]
    return u * v.reshape(B, L, GM_DIM)


def short_conv(z, w, b):
    L = z.shape[1]
    zp = jnp.pad(z, ((0, 0), (1, 1), (0, 0)))
    return zp[:, :L] * w[0] + zp[:, 1:L + 1] * w[1] + zp[:, 2:] * w[2] + b


def hyena_filters(L, w1, b1, w2, b2, w3, b3):
    f32 = jnp.float32
    t = jnp.linspace(0.0, 1.0, L, dtype=f32)[:, None]
    w = 2.0 * math.pi * jnp.arange(L, dtype=f32)[:, None] / L
    f = jnp.linspace(1e-4, HY_BANDS - 1, HY_BANDS, dtype=f32)[None, :]
    emb = jnp.concatenate([t, jnp.cos(f * w), -jnp.sin(f * w)], axis=-1)
    h = jnp.sin(emb @ w1.astype(f32) + b1.astype(f32))
    h = jnp.sin(h @ w2.astype(f32) + b2.astype(f32))
    h = h @ w3.astype(f32) + b3.astype(f32)
    max_decay = math.log(HY_DECAY_TARGET) / HY_DECAY_FAST
    min_decay = math.log(HY_DECAY_TARGET) / HY_DECAY_SLOW
    deltas = jnp.abs(jnp.linspace(min_decay, max_decay, HY_DIM, dtype=f32))
    window = jnp.exp(-t * deltas[None, :]) + HY_DECAY_SHIFT
    h = h.reshape(L, 2, HY_DIM) * window[:, None, :]
    return h[:, 0], h[:, 1]


def bidirectional_long_conv(v, h_fwd, h_bwd):
    L = v.shape[1]
    k = jnp.concatenate([h_fwd, jnp.zeros((1, HY_DIM), jnp.float32), jnp.flip(h_bwd[1:], axis=0)], axis=0)
    kf = jnp.fft.rfft(k, axis=0)
    vf = jnp.fft.rfft(v.astype(jnp.float32), n=2 * L, axis=1)
    return jnp.fft.irfft(vf * kf[None], n=2 * L, axis=1)[:, :L]


def hyena_mixer(z, conv_w, conv_b, h_fwd, h_bwd, skip):
    zc = short_conv(z, conv_w, conv_b)
    x0, x1, v = jnp.split(zc, 3, axis=-1)
    v = v * x1
    y = bidirectional_long_conv(v, h_fwd, h_bwd) + v.astype(jnp.float32) * skip.astype(jnp.float32)
    return y.astype(z.dtype) * x0


def axial_rope(rows):
    n_freq = DA_HEAD_DIM // 4
    row = jnp.broadcast_to(jnp.arange(rows)[:, None], (rows, GRID_W)).reshape(-1).astype(jnp.float32)
    col = jnp.broadcast_to(jnp.arange(GRID_W)[None, :], (rows, GRID_W)).reshape(-1).astype(jnp.float32)
    inv = ROPE_BASE ** (-jnp.arange(n_freq, dtype=jnp.float32) / n_freq)
    ang = jnp.stack([row[:, None] * inv, col[:, None] * inv], axis=1)
    return jnp.cos(ang), jnp.sin(ang)


def apply_rope(x, cos, sin):
    n_freq = DA_HEAD_DIM // 4
    xr = x.astype(jnp.float32).reshape(x.shape[:-1] + (2, 2, n_freq))
    x1, x2 = xr[..., 0, :], xr[..., 1, :]
    c = cos[:, None, None]
    s = sin[:, None, None]
    out = jnp.stack([x1 * c - x2 * s, x2 * c + x1 * s], axis=-2)
    return out.reshape(x.shape).astype(x.dtype)


def split_q(zq):
    B, L, _ = zq.shape
    return zq.reshape(B, L, DA_HEADS, 2, DA_HEAD_DIM)


def split_kv(zkv):
    B, L, _ = zkv.shape
    k = zkv[..., :DA_QK_W].reshape(B, L, DA_HEADS, 2, DA_HEAD_DIM)
    v = zkv[..., DA_QK_W:].reshape(B, L, DA_HEADS, DA_V_DIM)
    return k, v


def diff_softmax_attend(q, k, v, lam):
    s = jnp.einsum('bqhmd,bkhmd->bhmqk', q, k, preferred_element_type=jnp.float32) * (DA_HEAD_DIM ** -0.5)
    p = jax.nn.softmax(s, axis=-1)
    a = p[:, :, 0] - lam * p[:, :, 1]
    return jnp.einsum('bhqk,bkhe->bqhe', a.astype(v.dtype), v)


def latent_diff_attention(q, k, v, lam):
    B, L = q.shape[:2]
    nb = L // DA_Q_BLOCK
    qb = jnp.moveaxis(q.reshape((B, nb, DA_Q_BLOCK) + q.shape[2:]), 1, 0)
    ob = lax.map(lambda qq: diff_softmax_attend(qq, k, v, lam), qb)
    return jnp.moveaxis(ob, 0, 1).reshape(B, L, DA_HEADS, DA_V_DIM)


def head_rms(o, g, lam_init):
    B, L = o.shape[:2]
    of = o.astype(jnp.float32)
    of = of * lax.rsqrt(jnp.mean(jnp.square(of), axis=-1, keepdims=True) + LN_EPS) * g.astype(jnp.float32)
    return (of * (1.0 - lam_init)).reshape(B, L, DA_V_W).astype(o.dtype)


def merge_branches(z, y_c, lp):
    L = z.shape[1]
    y_a = chunk_gmlp(z[..., OFF_GM:OFF_HY], lp['gm_ln_g'], lp['gm_ln_b'], lp['gm_ws'], lp['gm_bs'])
    h_fwd, h_bwd = hyena_filters(L, lp['hy_f_w1'], lp['hy_f_b1'], lp['hy_f_w2'], lp['hy_f_b2'],
                                 lp['hy_f_w3'], lp['hy_f_b3'])
    y_b = hyena_mixer(z[..., OFF_HY:OFF_Q], lp['hy_conv_w'], lp['hy_conv_b'], h_fwd, h_bwd, lp['hy_skip'])
    g_a, g_b, g_c = jnp.split(jax.nn.sigmoid(z[..., OFF_GATE:]), N_BRANCH, axis=-1)
    merged = g_a * (y_a @ lp['p_a']) + g_b * (y_b @ lp['p_b']) + g_c * (y_c @ lp['p_c'])
    return merged @ lp['w_out']


def hierarchical_moe(xt, wg, bg, we, be, w_gate, w_up, w_down):
    T, D = xt.shape
    A = T * MOE_TOP_K
    g_logits = (xt @ wg + bg).astype(jnp.float32)
    g_idx = jnp.argmax(g_logits, axis=-1)
    g_prob = jnp.take_along_axis(jax.nn.softmax(g_logits, axis=-1), g_idx[:, None], axis=-1)
    e_logits = (xt @ we + be).astype(jnp.float32).reshape(T, MOE_GROUPS, MOE_EXPERTS_PER_GROUP)
    e_logits = jnp.take_along_axis(e_logits, g_idx[:, None, None], axis=1)[:, 0]
    top_v, top_i = lax.top_k(e_logits, MOE_TOP_K)
    weights = g_prob * jax.nn.softmax(top_v, axis=-1)
    eid = (g_idx[:, None] * MOE_EXPERTS_PER_GROUP + top_i).reshape(-1).astype(jnp.int32)
    w_flat = weights.reshape(-1)
    order = jnp.argsort(eid)
    e_s = eid[order]
    tok_s = (order // MOE_TOP_K).astype(jnp.int32)
    w_s = w_flat[order]
    counts = jnp.bincount(eid, length=MOE_N_EXPERTS)
    starts = jnp.cumsum(counts) - counts
    pcounts = (counts + MOE_BLOCK - 1) // MOE_BLOCK * MOE_BLOCK
    pends = jnp.cumsum(pcounts)
    pstarts = pends - pcounts
    dest = pstarts[e_s] + jnp.arange(A) - starts[e_s]
    n_blk = -(-A // MOE_BLOCK) + MOE_N_EXPERTS
    P = n_blk * MOE_BLOCK
    src = jnp.zeros((P,), jnp.int32).at[dest].set(tok_s)
    wbuf = jnp.zeros((P,), jnp.float32).at[dest].set(w_s)
    valid = jnp.zeros((P,), bool).at[dest].set(True)
    xbuf = jnp.where(valid[:, None], xt[src], 0).reshape(n_blk, MOE_BLOCK, D)
    blk_e = jnp.minimum(jnp.searchsorted(pends, jnp.arange(n_blk) * MOE_BLOCK, side='right'),
                        MOE_N_EXPERTS - 1)

    def expert_block(args):
        xb, e = args
        return (jax.nn.silu(xb @ w_gate[e]) * (xb @ w_up[e])) @ w_down[e]

    ybuf = lax.map(expert_block, (xbuf, blk_e)).reshape(P, D)
    return jax.ops.segment_sum(ybuf * wbuf[:, None].astype(ybuf.dtype), src, num_segments=T)


def setup_inputs(seed: int = 0) -> dict:
    key = jax.random.key(seed)
    ks = iter(jax.random.split(key, 64))
    D = D_MODEL
    L_ = DEPTH

    def nrm(shape, scale):
        return jax.random.normal(next(ks), shape, jnp.float32) * scale

    beta = DEEPNORM_BETA
    return {
        'x': nrm((BATCH, SEQ, D), 1.0),
        'c': nrm((BATCH, D), 1.0),
        'ctx': nrm((BATCH, CTX_LEN, D), 1.0),
        'c_ctx': nrm((D,), 1.0),
        'ada_w': nrm((L_, D, 6 * D), 0.5 * D ** -0.5),
        'ada_b': nrm((L_, 6 * D), 0.02),
        'w_in': nrm((L_, D, N_IN), D ** -0.5),
        'gm_ln_g': 1.0 + nrm((L_, GM_DIM), 0.05),
        'gm_ln_b': nrm((L_, GM_DIM), 0.02),
        'gm_ws': nrm((L_, GM_GROUPS, GM_CHUNK, GM_CHUNK), GM_CHUNK ** -0.5),
        'gm_bs': 1.0 + nrm((L_, GM_GROUPS, GM_CHUNK), 0.1),
        'hy_conv_w': nrm((L_, 3, 3 * HY_DIM), 3 ** -0.5),
        'hy_conv_b': nrm((L_, 3 * HY_DIM), 0.02),
        'hy_f_w1': nrm((L_, HY_EMB, HY_FFN), HY_EMB ** -0.5),
        'hy_f_b1': nrm((L_, HY_FFN), 0.1),
        'hy_f_w2': nrm((L_, HY_FFN, HY_FFN), HY_FFN ** -0.5),
        'hy_f_b2': nrm((L_, HY_FFN), 0.1),
        'hy_f_w3': nrm((L_, HY_FFN, 2 * HY_DIM), HY_FFN ** -0.5),
        'hy_f_b3': nrm((L_, 2 * HY_DIM), 0.02),
        'hy_skip': nrm((L_, HY_DIM), 1.0),
        'da_lq1': nrm((L_, DA_HEAD_DIM), 0.1),
        'da_lk1': nrm((L_, DA_HEAD_DIM), 0.1),
        'da_lq2': nrm((L_, DA_HEAD_DIM), 0.1),
        'da_lk2': nrm((L_, DA_HEAD_DIM), 0.1),
        'da_norm_g': 1.0 + nrm((L_, DA_V_DIM), 0.05),
        'p_a': nrm((L_, GM_DIM, D), beta * GM_DIM ** -0.5),
        'p_b': nrm((L_, HY_DIM, D), beta * HY_DIM ** -0.5),
        'p_c': nrm((L_, DA_V_W, D), beta * DA_V_W ** -0.5),
        'w_out': nrm((L_, D, D), beta * D ** -0.5),
        'ln1_g': 1.0 + nrm((L_, D), 0.05),
        'ln1_b': nrm((L_, D), 0.02),
        'moe_wg': nrm((L_, D, MOE_GROUPS), D ** -0.5),
        'moe_bg': nrm((L_, MOE_GROUPS), 0.01),
        'moe_we': nrm((L_, D, MOE_N_EXPERTS), D ** -0.5),
        'moe_be': nrm((L_, MOE_N_EXPERTS), 0.01),
        'ex_w_gate': nrm((L_, MOE_N_EXPERTS, D, MOE_HIDDEN), D ** -0.5),
        'ex_w_up': nrm((L_, MOE_N_EXPERTS, D, MOE_HIDDEN), D ** -0.5),
        'ex_w_down': nrm((L_, MOE_N_EXPERTS, MOE_HIDDEN, D), beta * MOE_HIDDEN ** -0.5),
        'ln2_g': 1.0 + nrm((L_, D), 0.05),
        'ln2_b': nrm((L_, D), 0.02),
    }


def reference(x, c, ctx, c_ctx, ada_w, ada_b, w_in, gm_ln_g, gm_ln_b, gm_ws, gm_bs,
              hy_conv_w, hy_conv_b, hy_f_w1, hy_f_b1, hy_f_w2, hy_f_b2, hy_f_w3, hy_f_b3, hy_skip,
              da_lq1, da_lk1, da_lq2, da_lk2, da_norm_g, p_a, p_b, p_c, w_out, ln1_g, ln1_b,
              moe_wg, moe_bg, moe_we, moe_be, ex_w_gate, ex_w_up, ex_w_down, ln2_g, ln2_b):
    B, L, D = x.shape
    rows = L // GRID_W
    cos, sin = axial_rope(rows)
    xc = ctx
    for l in range(DEPTH):
        last = l == DEPTH - 1
        lp = {
            'gm_ln_g': gm_ln_g[l], 'gm_ln_b': gm_ln_b[l], 'gm_ws': gm_ws[l], 'gm_bs': gm_bs[l],
            'hy_conv_w': hy_conv_w[l], 'hy_conv_b': hy_conv_b[l],
            'hy_f_w1': hy_f_w1[l], 'hy_f_b1': hy_f_b1[l], 'hy_f_w2': hy_f_w2[l], 'hy_f_b2': hy_f_b2[l],
            'hy_f_w3': hy_f_w3[l], 'hy_f_b3': hy_f_b3[l], 'hy_skip': hy_skip[l],
            'p_a': p_a[l], 'p_b': p_b[l], 'p_c': p_c[l], 'w_out': w_out[l],
        }
        lam_init = 0.8 - 0.6 * math.exp(-0.3 * l)
        lam = (jnp.exp(jnp.sum(da_lq1[l].astype(jnp.float32) * da_lk1[l].astype(jnp.float32)))
               - jnp.exp(jnp.sum(da_lq2[l].astype(jnp.float32) * da_lk2[l].astype(jnp.float32)))
               + lam_init)
        mod = jax.nn.silu(c) @ ada_w[l] + ada_b[l]
        mod_c = jax.nn.silu(c_ctx) @ ada_w[l] + ada_b[l]
        sh1, sc1, g1, sh2, sc2, g2 = jnp.split(mod[:, None, :], 6, axis=-1)
        csh1, csc1, cg1, csh2, csc2, cg2 = jnp.split(mod_c, 6, axis=-1)

        h = modulate(x, sh1, sc1)
        hc = modulate(xc, csh1, csc1)
        z = h @ w_in[l]
        if last:
            k_c, v_c = split_kv(hc @ w_in[l][:, OFF_K:OFF_GATE])
        else:
            zc = hc @ w_in[l]
            k_c, v_c = split_kv(zc[..., OFF_K:OFF_GATE])
        q_l = apply_rope(split_q(z[..., OFF_Q:OFF_K]), cos, sin)
        k_l, v_l = split_kv(z[..., OFF_K:OFF_GATE])
        k_l = apply_rope(k_l, cos, sin)
        k_all = jnp.concatenate([k_l, k_c], axis=1)
        v_all = jnp.concatenate([v_l, v_c], axis=1)
        y_c = head_rms(latent_diff_attention(q_l, k_all, v_all, lam), da_norm_g[l], lam_init)
        out = merge_branches(z, y_c, lp)
        x = layer_norm(DEEPNORM_ALPHA * x + g1 * out, ln1_g[l], ln1_b[l])
        if not last:
            q_c = split_q(zc[..., OFF_Q:OFF_K])
            yc_c = head_rms(diff_softmax_attend(q_c, k_c, v_c, lam), da_norm_g[l], lam_init)
            out_c = merge_branches(zc, yc_c, lp)
            xc = layer_norm(DEEPNORM_ALPHA * xc + cg1 * out_c, ln1_g[l], ln1_b[l])

        h2 = modulate(x, sh2, sc2).reshape(B * L, D)
        if last:
            y = hierarchical_moe(h2, moe_wg[l], moe_bg[l], moe_we[l], moe_be[l],
                                 ex_w_gate[l], ex_w_up[l], ex_w_down[l]).reshape(B, L, D)
        else:
            Lc = xc.shape[1]
            h2c = modulate(xc, csh2, csc2).reshape(B * Lc, D)
            y_all = hierarchical_moe(jnp.concatenate([h2, h2c], axis=0), moe_wg[l], moe_bg[l],
                                     moe_we[l], moe_be[l], ex_w_gate[l], ex_w_up[l], ex_w_down[l])
            y = y_all[:B * L].reshape(B, L, D)
            y_c2 = y_all[B * L:].reshape(B, Lc, D)
            xc = layer_norm(DEEPNORM_ALPHA * xc + cg2 * y_c2, ln2_g[l], ln2_b[l])
        x = layer_norm(DEEPNORM_ALPHA * x + g2 * y, ln2_g[l], ln2_b[l])
    return x
```

```cpp
#include <hip/hip_runtime.h>
#include <cstdio>
#include <cstdint>

#ifndef MK_SPLIT
#define MK_SPLIT 0
#endif

#ifndef MK_F8BUILTIN
#define MK_F8BUILTIN 0
#endif
#ifndef MK_ALIGN_EPIIN
#define MK_ALIGN_EPIIN 1
#endif
#ifndef MK_ALIGN_EPIMERGE
#define MK_ALIGN_EPIMERGE 1
#endif
#ifndef MK_ALIGN_EPIOUT
#define MK_ALIGN_EPIOUT 0
#endif
#ifndef MK_ALIGN_EPIMOE1
#define MK_ALIGN_EPIMOE1 1
#endif
#ifndef MK_ALIGN_EPIMOE2
#define MK_ALIGN_EPIMOE2 1
#endif
#ifndef MK_DUP
#define MK_DUP -1
#endif
#ifndef MK_ROPE_EPI
#define MK_ROPE_EPI 1
#endif
#define GAS __attribute__((address_space(1)))
#define LAS __attribute__((address_space(3)))
typedef unsigned short bf16_t;
typedef short bf16x8 __attribute__((ext_vector_type(8)));
typedef short s16x4 __attribute__((ext_vector_type(4)));
typedef float f32x2 __attribute__((ext_vector_type(2)));
typedef float f32x4 __attribute__((ext_vector_type(4)));
typedef float f32x16 __attribute__((ext_vector_type(16)));
typedef unsigned u32x2 __attribute__((ext_vector_type(2)));
typedef unsigned u32x4 __attribute__((ext_vector_type(4)));
typedef __bf16 bf16x2_t __attribute__((ext_vector_type(2)));

constexpr int D = 1024, BATCH = 32, SEQ = 2048, CTXL = 256, DEPTH = 2;
constexpr int TL = BATCH * SEQ, TC = BATCH * CTXL, TA = TL + TC;
constexpr int NIN = 5888, NZ = 2816;
constexpr int OFF_GM = 0, OFF_HY = 512, OFF_Q = 1280, OFF_K = 1792, OFF_V = 2304, OFF_GATE = 2816;
constexpr int NEXP = 32, MOEH = 512;
constexpr float LN_EPS = 1e-5f;
constexpr float DN_ALPHA = 1.4142135623730951f;
constexpr float QSCALE = 0.125f * 1.4426950408889634f;
constexpr int NWAVES = 8, NTHREADS = 512;

constexpr size_t MiB = 1u << 20;
constexpr size_t WS_CTL = 0, CTL_ZERO_BYTES = 1 * MiB;
constexpr size_t WS_MOD = 1 * MiB;
constexpr size_t WS_MODP = 3 * MiB;
constexpr size_t WS_ROPE = 16 * MiB;
constexpr size_t WS_HF = 17 * MiB;
constexpr size_t WS_LIST = 26 * MiB;
constexpr size_t WS_WT = 36 * MiB;
constexpr size_t WS_WTS = 988 * MiB;
constexpr size_t WS_WSB = 37 * MiB;
constexpr size_t WS_WS = 48 * MiB;
constexpr size_t WSL = 20 * MiB;
constexpr size_t WS_HB = 88 * MiB;
constexpr size_t WS_X = 232 * MiB;
constexpr size_t WS_ZG = 376 * MiB;
constexpr size_t WS_ZH = 448 * MiB;
constexpr size_t WS_Q = 556 * MiB;
constexpr size_t WS_K = 628 * MiB;
constexpr size_t WS_V = 700 * MiB;
constexpr size_t WS_YCAT = 772 * MiB;
constexpr size_t WS_HB8 = 772 * MiB;
constexpr size_t WS_VT = 916 * MiB;
constexpr size_t WS_X0 = 952 * MiB;
constexpr size_t WS_END = 997 * MiB;
constexpr size_t WS_YT = WS_ZG;
constexpr size_t WS_PSCR = WS_ZH;
constexpr size_t WS_MERGED = WS_Q;
constexpr size_t WS_R1 = WS_ZG;
constexpr size_t WS_EW1 = 700 * MiB;
constexpr size_t WS_EW2 = 732 * MiB;
constexpr size_t WS_HID = 604 * MiB;
constexpr size_t WS_YS = WS_ZG;
constexpr size_t WS_POS = 36 * MiB;
constexpr int CW_BAR = 4096;
constexpr int NCONV_E = 9216;
constexpr int CW_CNT = 16384;

constexpr int LDS_BYTES = 155648;
constexpr int MISC_OFF = LDS_BYTES - 512;

__device__ __forceinline__ unsigned pk2(float lo, float hi) { f32x2 v = {lo, hi}; bf16x2_t b = __builtin_convertvector(v, bf16x2_t); return __builtin_bit_cast(unsigned, b); }
__device__ __forceinline__ float sat8(float x) { return __builtin_amdgcn_fmed3f(x, -448.0f, 448.0f); }
__device__ __forceinline__ unsigned pk4_fp8(float a, float b, float c, float d) { int w = __builtin_amdgcn_cvt_pk_fp8_f32(sat8(a), sat8(b), 0, false); w = __builtin_amdgcn_cvt_pk_fp8_f32(sat8(c), sat8(d), w, true); return (unsigned)w; }
constexpr float H8S = 16.0f;
constexpr float W8S = 32.0f, W8R = 1.0f / 32.0f;
__device__ __forceinline__ void fp8x4_to_f32(unsigned w, float (&o)[4]) { const f32x2 a = __builtin_amdgcn_cvt_pk_f32_fp8((int)w, false), b = __builtin_amdgcn_cvt_pk_f32_fp8((int)w, true); o[0] = a.x; o[1] = a.y; o[2] = b.x; o[3] = b.y; }
__device__ __forceinline__ float bf_lo(unsigned w) { return __uint_as_float(w << 16); }
__device__ __forceinline__ float bf_hi(unsigned w) { return __uint_as_float(w & 0xffff0000u); }
__device__ __forceinline__ float bf1(bf16_t b) { return __uint_as_float(((unsigned)b) << 16); }
__device__ __forceinline__ float wave_sum(float v) {
#pragma unroll
    for (int o = 1; o < 64; o <<= 1) v += __shfl_xor(v, o);
    return v;
}
__device__ __forceinline__ float fast_exp2(float x) { return __builtin_amdgcn_exp2f(x); }
__device__ __forceinline__ float fast_rcp(float x) { return __builtin_amdgcn_rcpf(x); }
__device__ __forceinline__ float sigmoidf_(float x) { return fast_rcp(1.0f + fast_exp2(-1.4426950408889634f * x)); }
__device__ __forceinline__ float gelu_tanh(float x) {
    const float u = 0.7978845608028654f * (x + 0.044715f * x * x * x);
    return x * fast_rcp(1.0f + fast_exp2(-2.8853900817779268f * u));
}
#define XB_TMO      128
#define XB_XCNT(j)  (256  + 64 * (j))
#define XB_XSUB(j)  (1280 + 64 * (j))
#define XB_XGEN(j)  (2304 + 64 * (j))
#define XB_TOP      3328
#define XB_TOPGEN   3392
#define XCD_BAR_WORDS 3456
#define XB_SPIN_CAP (1u << 18)

__device__ __forceinline__ unsigned xb_ld(unsigned* p)              { return __hip_atomic_load(p, __ATOMIC_RELAXED, __HIP_MEMORY_SCOPE_AGENT); }
__device__ __forceinline__ unsigned xb_add(unsigned* p, unsigned v) { return __hip_atomic_fetch_add(p, v, __ATOMIC_RELAXED, __HIP_MEMORY_SCOPE_AGENT); }
__device__ __forceinline__ unsigned xb_xcc_id() { return (unsigned)__builtin_amdgcn_s_getreg((3 << 11) | 20) & 0xFu; }
#define XB_SPIN(cond, bar) do { unsigned _sp = 0; while (cond) { __builtin_amdgcn_s_sleep(1); \
    if ((++_sp & 255u) == 0u) { if (xb_ld(&(bar)[XB_TMO])) break; if (_sp > XB_SPIN_CAP) { atomicAdd(&(bar)[XB_TMO], 1u); break; } } } } while (0)

struct XcdBarrier {
    unsigned* bar; unsigned x;
    volatile LAS unsigned* st;
};

__device__ __forceinline__ XcdBarrier xcd_barrier_post(unsigned* bar, volatile LAS unsigned* st) {
    XcdBarrier b; b.bar = bar; b.x = xb_xcc_id(); b.st = st;
    if (threadIdx.x == 0) (void)xb_add(&bar[XB_XCNT(b.x)], 1u);
    return b;
}
__device__ __forceinline__ void xcd_barrier_complete(unsigned* bar, unsigned x, unsigned& nloc, unsigned& nx) {
    const unsigned G = gridDim.x * gridDim.y * gridDim.z;
    unsigned sum, cnt, mine, sp = 0u;
    for (;;) {
        sum = 0u; cnt = 0u; mine = 0u;
#pragma unroll
        for (unsigned j = 0; j < 16; ++j) { const unsigned c = xb_ld(&bar[XB_XCNT(j)]); sum += c; cnt += (c > 0u) ? 1u : 0u; mine = (j == x) ? c : mine; }
        if (sum == G) break;
        __builtin_amdgcn_s_sleep(1);
        if ((++sp & 255u) == 0u) { if (xb_ld(&bar[XB_TMO])) break; if (sp > XB_SPIN_CAP) { atomicAdd(&bar[XB_TMO], 1u); break; } }
    }
    nloc = mine > 0u ? mine : 1u; nx = cnt > 0u ? cnt : 1u;
}

__device__ __forceinline__ void xcd_barrier(const XcdBarrier& b) {
    asm volatile("s_waitcnt vmcnt(0)" ::: "memory");
    __syncthreads();
    if (threadIdx.x == 0) {
        unsigned* bar = b.bar;
        __builtin_amdgcn_s_waitcnt(0);
        unsigned nloc = b.st[0], nx = b.st[1];
        if (nloc == 0u) { xcd_barrier_complete(bar, b.x, nloc, nx); b.st[0] = nloc; b.st[1] = nx; }
        const unsigned old = xb_add(&bar[XB_XSUB(b.x)], 1u);
        const unsigned gen = old / nloc;
        if (old + 1u == (gen + 1u) * nloc) {
            __builtin_amdgcn_fence(__ATOMIC_RELEASE, "agent");
            asm volatile("s_waitcnt vmcnt(0)" ::: "memory");
            const unsigned og = xb_add(&bar[XB_TOP], 1u);
            const unsigned tg = og / nx;
            if (og + 1u == (tg + 1u) * nx) xb_add(&bar[XB_TOPGEN], 1u);
            else XB_SPIN(xb_ld(&bar[XB_TOPGEN]) == tg, bar);
            __builtin_amdgcn_fence(__ATOMIC_ACQUIRE, "agent");
            xb_add(&bar[XB_XGEN(b.x)], 1u);
            asm volatile("s_waitcnt vmcnt(0)" ::: "memory");
        } else {
            XB_SPIN(xb_ld(&bar[XB_XGEN(b.x)]) == gen, bar);
            __builtin_amdgcn_fence(__ATOMIC_ACQUIRE, "agent");
            asm volatile("s_waitcnt vmcnt(0)" ::: "memory");
        }
    }
    __syncthreads();
}


namespace pg8 {
constexpr int BM = 256, BK = 64, HALF = 128, HTB = HALF * BK * 2, STAGE_BYTES = 8 * HTB;
__host__ __device__ __forceinline__ int lds_byte(int r, int c) { const int st = (r >> 4) * 2 + (c >> 5), rr = r & 15, cc = c & 31, ob = rr * 64 + cc * 2; return st * 1024 + (ob ^ (((ob >> 9) & 1) << 5)); }
__host__ __device__ __forceinline__ void stage_rc(int b, int& R, int& C) { const int st = b / 1024, sb = b % 1024, swz = sb ^ (((sb >> 9) & 1) << 5); R = (st >> 1) * 16 + swz / 64; C = (st & 1) * 32 + (swz % 64) / 2; }
__host__ __device__ __forceinline__ int perm32(int rho) { const int n = rho >> 4, i = rho & 15; return 8 * (i >> 2) + 4 * n + (i & 3); }

struct GU { const char* A; const char* B; const int* gl; int K, kind, pm, pn, e, nvalid; };

__device__ __forceinline__ void grid_order(int L, int nM, int nN, int& pm, int& pn) {
    const int nwg = nM * nN; int wgid = L;
    { const int q = nwg / 8, r = nwg % 8, xcd = wgid % 8, off = wgid / 8; wgid = (xcd < r ? xcd * (q + 1) : r * (q + 1) + (xcd - r) * q) + off; }
    const int nig = 8 * nN, gid = wgid / nig, fm = gid * 8, gsz = (nM - fm) < 8 ? (nM - fm) : 8;
    pm = fm + ((wgid % nig) % gsz); pn = (wgid % nig) / gsz;
}

typedef int v8i __attribute__((ext_vector_type(8)));
typedef short bf16x16_t __attribute__((ext_vector_type(16)));
template <class Epi, class Sched, bool GATHER, bool F8 = false>
__device__ __forceinline__ void gemm_phase(LAS unsigned char* lds, const Sched& S, const Epi& E, const int lda, const int ldb, const int wid, const int lane) {
    const int tid = wid * 64 + lane;
    const int wr = wid >> 2, wc = wid & 3, fr = lane & 15, fq = lane >> 4;
    unsigned voffA[2], voffB[2]; int Rr[2], Cb[2];
#pragma unroll
    for (int i = 0; i < 2; ++i) { int R, C; stage_rc(tid * 16 + i * 8192, R, C); const int Rb = (R & ~31) + perm32(R & 31);
        Rr[i] = R; Cb[i] = C * 2; voffA[i] = (unsigned)(R * lda + C * 2); voffB[i] = (unsigned)(Rb * ldb + C * 2); }
    const size_t kstep = (size_t)(BK * 2);
    const size_t hstepA = (size_t)HALF * lda, hstepB = (size_t)HALF * ldb, qstepA = (size_t)64 * lda, qstepB = (size_t)64 * ldb;
    const unsigned ldsw = (unsigned)wid * 1024u;
    const int aoff = lds_byte(wr * 64 + fr, fq * 8), boff = lds_byte(wc * 32 + fr, fq * 8);
#define PG8_SA(b, h) (((b) * 2 + (h)) * HTB)
#define PG8_SB(b, h) ((4 + (b) * 2 + (h)) * HTB)
#define PG8_STAGE(bufoff, gbase, voff) do { _Pragma("unroll") for (int _i = 0; _i < 2; ++_i) \
        __builtin_amdgcn_global_load_lds((const unsigned*)((const char*)(gbase) + (voff)[_i]), (LAS unsigned*)(lds + (bufoff) + ldsw + _i * 8192), 16, 0, 0); } while (0)
#define PG8_STAGE1(bufoff, gbase, voff0, qstep) do { _Pragma("unroll") for (int _i = 0; _i < 2; ++_i) \
        __builtin_amdgcn_global_load_lds((const unsigned*)((const char*)(gbase) + (size_t)_i * (qstep) + (voff0)), (LAS unsigned*)(lds + (bufoff) + ldsw + _i * 8192), 16, 0, 0); } while (0)
#define PG8_STAGE_A(b, h, kp) do { if constexpr (GATHER) { if ((h) == 0) PG8_STAGE(PG8_SA(b, h), kp, gA0); else PG8_STAGE(PG8_SA(b, h), kp, gA1); } \
        else PG8_STAGE1(PG8_SA(b, h), (kp) + (h) * hstepA, voffA[0], qstepA); } while (0)
#define PG8_STAGE_B(b, h, kp) PG8_STAGE1(PG8_SB(b, h), (kp) + (h) * hstepB, voffB[0], qstepB)
#define PG8_LDA(dst, b, h) do { _Pragma("unroll") for (int m = 0; m < 4; ++m) _Pragma("unroll") for (int k = 0; k < 2; ++k) dst[m][k] = *(const LAS bf16x8*)(lds + PG8_SA(b, h) + aoff + m * 2048 + k * 1024); } while (0)
#define PG8_LDB(dst, b, h) do { _Pragma("unroll") for (int n = 0; n < 2; ++n) _Pragma("unroll") for (int k = 0; k < 2; ++k) dst[n][k] = *(const LAS bf16x8*)(lds + PG8_SB(b, h) + boff + n * 2048 + k * 1024); } while (0)
#define PG8_J8(X) __builtin_bit_cast(v8i, (bf16x16_t){X[0][0], X[0][1], X[0][2], X[0][3], X[0][4], X[0][5], X[0][6], X[0][7], X[1][0], X[1][1], X[1][2], X[1][3], X[1][4], X[1][5], X[1][6], X[1][7]})
#define PG8_MMA(ai, bj, At, Bt) do { __builtin_amdgcn_s_setprio(1); _Pragma("unroll") for (int m = 0; m < 4; ++m) _Pragma("unroll") for (int n = 0; n < 2; ++n) { \
        if constexpr (F8 && GATHER) acc[ai][bj][m][n] = __builtin_amdgcn_mfma_scale_f32_16x16x128_f8f6f4(PG8_J8(Bt[n]), PG8_J8(At[m]), acc[ai][bj][m][n], 0, 0, 0, 0x7F7F7F7F, 0, 0x7F7F7F7F); \
        else if constexpr (F8) { const v8i b8_ = PG8_J8(Bt[n]), a8_ = PG8_J8(At[m]); asm volatile("v_mfma_scale_f32_16x16x128_f8f6f4 %0, %1, %2, %0, %3, %3 op_sel_hi:[0,0,0]" : "+v"(acc[ai][bj][m][n]) : "v"(b8_), "v"(a8_), "v"(0x7F7F7F7F)); } \
        else { _Pragma("unroll") for (int k = 0; k < 2; ++k) acc[ai][bj][m][n] = __builtin_amdgcn_mfma_f32_16x16x32_bf16(Bt[n][k], At[m][k], acc[ai][bj][m][n], 0, 0, 0); } } \
        __builtin_amdgcn_s_setprio(0); } while (0)
#define PG8_WAIT_V(n) asm volatile("s_waitcnt vmcnt(" #n ")" ::: "memory")
#define PG8_WAIT_L(n) asm volatile("s_waitcnt lgkmcnt(" #n ")" ::: "memory")
#define PG8_BAR __builtin_amdgcn_s_barrier()
#define PG8_SCHED __builtin_amdgcn_sched_barrier(0)
#define PG8_GOFF(u, o0, o1) do { _Pragma("unroll") for (int _i = 0; _i < 2; ++_i) { const int _r0 = Rr[_i], _r1 = HALF + Rr[_i]; \
        const int _t0 = (_r0 < (u).nvalid) ? ((u).gl[_r0] >> 1) : 0, _t1 = (_r1 < (u).nvalid) ? ((u).gl[_r1] >> 1) : 0; \
        o0[_i] = (unsigned)_t0 * (unsigned)lda + (unsigned)Cb[_i]; o1[_i] = (unsigned)_t1 * (unsigned)lda + (unsigned)Cb[_i]; } } while (0)
    GU cur, nxt; int ui = 0;
    if (!S.next(0, cur)) return;
    f32x4 acc[2][2][4][2];
#pragma unroll
    for (int a = 0; a < 2; ++a)
#pragma unroll
        for (int b = 0; b < 2; ++b)
#pragma unroll
            for (int m = 0; m < 4; ++m)
#pragma unroll
                for (int n = 0; n < 2; ++n) acc[a][b][m][n] = (f32x4){0.f, 0.f, 0.f, 0.f};
    bf16x8 At[4][2], B0[2][2], B1[2][2];
    unsigned gA0[2] = {0u, 0u}, gA1[2] = {0u, 0u};
    if constexpr (GATHER) PG8_GOFF(cur, gA0, gA1);
    const char* cA = cur.A; const char* cB = cur.B;
    PG8_STAGE_B(0, 0, cB); PG8_STAGE_B(0, 1, cB); PG8_STAGE_A(0, 0, cA); PG8_STAGE_A(0, 1, cA);
    if (wr == 1) PG8_BAR;
    PG8_WAIT_V(2); PG8_BAR;
    PG8_STAGE_B(1, 0, cB + kstep); PG8_STAGE_A(1, 0, cA + kstep); PG8_STAGE_B(1, 1, cB + kstep);
    PG8_WAIT_V(6); PG8_BAR;
    for (;;) {
        const bool has_next = S.next(ui + 1, nxt);
        int nid[2][2] = {{0, 0}, {0, 0}};
        if constexpr (GATHER) { if (has_next) {
#pragma unroll
            for (int _i = 0; _i < 2; ++_i) { const int _r0 = Rr[_i], _r1 = HALF + Rr[_i]; nid[0][_i] = nxt.gl[_r0 < nxt.nvalid ? _r0 : 0]; nid[1][_i] = nxt.gl[_r1 < nxt.nvalid ? _r1 : 0]; } } }
        const char* nA = has_next ? nxt.A : cA; const char* nB = has_next ? nxt.B : cB;
        const int nt = F8 ? cur.K / 128 : cur.K / BK;
        for (int t = 0; t < nt; t += 2) {
            const bool last = (t == nt - 2);
            const char* a1 = cA + (size_t)(t + 1) * kstep;
            const char* a2 = last ? nA : cA + (size_t)(t + 2) * kstep; const char* b2 = last ? nB : cB + (size_t)(t + 2) * kstep;
            const char* a3 = a2 + kstep; const char* b3 = b2 + kstep;
            PG8_LDB(B0, 0, 0); PG8_LDB(B1, 0, 1); PG8_SCHED; PG8_LDA(At, 0, 0); PG8_STAGE_A(1, 1, a1);
            if constexpr (GATHER) { if (last && has_next) {
#pragma unroll
                for (int _i = 0; _i < 2; ++_i) { const int _r0 = Rr[_i], _r1 = HALF + Rr[_i];
                    const int _t0 = (_r0 < nxt.nvalid) ? (nid[0][_i] >> 1) : 0, _t1 = (_r1 < nxt.nvalid) ? (nid[1][_i] >> 1) : 0;
                    gA0[_i] = (unsigned)_t0 * (unsigned)lda + (unsigned)Cb[_i]; gA1[_i] = (unsigned)_t1 * (unsigned)lda + (unsigned)Cb[_i]; } } }
            PG8_WAIT_V(8); PG8_WAIT_L(0); PG8_BAR; PG8_MMA(0, 0, At, B0); PG8_MMA(0, 1, At, B1); PG8_BAR; PG8_SCHED;
            PG8_LDA(At, 0, 1); PG8_STAGE_B(0, 0, b2); PG8_STAGE_B(0, 1, b2); PG8_STAGE_A(0, 0, a2);
            PG8_WAIT_V(8); PG8_WAIT_L(0); PG8_BAR; PG8_MMA(1, 0, At, B0); PG8_MMA(1, 1, At, B1); PG8_BAR; PG8_SCHED;
            PG8_LDB(B0, 1, 0); PG8_LDB(B1, 1, 1); PG8_SCHED; PG8_LDA(At, 1, 0); PG8_STAGE_A(0, 1, a2);
            PG8_WAIT_V(8); PG8_WAIT_L(0); PG8_BAR; PG8_MMA(0, 0, At, B0); PG8_MMA(0, 1, At, B1); PG8_BAR; PG8_SCHED;
            PG8_LDA(At, 1, 1); PG8_STAGE_B(1, 0, b3); PG8_STAGE_B(1, 1, b3); PG8_STAGE_A(1, 0, a3);
            PG8_WAIT_V(8); PG8_WAIT_L(0); PG8_BAR; PG8_MMA(1, 0, At, B0); PG8_MMA(1, 1, At, B1); PG8_BAR; PG8_SCHED;
        }
        if ((Epi::ALIGN || !has_next) && wr == 0) PG8_BAR;
        if constexpr (F8) { asm volatile("s_nop 15\n\ts_nop 15" ::: "memory"); PG8_SCHED; }
        E(acc, cur, wr, wc, fr, fq);
        if (!has_next) break;
#pragma unroll
        for (int a = 0; a < 2; ++a)
#pragma unroll
            for (int b = 0; b < 2; ++b)
#pragma unroll
                for (int m = 0; m < 4; ++m)
#pragma unroll
                    for (int n = 0; n < 2; ++n) acc[a][b][m][n] = (f32x4){0.f, 0.f, 0.f, 0.f};
        cur = nxt; cA = nA; cB = nB; ++ui;
        if (Epi::ALIGN && wr == 1) PG8_BAR;
    }
    PG8_WAIT_V(0);
    PG8_BAR;
#undef PG8_SA
#undef PG8_SB
#undef PG8_STAGE
#undef PG8_STAGE1
#undef PG8_STAGE_A
#undef PG8_STAGE_B
#undef PG8_LDA
#undef PG8_LDB
#undef PG8_MMA
#undef PG8_J8
#undef PG8_WAIT_V
#undef PG8_WAIT_L
#undef PG8_BAR
#undef PG8_SCHED
#undef PG8_GOFF
}
}

struct Args { const float* in[40]; float* out; unsigned char* ws; int ph_lo, ph_hi; };
typedef const __attribute__((address_space(4))) Args* ArgsP;
enum InIdx { I_X = 0, I_C, I_CTX, I_CCTX, I_ADAW, I_ADAB, I_WIN, I_GMLNG, I_GMLNB, I_GMWS, I_GMBS, I_HYCW, I_HYCB, I_HYW1, I_HYB1, I_HYW2, I_HYB2, I_HYW3, I_HYB3, I_HYSKIP,
             I_LQ1, I_LK1, I_LQ2, I_LK2, I_DANG, I_PA, I_PB, I_PC, I_WOUT, I_LN1G, I_LN1B, I_MOEWG, I_MOEBG, I_MOEWE, I_MOEBE, I_EXG, I_EXU, I_EXD, I_LN2G, I_LN2B };

struct Frame {
    LAS unsigned char* lds;
    volatile LAS unsigned* MISC;
    unsigned* ctl;
    int tid, lane, wave, G, bid, gw, NGW;
    unsigned char* ws;
};

template <int MODE>
__device__ __forceinline__ void cvt_item(const float* __restrict__ W, int N, bf16_t* __restrict__ WT, int ldk, int item, int lane) {
    const int nblk = N >> 6, kb = item / nblk, nb = item - kb * nblk, n = nb * 64 + lane, k0 = kb * 64;
    int row = n; if (MODE == 1) row = 8 * (n >> 2) + (n & 3); if (MODE == 2) row = 8 * (n >> 2) + 4 + (n & 3);
    const float* src = W + (size_t)k0 * N + n;
    bf16_t* dst = WT + (size_t)row * ldk + k0;
#pragma unroll 1
    for (int q = 0; q < 8; ++q) {
        float v[8];
#pragma unroll
        for (int j = 0; j < 8; ++j) v[j] = src[(size_t)(q * 8 + j) * N];
        u32x4 o; o.x = pk2(v[0], v[1]); o.y = pk2(v[2], v[3]); o.z = pk2(v[4], v[5]); o.w = pk2(v[6], v[7]);
        *(u32x4*)(dst + q * 8) = o;
    }
}

template <int MODE, bool F8W = false>
__device__ __forceinline__ void tr_item(const float* __restrict__ W, int N, bf16_t* __restrict__ WT, int ldk, LAS float* scr, int item, int lane, int nblk = 0) {
    if (nblk == 0) nblk = N >> 5;
    const int kb = item / nblk, nb = item - kb * nblk, k0 = 64 * kb, n0 = 32 * nb;
    const float* src = W + (size_t)k0 * N + n0 + (lane & 31) + (size_t)(lane >> 5) * N;
#pragma unroll 8
    for (int i = 0; i < 32; ++i) scr[(2 * i + (lane >> 5)) * 33 + (lane & 31)] = src[(size_t)(2 * i) * N];
    asm volatile("s_waitcnt lgkmcnt(0)" ::: "memory");
    const int c = lane & 7;
#pragma unroll
    for (int j = 0; j < 4; ++j) { const int n = n0 + (lane >> 3) + 8 * j; const LAS float* s = scr + (8 * c) * 33 + (lane >> 3) + 8 * j;
        int row = n; if (MODE == 1) row = 8 * (n >> 2) + (n & 3); if (MODE == 2) row = 8 * (n >> 2) + 4 + (n & 3);
        if constexpr (F8W) { u32x2 o; o.x = pk4_fp8(s[0 * 33] * W8S, s[1 * 33] * W8S, s[2 * 33] * W8S, s[3 * 33] * W8S); o.y = pk4_fp8(s[4 * 33] * W8S, s[5 * 33] * W8S, s[6 * 33] * W8S, s[7 * 33] * W8S);
            *(u32x2*)((unsigned char*)WT + (size_t)row * ldk + k0 + 8 * c) = o; }
        else { u32x4 o; o.x = pk2(s[0 * 33], s[1 * 33]); o.y = pk2(s[2 * 33], s[3 * 33]); o.z = pk2(s[4 * 33], s[5 * 33]); o.w = pk2(s[6 * 33], s[7 * 33]);
            *(u32x4*)(WT + (size_t)row * ldk + k0 + 8 * c) = o; } }
    asm volatile("s_waitcnt lgkmcnt(0)" ::: "memory");
}

template <int MODE, bool F8W>
__device__ __forceinline__ void tr_item2(const float* __restrict__ W, int N, bf16_t* __restrict__ WT, int ldk, LAS float* scr, int item, int lane) {
    const int nblk = N >> 5;
    float v[2][32];
#pragma unroll
    for (int t = 0; t < 2; ++t) { const int it = item + t, kb = it / nblk, nb = it - kb * nblk;
        const float* src = W + (size_t)(64 * kb) * N + 32 * nb + (lane & 31) + (size_t)(lane >> 5) * N;
#pragma unroll
        for (int i = 0; i < 32; ++i) v[t][i] = src[(size_t)(2 * i) * N]; }
#pragma unroll
    for (int t = 0; t < 2; ++t) { const int it = item + t, kb = it / nblk, nb = it - kb * nblk, k0 = 64 * kb, n0 = 32 * nb;
#pragma unroll
        for (int i = 0; i < 32; ++i) scr[(2 * i + (lane >> 5)) * 33 + (lane & 31)] = v[t][i];
        asm volatile("s_waitcnt lgkmcnt(0)" ::: "memory");
        const int c = lane & 7;
#pragma unroll
        for (int j = 0; j < 4; ++j) { const int n = n0 + (lane >> 3) + 8 * j; const LAS float* s = scr + (8 * c) * 33 + (lane >> 3) + 8 * j;
            int row = n; if (MODE == 1) row = 8 * (n >> 2) + (n & 3); if (MODE == 2) row = 8 * (n >> 2) + 4 + (n & 3);
            if constexpr (F8W) { u32x2 o; o.x = pk4_fp8(s[0 * 33] * W8S, s[1 * 33] * W8S, s[2 * 33] * W8S, s[3 * 33] * W8S); o.y = pk4_fp8(s[4 * 33] * W8S, s[5 * 33] * W8S, s[6 * 33] * W8S, s[7 * 33] * W8S);
                *(u32x2*)((unsigned char*)WT + (size_t)row * ldk + k0 + 8 * c) = o; }
            else { u32x4 o; o.x = pk2(s[0 * 33], s[1 * 33]); o.y = pk2(s[2 * 33], s[3 * 33]); o.z = pk2(s[4 * 33], s[5 * 33]); o.w = pk2(s[6 * 33], s[7 * 33]);
                *(u32x4*)(WT + (size_t)row * ldk + k0 + 8 * c) = o; } }
        asm volatile("s_waitcnt lgkmcnt(0)" ::: "memory"); }
}

__device__ __forceinline__ void p0a_prologue(Frame& F, ArgsP a) {
    {
        constexpr int I_WIN_ = 16 * 184, I_PA_ = 4 * 32, I_PC_ = 8 * 32, I_WO_ = 16 * 32, PER = I_WIN_ + 2 * I_PA_ + I_PC_ + I_WO_;
        LAS float* scr = (LAS float*)(F.lds + F.wave * 8448);
        for (int it = F.gw; it < 2 * PER; it += F.NGW) {
            const int l = it / PER; int r = it - l * PER;
            bf16_t* wsl = (bf16_t*)(F.ws + WS_WS + (size_t)l * WSL);
            if (r < I_WIN_) { tr_item<0>(a->in[I_WIN] + (size_t)l * D * NIN, NIN, wsl, D, scr, r, F.lane); continue; } r -= I_WIN_;
            bf16_t* pt = wsl + 6 * MiB;
            if (r < I_PA_) { tr_item<0>(a->in[I_PA] + (size_t)l * 256 * D, D, pt, D, scr, r, F.lane); continue; } r -= I_PA_;
            if (r < I_PA_) { tr_item<0>(a->in[I_PB] + (size_t)l * 256 * D, D, pt + (size_t)D * D, D, scr, r, F.lane); continue; } r -= I_PA_;
            if (r < I_PC_) { tr_item<0>(a->in[I_PC] + (size_t)l * 512 * D, D, pt + (size_t)2 * D * D, D, scr, r, F.lane); continue; } r -= I_PC_;
            tr_item<0>(a->in[I_WOUT] + (size_t)l * D * D, D, wsl + 9 * MiB, D, scr, r, F.lane);
        }
        __syncthreads();
    }
    {
        LAS float* s = (LAS float*)F.lds;
        float* modp = (float*)(F.ws + WS_MODP);
        for (int u = F.bid; u < 192; u += F.G) {
            const int cb = u % 24, kc = u / 24, n = cb * 512 + F.tid, l = n / 6144, col = n - l * 6144;
            __syncthreads();
            for (int i = F.tid; i < 33 * 128; i += NTHREADS) { const int r = i >> 7, k = i & 127; const float c = (r < 32) ? a->in[I_C][r * D + kc * 128 + k] : a->in[I_CCTX][kc * 128 + k];
                s[i] = c * sigmoidf_(c); }
            __syncthreads();
            float acc[33];
#pragma unroll
            for (int r = 0; r < 33; ++r) acc[r] = 0.f;
            const float* w = a->in[I_ADAW] + ((size_t)l * D + kc * 128) * 6144 + col;
            for (int k = 0; k < 128; k += 4) {
                const float w0 = w[(size_t)k * 6144], w1 = w[(size_t)(k + 1) * 6144], w2 = w[(size_t)(k + 2) * 6144], w3 = w[(size_t)(k + 3) * 6144];
#pragma unroll
                for (int r = 0; r < 33; ++r) { const f32x4 sv = *(const LAS f32x4*)(s + r * 128 + k); acc[r] += sv.x * w0 + sv.y * w1 + sv.z * w2 + sv.w * w3; }
            }
#pragma unroll
            for (int r = 0; r < 33; ++r) modp[((size_t)(kc * 2 + l) * 33 + r) * 6144 + col] = acc[r];
        }
        __syncthreads();
    }
    {
        float* HF = (float*)(F.ws + WS_HF);
        for (int p = F.gw; p < 4096 + 256; p += F.NGW) {
            const bool isc = p >= 4096; const int l = isc ? 0 : (p >> 11), d = isc ? (p - 4096) : (p & 2047), L = isc ? 256 : 2048;
            const float t = (float)d / (float)(L - 1), w = 6.283185307179586f * (float)d / (float)L;
            const int lane = F.lane;
            float emb = 0.f;
            if (lane == 0) emb = t;
            else if (lane <= 32) { const int j = (lane - 1) & 15; const float f = 1e-4f + (float)j * ((15.0f - 1e-4f) / 15.0f); const float ang = f * w; emb = (lane <= 16) ? cosf(ang) : -sinf(ang); }
            const float* w1 = a->in[I_HYW1] + (size_t)l * 33 * 64; const float* w2 = a->in[I_HYW2] + (size_t)l * 64 * 64; const float* w3 = a->in[I_HYW3] + (size_t)l * 64 * 512;
            float z = a->in[I_HYB1][l * 64 + lane];
            for (int i = 0; i < 33; ++i) z += __shfl(emb, i) * w1[i * 64 + lane];
            const float h1 = sinf(z);
            z = a->in[I_HYB2][l * 64 + lane];
            for (int i = 0; i < 64; ++i) z += __shfl(h1, i) * w2[i * 64 + lane];
            const float h2 = sinf(z);
            float o[8];
#pragma unroll
            for (int m = 0; m < 8; ++m) o[m] = a->in[I_HYB3][l * 512 + lane + 64 * m];
            for (int i = 0; i < 64; ++i) { const float hv = __shfl(h2, i);
#pragma unroll
                for (int m = 0; m < 8; ++m) o[m] += hv * w3[i * 512 + lane + 64 * m]; }
            float* dst = isc ? (HF + (size_t)2 * 2048 * 512 + (size_t)d * 512) : (HF + ((size_t)l * 2048 + d) * 512);
            const float mind = -3.0701134573253945f, maxd = -15.350567286626973f;
#pragma unroll
            for (int m = 0; m < 8; ++m) { const int n = lane + 64 * m, c = n & 255; const float delta = fabsf(mind + (float)c * ((maxd - mind) / 255.0f));
                dst[n] = o[m] * (expf(-t * delta) + 0.05f); }
        }
    }
    {
        const float* src = a->in[I_GMWS]; unsigned* dst = (unsigned*)(F.ws + WS_WSB);
        for (int i = F.bid * NTHREADS + F.tid; i < 2 * 4 * 128 * 128 / 2; i += F.G * NTHREADS) dst[i] = pk2(src[2 * i], src[2 * i + 1]);
    }
    {
        float* COS = (float*)(F.ws + WS_ROPE); float* SIN = COS + 65536;
        for (int e = F.bid * NTHREADS + F.tid; e < 65536; e += F.G * NTHREADS) {
            const int t = e >> 5, ax = (e >> 4) & 1, i = e & 15; const float pos = (float)(ax ? (t & 63) : (t >> 6));
            const float inv = powf(10000.0f, -(float)i / 16.0f), ang = pos * inv;
            COS[e] = cosf(ang); SIN[e] = sinf(ang);
        }
    }
}

__device__ __forceinline__ void p0b_mod(Frame& F, ArgsP a) {
    const float* modp = (const float*)(F.ws + WS_MODP); float* mod = (float*)(F.ws + WS_MOD);
    for (int i = F.bid * NTHREADS + F.tid; i < 2 * 33 * 6144; i += F.G * NTHREADS) {
        const int l = i / (33 * 6144), rem = i - l * 33 * 6144, r = rem / 6144, col = rem - r * 6144;
        float s = a->in[I_ADAB][l * 6144 + col];
#pragma unroll
        for (int kc = 0; kc < 8; ++kc) s += modp[((size_t)(kc * 2 + l) * 33 + r) * 6144 + col];
        mod[i] = s;
    }
}

__device__ __forceinline__ int mod_row(int row) { return row < TL ? (row >> 11) : 32; }

__device__ __forceinline__ void phase_modulate0(Frame& F, ArgsP a) {
    const float* mod = (const float*)(F.ws + WS_MOD); bf16_t* HB = (bf16_t*)(F.ws + WS_HB);
    for (int row0 = F.gw; row0 < TA; row0 += 4 * F.NGW) {
        f32x4 xv[4][4];
#pragma unroll
        for (int q = 0; q < 4; ++q) { const int row = row0 + q * F.NGW; const float* src = row < TL ? a->in[I_X] + (size_t)row * D : a->in[I_CTX] + (size_t)(row - TL) * D;
#pragma unroll
            for (int j = 0; j < 4; ++j) xv[q][j] = *(const f32x4*)(src + 4 * F.lane + 256 * j); }
#pragma unroll
        for (int q = 0; q < 4; ++q) { const int row = row0 + q * F.NGW; const float* m = mod + (size_t)mod_row(row) * 6144;
            u32x2* dst = (u32x2*)(HB + (size_t)row * D);
#pragma unroll
            for (int j = 0; j < 4; ++j) { const int c = 4 * F.lane + 256 * j; const f32x4 x = xv[q][j], sh = *(const f32x4*)(m + c), sc = *(const f32x4*)(m + 1024 + c);
                const float h0 = x.x * (1.f + sc.x) + sh.x, h1 = x.y * (1.f + sc.y) + sh.y, h2 = x.z * (1.f + sc.z) + sh.z, h3 = x.w * (1.f + sc.w) + sh.w;
                u32x2 o; o.x = pk2(h0, h1); o.y = pk2(h2, h3); dst[F.lane + 64 * j] = o; } }
    }
}

struct SchedIn {
    int G, c, nreg, nctx; const char* A; const char* B;
    int nM;
    __device__ __forceinline__ bool next(int i, pg8::GU& u) const {
        const int L = i * G + c; if (L >= nreg + nctx) return false;
        int pm, pn;
        if (L < nreg) pg8::grid_order(L, nM, 11, pm, pn);
        else { const int j = L - nreg; pm = 256 + (j >> 2); pn = 7 + (j & 3); }
        u.A = A + (size_t)pm * 256 * 2048; u.B = B + (size_t)pn * 256 * 2048; u.gl = nullptr; u.K = 1024; u.kind = 0; u.pm = pm; u.pn = pn; u.e = 0; u.nvalid = 256;
        return true;
    }
};
struct EpiIn { static constexpr bool ALIGN = MK_ALIGN_EPIIN;
    bf16_t *ZG, *ZH, *Q, *K, *V; const float* COS;
    __device__ __forceinline__ void rope_store(const f32x4 (&acc)[2][2][4][2], const pg8::GU& u, int wr, int wc, int fr, int fq, bf16_t* base, int colt, float sc) const {
        const int row0 = u.pm * 256 + wr * 64 + fr, col0 = colt + wc * 32 + 8 * fq;
        const float sgn = (fq < 2) ? -1.0f : 1.0f; const bool lowhalf = fq < 2;
        const float* SIN = COS + 65536; const int toff = (wc & 1) * 16 + 8 * (fq & 1);
#pragma unroll
        for (int ai = 0; ai < 2; ++ai)
#pragma unroll
            for (int m = 0; m < 4; ++m) { const int row = row0 + ai * 128 + m * 16, t = row & (SEQ - 1);
                const f32x4 c0 = *(const f32x4*)(COS + t * 32 + toff), c1 = *(const f32x4*)(COS + t * 32 + toff + 4), s0 = *(const f32x4*)(SIN + t * 32 + toff) * sgn, s1 = *(const f32x4*)(SIN + t * 32 + toff + 4) * sgn;
#pragma unroll
                for (int bj = 0; bj < 2; ++bj) { const f32x4 v0 = acc[ai][bj][m][0], v1 = acc[ai][bj][m][1]; f32x4 p0, p1;
#pragma unroll
                    for (int j = 0; j < 4; ++j) {
                        auto ra = __builtin_amdgcn_permlane32_swap(__float_as_uint(v0[j]), __float_as_uint(v0[j]), false, false); p0[j] = __uint_as_float(lowhalf ? ra[1] : ra[0]);
                        auto rb = __builtin_amdgcn_permlane32_swap(__float_as_uint(v1[j]), __float_as_uint(v1[j]), false, false); p1[j] = __uint_as_float(lowhalf ? rb[1] : rb[0]); }
                    const f32x4 o0 = (v0 * c0 + p0 * s0) * sc, o1 = (v1 * c1 + p1 * s1) * sc;
                    u32x4 w; w.x = pk2(o0[0], o0[1]); w.y = pk2(o0[2], o0[3]); w.z = pk2(o1[0], o1[1]); w.w = pk2(o1[2], o1[3]);
                    *(u32x4*)(base + (size_t)row * 512 + col0 + bj * 128) = w; } }
    }
    __device__ __forceinline__ void operator()(const f32x4 (&acc)[2][2][4][2], const pg8::GU& u, int wr, int wc, int fr, int fq) const {
        const int pn = u.pn; bf16_t* base; int ldc, colt, act = 0; float sc = 1.f;
        if (MK_ROPE_EPI && pn >= 5 && pn < 9 && u.pm < 256) { if (pn < 7) rope_store(acc, u, wr, wc, fr, fq, Q, (pn - 5) * 256, QSCALE); else rope_store(acc, u, wr, wc, fr, fq, K, (pn - 7) * 256, 1.0f); return; }
        if (pn < 2) { base = ZG; ldc = 512; colt = pn * 256; act = 1; }
        else if (pn < 5) { base = ZH; ldc = 768; colt = (pn - 2) * 256; }
        else if (pn < 7) { base = Q; ldc = 512; colt = (pn - 5) * 256; sc = QSCALE; }
        else if (pn < 9) { base = K; ldc = 512; colt = (pn - 7) * 256; }
        else { base = V; ldc = 512; colt = (pn - 9) * 256; }
        const int row0 = u.pm * 256 + wr * 64 + fr, col0 = colt + wc * 32 + 8 * fq;
#pragma unroll
        for (int ai = 0; ai < 2; ++ai)
#pragma unroll
            for (int m = 0; m < 4; ++m) { bf16_t* rowp = base + (size_t)(row0 + ai * 128 + m * 16) * ldc + col0;
#pragma unroll
                for (int bj = 0; bj < 2; ++bj) { f32x4 v0 = acc[ai][bj][m][0], v1 = acc[ai][bj][m][1];
                    if (act) {
#pragma unroll
                        for (int j = 0; j < 4; ++j) { v0[j] = gelu_tanh(v0[j]); v1[j] = gelu_tanh(v1[j]); } }
                    else { v0 = v0 * sc; v1 = v1 * sc; }
                    u32x4 w; w.x = pk2(v0[0], v0[1]); w.y = pk2(v0[2], v0[3]); w.z = pk2(v1[0], v1[1]); w.w = pk2(v1[2], v1[3]);
                    *(u32x4*)(rowp + bj * 128) = w; } }
    }
};

__device__ __forceinline__ void gmlp_unit(Frame& F, ArgsP a, int l, int chunk) {
    const bf16_t* ZG = (const bf16_t*)(F.ws + WS_ZG); bf16_t* YC = (bf16_t*)(F.ws + WS_YCAT);
    LAS bf16_t* vT = (LAS bf16_t*)F.lds;
    const int row0 = chunk * 128, lane = F.lane;
    __syncthreads();
    {
        const f32x4 g = *(const f32x4*)(a->in[I_GMLNG] + l * 256 + 4 * lane), bb = *(const f32x4*)(a->in[I_GMLNB] + l * 256 + 4 * lane);
        u32x2 wv[16];
#pragma unroll
        for (int i = 0; i < 16; ++i) wv[i] = *(const u32x2*)(ZG + (size_t)(row0 + F.wave + 8 * i) * 512 + 256 + 4 * lane);
#pragma unroll
        for (int i0 = 0; i0 < 16; i0 += 4) {
            f32x4 v[4]; float s[4], qq[4];
#pragma unroll
            for (int k = 0; k < 4; ++k) { const u32x2 w = wv[i0 + k]; v[k] = (f32x4){bf_lo(w.x), bf_hi(w.x), bf_lo(w.y), bf_hi(w.y)}; s[k] = (v[k].x + v[k].y) + (v[k].z + v[k].w); }
#pragma unroll
            for (int o = 1; o < 64; o <<= 1)
#pragma unroll
                for (int k = 0; k < 4; ++k) s[k] += __shfl_xor(s[k], o);
#pragma unroll
            for (int k = 0; k < 4; ++k) { v[k] = v[k] - s[k] * (1.f / 256.f); qq[k] = (v[k].x * v[k].x + v[k].y * v[k].y) + (v[k].z * v[k].z + v[k].w * v[k].w); }
#pragma unroll
            for (int o = 1; o < 64; o <<= 1)
#pragma unroll
                for (int k = 0; k < 4; ++k) qq[k] += __shfl_xor(qq[k], o);
#pragma unroll
            for (int k = 0; k < 4; ++k) { const int q = F.wave + 8 * (i0 + k); const float rstd = 1.0f / sqrtf(qq[k] * (1.f / 256.f) + LN_EPS);
                const f32x4 y = v[k] * rstd * g + bb;
                const unsigned p01 = pk2(y.x, y.y), p23 = pk2(y.z, y.w);
                vT[(4 * lane + 0) * 136 + q] = (bf16_t)(p01 & 0xffffu); vT[(4 * lane + 1) * 136 + q] = (bf16_t)(p01 >> 16);
                vT[(4 * lane + 2) * 136 + q] = (bf16_t)(p23 & 0xffffu); vT[(4 * lane + 3) * 136 + q] = (bf16_t)(p23 >> 16); }
        }
    }
    __syncthreads();
    const int g = F.wave >> 1, ct = F.wave & 1, r32 = lane & 31, hi = lane >> 5;
    const bf16_t* wsb = (const bf16_t*)(F.ws + WS_WSB) + ((size_t)(l * 4 + g) * 128 + r32) * 128 + 8 * hi;
    const LAS unsigned char* vb = (const LAS unsigned char*)vT + (g * 64 + ct * 32 + r32) * 272 + 16 * hi;
    f32x16 acc[4];
#pragma unroll
    for (int pt = 0; pt < 4; ++pt) acc[pt] = (f32x16){0.f};
#pragma unroll
    for (int ks = 0; ks < 8; ++ks) { const bf16x8 B = *(const LAS bf16x8*)(vb + 32 * ks);
#pragma unroll
        for (int pt = 0; pt < 4; ++pt) { const bf16x8 A = *(const bf16x8*)(wsb + (size_t)pt * 32 * 128 + 16 * ks); acc[pt] = __builtin_amdgcn_mfma_f32_32x32x16_bf16(A, B, acc[pt], 0, 0, 0); } }
    const int c = g * 64 + ct * 32 + r32;
    const float* bsr = a->in[I_GMBS] + (l * 4 + g) * 128;
    LAS bf16_t* ot = (LAS bf16_t*)(F.lds + 73728);
#pragma unroll
    for (int pt = 0; pt < 4; ++pt)
#pragma unroll
        for (int r = 0; r < 16; ++r) { const int p = 32 * pt + (r & 3) + 8 * (r >> 2) + 4 * hi;
            ot[p * 264 + c] = (bf16_t)(pk2(acc[pt][r] + bsr[p], 0.f) & 0xffffu); }
    __syncthreads();
    for (int it = F.tid; it < 128 * 32; it += NTHREADS) { const int p = it >> 5, c8 = (it & 31) * 8;
        const u32x4 uw = *(const u32x4*)(ZG + (size_t)(row0 + p) * 512 + c8), ow = *(const LAS u32x4*)(ot + p * 264 + c8);
        u32x4 y; y.x = pk2(bf_lo(uw.x) * bf_lo(ow.x), bf_hi(uw.x) * bf_hi(ow.x)); y.y = pk2(bf_lo(uw.y) * bf_lo(ow.y), bf_hi(uw.y) * bf_hi(ow.y));
        y.z = pk2(bf_lo(uw.z) * bf_lo(ow.z), bf_hi(uw.z) * bf_hi(ow.z)); y.w = pk2(bf_lo(uw.w) * bf_lo(ow.w), bf_hi(uw.w) * bf_hi(ow.w));
        *(u32x4*)(YC + (size_t)(row0 + p) * 1024 + c8) = y; }
}

__device__ __forceinline__ void sconv_unit(Frame& F, ArgsP a, int l, int blk) {
    const bf16_t* ZH = (const bf16_t*)(F.ws + WS_ZH); bf16_t* X0 = (bf16_t*)(F.ws + WS_X0); bf16_t* VT = (bf16_t*)(F.ws + WS_VT);
    LAS bf16_t* vt = (LAS bf16_t*)F.lds;
    const int row0 = blk * 128; const bool lat = row0 < TL;
    const int Lseq = lat ? SEQ : CTXL, seq0 = lat ? (row0 & ~(SEQ - 1)) : TL + ((row0 - TL) & ~(CTXL - 1));
    const float* cw = a->in[I_HYCW] + (size_t)l * 3 * 768; const float* cb = a->in[I_HYCB] + (size_t)l * 768;
    __syncthreads();
    const int c = (F.tid & 31) * 8;
    float wt[3][4][8];
#pragma unroll
    for (int part = 0; part < 3; ++part)
#pragma unroll
        for (int k = 0; k < 4; ++k) { const float* s = (k < 3 ? cw + k * 768 : cb) + part * 256 + c; const f32x4 lo = *(const f32x4*)s, hi4 = *(const f32x4*)(s + 4);
#pragma unroll
            for (int j = 0; j < 4; ++j) { wt[part][k][j] = lo[j]; wt[part][k][4 + j] = hi4[j]; } }
    for (int it = F.tid; it < 128 * 32; it += NTHREADS) {
        const int rl = it >> 5, row = row0 + rl;
        const bool hasp = row > seq0, hasn = row < seq0 + Lseq - 1;
        float zc[3][8];
#pragma unroll
        for (int part = 0; part < 3; ++part) {
            const int col = part * 256 + c; const bf16_t* zp = ZH + (size_t)row * 768 + col;
            const u32x4 zero = {0u, 0u, 0u, 0u};
            const u32x4 z1 = *(const u32x4*)zp; const u32x4 z0 = hasp ? *(const u32x4*)(zp - 768) : zero; const u32x4 z2 = hasn ? *(const u32x4*)(zp + 768) : zero;
            const unsigned a0[4] = {z0.x, z0.y, z0.z, z0.w}, a1[4] = {z1.x, z1.y, z1.z, z1.w}, a2[4] = {z2.x, z2.y, z2.z, z2.w};
#pragma unroll
            for (int j = 0; j < 4; ++j) {
                zc[part][2 * j] = bf_lo(a0[j]) * wt[part][0][2 * j] + bf_lo(a1[j]) * wt[part][1][2 * j] + bf_lo(a2[j]) * wt[part][2][2 * j] + wt[part][3][2 * j];
                zc[part][2 * j + 1] = bf_hi(a0[j]) * wt[part][0][2 * j + 1] + bf_hi(a1[j]) * wt[part][1][2 * j + 1] + bf_hi(a2[j]) * wt[part][2][2 * j + 1] + wt[part][3][2 * j + 1];
            }
        }
        u32x4 o; o.x = pk2(zc[0][0], zc[0][1]); o.y = pk2(zc[0][2], zc[0][3]); o.z = pk2(zc[0][4], zc[0][5]); o.w = pk2(zc[0][6], zc[0][7]);
        *(u32x4*)(X0 + (size_t)row * 256 + c) = o;
#pragma unroll
        for (int j = 0; j < 8; ++j) vt[(c + j) * 136 + rl] = (bf16_t)(pk2(zc[2][j] * zc[1][j], 0.f) & 0xffffu);
    }
    __syncthreads();
    const size_t cstride = lat ? (size_t)TL : (size_t)TC; bf16_t* vbase = lat ? VT + row0 : VT + (size_t)256 * TL + (row0 - TL);
    for (int it = F.tid; it < 256 * 16; it += NTHREADS) {
        const int c = it >> 4, ch = it & 15;
        const u32x4 v = *(const LAS u32x4*)(vt + c * 136 + ch * 8);
        *(u32x4*)(vbase + (size_t)c * cstride + ch * 8) = v;
    }
}

__device__ __forceinline__ void rope_unit(Frame& F, int blk, const float sgn = 1.0f) {
    bf16_t* Q = (bf16_t*)(F.ws + WS_Q); bf16_t* K = (bf16_t*)(F.ws + WS_K);
    const float* COS = (const float*)(F.ws + WS_ROPE); const float* SIN = COS + 65536;
    const int row0 = blk * 128;
    for (int it = F.tid; it < 128 * 16; it += NTHREADS) {
        const int rl = it >> 4, which = (it >> 3) & 1, hm = it & 7, row = row0 + rl, t = row & (SEQ - 1);
        bf16_t* p = (which ? K : Q) + (size_t)row * 512 + hm * 64;
#pragma unroll
        for (int ax = 0; ax < 2; ++ax) {
            u32x4 x1[2], x2[2];
            x1[0] = *(const u32x4*)(p + ax * 32); x1[1] = *(const u32x4*)(p + ax * 32 + 8); x2[0] = *(const u32x4*)(p + ax * 32 + 16); x2[1] = *(const u32x4*)(p + ax * 32 + 24);
            const float* cs = COS + t * 32 + ax * 16; const float* sn = SIN + t * 32 + ax * 16;
            u32x4 o1[2], o2[2];
#pragma unroll
            for (int hh = 0; hh < 2; ++hh) {
                const unsigned a[4] = {x1[hh].x, x1[hh].y, x1[hh].z, x1[hh].w}, b[4] = {x2[hh].x, x2[hh].y, x2[hh].z, x2[hh].w}; unsigned r1[4], r2[4];
#pragma unroll
                for (int j = 0; j < 4; ++j) { const int i0 = hh * 8 + 2 * j; const float c0 = cs[i0], s0 = sgn * sn[i0], c1 = cs[i0 + 1], s1 = sgn * sn[i0 + 1];
                    const float a0 = bf_lo(a[j]), a1 = bf_hi(a[j]), b0 = bf_lo(b[j]), b1 = bf_hi(b[j]);
                    r1[j] = pk2(a0 * c0 - b0 * s0, a1 * c1 - b1 * s1); r2[j] = pk2(b0 * c0 + a0 * s0, b1 * c1 + a1 * s1); }
                o1[hh] = (u32x4){r1[0], r1[1], r1[2], r1[3]}; o2[hh] = (u32x4){r2[0], r2[1], r2[2], r2[3]};
            }
            *(u32x4*)(p + ax * 32) = o1[0]; *(u32x4*)(p + ax * 32 + 8) = o1[1]; *(u32x4*)(p + ax * 32 + 16) = o2[0]; *(u32x4*)(p + ax * 32 + 24) = o2[1];
        }
    }
}

constexpr int VX_STRIDE = 4112, PKT_OFF = 32 * VX_STRIDE;
template <int NTW>
__device__ __forceinline__ void conv_unit(Frame& F, ArgsP a, int l, int c, const float* HFsrc, const bf16_t* VTc, bf16_t* YTc) {
    constexpr int Lseq = NTW * 256, NS = Lseq / 16;
    LAS unsigned char* lds = F.lds;
    LAS unsigned* pkt = (LAS unsigned*)(lds + PKT_OFF);
    __syncthreads();
    const float skip = a->in[I_HYSKIP][l * 256 + c];
    for (int m = F.tid; m < 2 * Lseq; m += NTHREADS) {
        float r[2];
#pragma unroll
        for (int k = 0; k < 2; ++k) { const int d = Lseq - (m + k); float v = 0.f;
            if (d >= 0 && d < Lseq) { v = HFsrc[(size_t)d * 512 + c]; if (d == 0) v += skip; }
            else if (d < 0 && d > -Lseq) v = HFsrc[(size_t)(-d) * 512 + 256 + c];
            r[k] = v; }
        pkt[m] = pk2(r[0], r[1]);
    }
    for (int it = F.tid; it < 32 * (Lseq / 8); it += NTHREADS) { const int b = it / (Lseq / 8), ch = it % (Lseq / 8);
        *(LAS u32x4*)(lds + b * VX_STRIDE + ch * 16) = *(const u32x4*)(VTc + (size_t)b * Lseq + ch * 8); }
    __syncthreads();
    const int i = F.lane & 31, h = F.lane >> 5, w = F.wave;
    f32x16 acc[NTW];
#pragma unroll
    for (int ti = 0; ti < NTW; ++ti) acc[ti] = (f32x16){0.f};
    const LAS unsigned char* bbase = lds + i * VX_STRIDE + h * 16;
    const int dlo = 2 * NTW * w - (NS - 1), dhi = 2 * (NTW * w + NTW - 1);
#define CV_LOAD(AF, BF, DL) do { const int ms_ = Lseq - 16 * (DL) - i + 8 * h; u32x4 af_; af_.x = pkt[ms_]; af_.y = pkt[ms_ + 2]; af_.z = pkt[ms_ + 4]; af_.w = pkt[ms_ + 6]; AF = __builtin_bit_cast(bf16x8, af_); \
        _Pragma("unroll") for (int ti = 0; ti < NTW; ++ti) { const int sj_ = 2 * (NTW * w + ti) - (DL), sjc_ = sj_ < 0 ? 0 : (sj_ >= NS ? NS - 1 : sj_); BF[ti] = *(const LAS bf16x8*)(bbase + sjc_ * 32); } } while (0)
#define CV_MMA(AF, BF, DL) do { _Pragma("unroll") for (int ti = 0; ti < NTW; ++ti) { const int sj_ = 2 * (NTW * w + ti) - (DL); \
        if (sj_ >= 0 && sj_ < NS) acc[ti] = __builtin_amdgcn_mfma_f32_32x32x16_bf16(AF, BF[ti], acc[ti], 0, 0, 0); } } while (0)
    bf16x8 A0, A1, B0[NTW], B1[NTW];
    CV_LOAD(A0, B0, dlo);
    for (int dl = dlo; dl <= dhi; dl += 2) {
        CV_LOAD(A1, B1, dl + 1);
        CV_MMA(A0, B0, dl);
        if (dl + 2 <= dhi) CV_LOAD(A0, B0, dl + 2);
        CV_MMA(A1, B1, dl + 1);
    }
#undef CV_LOAD
#undef CV_MMA
#pragma unroll
    for (int ti = 0; ti < NTW; ++ti)
#pragma unroll
        for (int g = 0; g < 4; ++g) { const int t = 32 * (NTW * w + ti) + 8 * g + 4 * h;
            u32x2 o; o.x = pk2(acc[ti][4 * g], acc[ti][4 * g + 1]); o.y = pk2(acc[ti][4 * g + 2], acc[ti][4 * g + 3]);
            *(u32x2*)(YTc + (size_t)i * Lseq + t) = o; }
}

template <int R>
__device__ __forceinline__ void ytrans_unit(Frame& F, int blk) {
    const bf16_t* YT = (const bf16_t*)(F.ws + WS_YT); const bf16_t* X0 = (const bf16_t*)(F.ws + WS_X0); bf16_t* YC = (bf16_t*)(F.ws + WS_YCAT);
    LAS bf16_t* tl = (LAS bf16_t*)F.lds;
    const int row0 = blk * R; const bool lat = row0 < TL;
    const size_t cstride = lat ? (size_t)TL : (size_t)TC; const bf16_t* ybase = lat ? YT + row0 : YT + (size_t)256 * TL + (row0 - TL);
    __syncthreads();
    for (int it = F.tid; it < 256 * (R / 8); it += NTHREADS) { const int c = it / (R / 8), ch = it % (R / 8);
        *(LAS u32x4*)(tl + c * (R + 8) + ch * 8) = *(const u32x4*)(ybase + (size_t)c * cstride + ch * 8); }
    __syncthreads();
    for (int it = F.tid; it < R * 32; it += NTHREADS) {
        const int cg = it / R, rl = it % R, row = row0 + rl, c = cg * 8;
        const u32x4 x = *(const u32x4*)(X0 + (size_t)row * 256 + c); const unsigned xs[4] = {x.x, x.y, x.z, x.w}; unsigned o[4];
#pragma unroll
        for (int j = 0; j < 4; ++j) o[j] = pk2(bf1(tl[(c + 2 * j) * (R + 8) + rl]) * bf_lo(xs[j]), bf1(tl[(c + 2 * j + 1) * (R + 8) + rl]) * bf_hi(xs[j]));
        *(u32x4*)(YC + (size_t)row * 1024 + 256 + c) = (u32x4){o[0], o[1], o[2], o[3]};
    }
}

namespace att {
#define KSWZ(row, colB) ((row) * 256 + ((colB) ^ (((row) & 7) << 4)))
__device__ __forceinline__ int crow(int r, int hi) { return (r & 3) + 8 * (r >> 2) + 4 * hi; }
__device__ __forceinline__ int v_st(int k, int c) { const int kk = (k & ~0xC) | ((k & 4) << 1) | ((k & 8) >> 1); return ((kk >> 3) * 4 + (c >> 5)) * 512 + ((kk & 7) * 32 + (c & 31)) * 2; }
__device__ __forceinline__ int v_rd_base(int lane) { return ((lane & 3) << 3) | (((lane >> 2) & 3) << 6) | (((lane >> 4) & 1) << 5) | (((lane >> 5) & 1) << 8); }
constexpr int v_rd_off(int d0, int ks, int half) { return d0 * 512 + ks * 4096 + half * 2048; }
template <int OFF> __device__ __forceinline__ s16x4 tr_read(int vb) {
    s16x4 r; asm volatile("ds_read_b64_tr_b16 %0, %1 offset:%2" : "=&v"(r) : "v"(vb), "i"(OFF) : "memory"); return r;
}
template <int D0> __device__ __forceinline__ void pv_one(f32x16& od, int vb, bf16x8 pa0, bf16x8 pa1, bf16x8 pa2, bf16x8 pa3) {
    const s16x4 l0 = tr_read<v_rd_off(D0, 0, 0)>(vb), h0 = tr_read<v_rd_off(D0, 0, 1)>(vb), l1 = tr_read<v_rd_off(D0, 1, 0)>(vb), h1 = tr_read<v_rd_off(D0, 1, 1)>(vb);
    const s16x4 l2 = tr_read<v_rd_off(D0, 2, 0)>(vb), h2 = tr_read<v_rd_off(D0, 2, 1)>(vb), l3 = tr_read<v_rd_off(D0, 3, 0)>(vb), h3 = tr_read<v_rd_off(D0, 3, 1)>(vb);
    asm volatile("s_waitcnt lgkmcnt(0)" ::: "memory"); __builtin_amdgcn_sched_barrier(0);
#define ATT_PK(L, H) (bf16x8){L[0], L[1], L[2], L[3], H[0], H[1], H[2], H[3]}
    od = __builtin_amdgcn_mfma_f32_32x32x16_bf16(pa0, ATT_PK(l0, h0), od, 0, 0, 0);
    od = __builtin_amdgcn_mfma_f32_32x32x16_bf16(pa1, ATT_PK(l1, h1), od, 0, 0, 0);
    od = __builtin_amdgcn_mfma_f32_32x32x16_bf16(pa2, ATT_PK(l2, h2), od, 0, 0, 0);
    od = __builtin_amdgcn_mfma_f32_32x32x16_bf16(pa3, ATT_PK(l3, h3), od, 0, 0, 0);
#undef ATT_PK
}
__device__ __forceinline__ void qkt2(f32x16& a0, f32x16& a1, f32x16& b0, f32x16& b1, const LAS char* Ks, const bf16x8 (&qr)[8], int r32, int hi) {
    a0 = (f32x16){0.f}; a1 = (f32x16){0.f}; b0 = (f32x16){0.f}; b1 = (f32x16){0.f};
#pragma unroll
    for (int d0 = 0; d0 < 4; ++d0) { const int cb = (d0 * 16 + hi * 8) * 2;
        const bf16x8 k0 = *(const LAS bf16x8*)(Ks + KSWZ(r32, cb)), k1 = *(const LAS bf16x8*)(Ks + KSWZ(32 + r32, cb));
        a0 = __builtin_amdgcn_mfma_f32_32x32x16_bf16(k0, qr[d0], a0, 0, 0, 0); a1 = __builtin_amdgcn_mfma_f32_32x32x16_bf16(k1, qr[d0], a1, 0, 0, 0); }
#pragma unroll
    for (int d0 = 4; d0 < 8; ++d0) { const int cb = (d0 * 16 + hi * 8) * 2;
        const bf16x8 k0 = *(const LAS bf16x8*)(Ks + KSWZ(r32, cb)), k1 = *(const LAS bf16x8*)(Ks + KSWZ(32 + r32, cb));
        b0 = __builtin_amdgcn_mfma_f32_32x32x16_bf16(k0, qr[d0], b0, 0, 0, 0); b1 = __builtin_amdgcn_mfma_f32_32x32x16_bf16(k1, qr[d0], b1, 0, 0, 0); }
}
__device__ __forceinline__ float xhalf_max(float v) { auto rr = __builtin_amdgcn_permlane32_swap(__float_as_uint(v), __float_as_uint(v), false, false); return fmaxf(__uint_as_float(rr[0]), __uint_as_float(rr[1])); }
__device__ __forceinline__ float xhalf_sum(float v) { auto rr = __builtin_amdgcn_permlane32_swap(__float_as_uint(v), __float_as_uint(v), false, false); return __uint_as_float(rr[0]) + __uint_as_float(rr[1]); }
constexpr float THR2 = 8.0f;
__device__ __forceinline__ void partialSM(f32x16& p0, f32x16& p1, float& m_reg, float& mn, float& alpha) {
    float pmax = p0[0];
#pragma unroll
    for (int r = 1; r < 16; ++r) pmax = fmaxf(pmax, p0[r]);
#pragma unroll
    for (int r = 0; r < 16; ++r) pmax = fmaxf(pmax, p1[r]);
    pmax = xhalf_max(pmax);
    if (__builtin_expect(__all(pmax - m_reg <= THR2), 1)) { mn = m_reg; alpha = 1.f; }
    else { mn = fmaxf(m_reg, pmax); alpha = fast_exp2(m_reg - mn); m_reg = mn; }
#pragma unroll
    for (int r = 0; r < 16; ++r) p0[r] -= mn;
#pragma unroll
    for (int r = 0; r < 16; ++r) p1[r] -= mn;
#pragma unroll
    for (int r = 0; r < 16; ++r) p0[r] = fast_exp2(p0[r]);
}
__device__ __forceinline__ void finishSM(f32x16& p0, f32x16& p1, float alpha, float& l_reg, bf16x8& pa0, bf16x8& pa1, bf16x8& pa2, bf16x8& pa3) {
#pragma unroll
    for (int r = 0; r < 16; ++r) p1[r] = fast_exp2(p1[r]);
    float ps = 0.f;
#pragma unroll
    for (int r = 0; r < 16; ++r) ps += p0[r];
#pragma unroll
    for (int r = 0; r < 16; ++r) ps += p1[r];
    ps = xhalf_sum(ps);
    l_reg = l_reg * alpha + ps;
#define ATT_PK4(P, BASE, OUT) do { unsigned x0_ = pk2(P[BASE + 0], P[BASE + 1]), x1_ = pk2(P[BASE + 2], P[BASE + 3]); \
        unsigned y0_ = pk2(P[BASE + 4], P[BASE + 5]), y1_ = pk2(P[BASE + 6], P[BASE + 7]); \
        auto r0_ = __builtin_amdgcn_permlane32_swap(x0_, y0_, false, false); auto r1_ = __builtin_amdgcn_permlane32_swap(x1_, y1_, false, false); \
        u32x4 w_ = {r0_[0], r1_[0], r0_[1], r1_[1]}; OUT = __builtin_bit_cast(bf16x8, w_); } while (0)
    ATT_PK4(p0, 0, pa0); ATT_PK4(p0, 8, pa1); ATT_PK4(p1, 0, pa2); ATT_PK4(p1, 8, pa3);
#undef ATT_PK4
}
__device__ __forceinline__ void qkt1(f32x16& p0, f32x16& p1, const LAS char* Ks, const bf16x8 (&qr)[4], int r32, int hi, int mcb) {
    p0 = (f32x16){0.f}; p1 = (f32x16){0.f};
#pragma unroll
    for (int d0 = 0; d0 < 4; ++d0) { const int cb = mcb + (d0 * 16 + hi * 8) * 2;
        const bf16x8 k0 = *(const LAS bf16x8*)(Ks + KSWZ(r32, cb)), k1 = *(const LAS bf16x8*)(Ks + KSWZ(32 + r32, cb));
        p0 = __builtin_amdgcn_mfma_f32_32x32x16_bf16(k0, qr[d0], p0, 0, 0, 0); p1 = __builtin_amdgcn_mfma_f32_32x32x16_bf16(k1, qr[d0], p1, 0, 0, 0); }
}
template <int KS> __device__ __forceinline__ void pv_step(f32x16 (&o)[4], int vb, bf16x8 pa) {
    const s16x4 l0 = tr_read<v_rd_off(0, KS, 0)>(vb), h0 = tr_read<v_rd_off(0, KS, 1)>(vb), l1 = tr_read<v_rd_off(1, KS, 0)>(vb), h1 = tr_read<v_rd_off(1, KS, 1)>(vb);
    const s16x4 l2 = tr_read<v_rd_off(2, KS, 0)>(vb), h2 = tr_read<v_rd_off(2, KS, 1)>(vb), l3 = tr_read<v_rd_off(3, KS, 0)>(vb), h3 = tr_read<v_rd_off(3, KS, 1)>(vb);
    asm volatile("s_waitcnt lgkmcnt(0)" ::: "memory"); __builtin_amdgcn_sched_barrier(0);
#define ATT_PK(L, H) (bf16x8){L[0], L[1], L[2], L[3], H[0], H[1], H[2], H[3]}
    o[0] = __builtin_amdgcn_mfma_f32_32x32x16_bf16(pa, ATT_PK(l0, h0), o[0], 0, 0, 0);
    o[1] = __builtin_amdgcn_mfma_f32_32x32x16_bf16(pa, ATT_PK(l1, h1), o[1], 0, 0, 0);
    o[2] = __builtin_amdgcn_mfma_f32_32x32x16_bf16(pa, ATT_PK(l2, h2), o[2], 0, 0, 0);
    o[3] = __builtin_amdgcn_mfma_f32_32x32x16_bf16(pa, ATT_PK(l3, h3), o[3], 0, 0, 0);
#undef ATT_PK
}
__device__ __forceinline__ void pv_d0(f32x16 (&o)[4], int vb, bf16x8 pa0, bf16x8 pa1, bf16x8 pa2, bf16x8 pa3) {
    pv_step<0>(o, vb, pa0); pv_step<1>(o, vb, pa1); pv_step<2>(o, vb, pa2); pv_step<3>(o, vb, pa3);
}
}

struct AttnUnit { int qrow0, h, klat0, nlat, kctx0, nt; };

constexpr int ATT_V = 0, ATT_K = 32768, ATT_WS = 65536, ATT_XCH = 65536 + 2048;
__device__ __forceinline__ void attn_unit(Frame& F, ArgsP a, int l, const AttnUnit& U, float lam, float lam_init) {
    using namespace att;
    const bf16_t* Qg = (const bf16_t*)(F.ws + WS_Q); const bf16_t* Kg = (const bf16_t*)(F.ws + WS_K); const bf16_t* Vg = (const bf16_t*)(F.ws + WS_V);
    bf16_t* YC = (bf16_t*)(F.ws + WS_YCAT);
    const int tid = F.tid, wid = F.wave, lane = F.lane, r32 = lane & 31, hi = lane >> 5, mp = wid >> 2, wq = wid & 3, mcb = mp * 128;
    LAS char* V_lds = (LAS char*)F.lds + ATT_V; LAS char* K_lds = (LAS char*)F.lds + ATT_K;
    LAS float* wsf = (LAS float*)(F.lds + ATT_WS) + wid * 64; LAS float* li_l = wsf; LAS float* al_l = wsf + 32;
    float m_reg = -1e30f, l_reg = 0.f; f32x16 o[4];
#pragma unroll
    for (int d = 0; d < 4; ++d) o[d] = (f32x16){0.f};
    bf16x8 qr[4];
    { const bf16_t* Qw = Qg + (size_t)(U.qrow0 + wq * 32 + r32) * 512 + U.h * 128 + mp * 64 + hi * 8;
#pragma unroll
      for (int d0 = 0; d0 < 4; ++d0) qr[d0] = *(const bf16x8*)(Qw + d0 * 16); }
    const int sr = tid >> 4, sc = (tid & 15) * 8;
    const int kst0 = KSWZ(sr, sc * 2), kst1 = KSWZ(32 + sr, sc * 2), vst0 = v_st(sr, sc), vst1 = v_st(32 + sr, sc);
    const int hoff = U.h * 128 + sc;
    const int vb0 = (int)(uintptr_t)V_lds + v_rd_base(lane);
#define KROW(j) ((j) < U.nlat ? U.klat0 + 64 * (j) : U.kctx0 + 64 * ((j) - U.nlat))
    bf16x8 s0v0, s0v1, s0k0, s0k1, s1v0, s1v1, s1k0, s1k1;
#define SLOAD0(j) do { const int kr_ = KROW(j); const size_t g0_ = (size_t)(kr_ + sr) * 512 + hoff, g1_ = (size_t)(kr_ + 32 + sr) * 512 + hoff; \
        s0v0 = *(const bf16x8*)(Vg + g0_); s0v1 = *(const bf16x8*)(Vg + g1_); s0k0 = *(const bf16x8*)(Kg + g0_); s0k1 = *(const bf16x8*)(Kg + g1_); } while (0)
#define SLOAD1(j) do { const int kr_ = KROW(j); const size_t g0_ = (size_t)(kr_ + sr) * 512 + hoff, g1_ = (size_t)(kr_ + 32 + sr) * 512 + hoff; \
        s1v0 = *(const bf16x8*)(Vg + g0_); s1v1 = *(const bf16x8*)(Vg + g1_); s1k0 = *(const bf16x8*)(Kg + g0_); s1k1 = *(const bf16x8*)(Kg + g1_); } while (0)
#define SWRITE0(b) do { *(LAS bf16x8*)(V_lds + (b) * 16384 + vst0) = s0v0; *(LAS bf16x8*)(V_lds + (b) * 16384 + vst1) = s0v1; \
        *(LAS bf16x8*)(K_lds + (b) * 16384 + kst0) = s0k0; *(LAS bf16x8*)(K_lds + (b) * 16384 + kst1) = s0k1; } while (0)
#define SWRITE1(b) do { *(LAS bf16x8*)(V_lds + (b) * 16384 + vst0) = s1v0; *(LAS bf16x8*)(V_lds + (b) * 16384 + vst1) = s1v1; \
        *(LAS bf16x8*)(K_lds + (b) * 16384 + kst0) = s1k0; *(LAS bf16x8*)(K_lds + (b) * 16384 + kst1) = s1k1; } while (0)
#define SWAIT() asm volatile("s_waitcnt vmcnt(4)" ::: "memory")
#define SBAR() __builtin_amdgcn_sched_barrier(0)
#define LBAR() do { asm volatile("s_waitcnt lgkmcnt(0)" ::: "memory"); __builtin_amdgcn_s_barrier(); asm volatile("" ::: "memory"); } while (0)
#define RESC(av) do { if (__any((av) < 1.f)) { if (hi == 0) al_l[r32] = (av); asm volatile("s_waitcnt lgkmcnt(0)" ::: "memory"); \
        _Pragma("unroll") for (int d_ = 0; d_ < 4; ++d_) _Pragma("unroll") for (int r_ = 0; r_ < 16; ++r_) o[d_][r_] *= al_l[crow(r_, hi)]; } } while (0)
    f32x16 pA0, pA1, pB0, pB1; float mnA, mnB, alA, alB; bf16x8 pa0, pa1, pa2, pa3; const int NT = U.nt;
    __syncthreads();
    SLOAD0(0); asm volatile("s_waitcnt vmcnt(0)" ::: "memory"); SWRITE0(0); __syncthreads();
    qkt1(pA0, pA1, K_lds, qr, r32, hi, mcb); partialSM(pA0, pA1, m_reg, mnA, alA);
    SLOAD1(1); if (2 < NT) SLOAD0(2);
    SWAIT(); SWRITE1(1); __syncthreads();
    for (int j = 1; j + 1 < NT; j += 2) {
        SBAR(); qkt1(pB0, pB1, K_lds + 16384, qr, r32, hi, mcb);
        finishSM(pA0, pA1, alA, l_reg, pa0, pa1, pa2, pa3); SBAR();
        SLOAD1(j + 2); SBAR();
        pv_d0(o, vb0, pa0, pa1, pa2, pa3); partialSM(pB0, pB1, m_reg, mnB, alB);
        __syncthreads(); SWAIT(); SWRITE0(0);
        RESC(alB); __syncthreads();
        SBAR(); qkt1(pA0, pA1, K_lds, qr, r32, hi, mcb);
        finishSM(pB0, pB1, alB, l_reg, pa0, pa1, pa2, pa3); SBAR();
        if (j + 3 < NT) SLOAD0(j + 3);
        SBAR();
        pv_d0(o, vb0 + 16384, pa0, pa1, pa2, pa3); partialSM(pA0, pA1, m_reg, mnA, alA);
        __syncthreads(); SWAIT(); SWRITE1(1);
        RESC(alA); __syncthreads();
    }
    SBAR(); qkt1(pB0, pB1, K_lds + 16384, qr, r32, hi, mcb);
    finishSM(pA0, pA1, alA, l_reg, pa0, pa1, pa2, pa3); SBAR();
    pv_d0(o, vb0, pa0, pa1, pa2, pa3); partialSM(pB0, pB1, m_reg, mnB, alB);
    __syncthreads(); RESC(alB);
    finishSM(pB0, pB1, alB, l_reg, pa0, pa1, pa2, pa3); SBAR();
    pv_d0(o, vb0 + 16384, pa0, pa1, pa2, pa3);
#undef KROW
#undef SLOAD0
#undef SLOAD1
#undef SWRITE0
#undef SWRITE1
#undef SWAIT
#undef SBAR
#undef LBAR
#undef RESC
    if (hi == 0) li_l[r32] = l_reg;
    asm volatile("s_waitcnt lgkmcnt(0)" ::: "memory");
    const float fac = mp ? lam : 1.0f;
    float rli[16];
#pragma unroll
    for (int r = 0; r < 16; ++r) rli[r] = fac * fast_rcp(li_l[crow(r, hi)]);
    LAS float* xch = (LAS float*)(F.lds + ATT_XCH) + wq * 4096;
    if (mp == 1) {
#pragma unroll
        for (int r = 0; r < 16; ++r)
#pragma unroll
            for (int d = 0; d < 4; ++d) xch[crow(r, hi) * 128 + 32 * d + r32] = o[d][r] * rli[r];
    }
    __syncthreads();
    if (mp == 0) {
        const float* gn = a->in[I_DANG] + l * 128;
        float gv[4];
#pragma unroll
        for (int d = 0; d < 4; ++d) gv[d] = gn[32 * d + r32] * (1.0f - lam_init);
#pragma unroll
        for (int r = 0; r < 16; ++r) {
            float ov[4];
#pragma unroll
            for (int d = 0; d < 4; ++d) ov[d] = o[d][r] * rli[r] - xch[crow(r, hi) * 128 + 32 * d + r32];
            float ss = (ov[0] * ov[0] + ov[1] * ov[1]) + (ov[2] * ov[2] + ov[3] * ov[3]);
#pragma unroll
            for (int x = 1; x < 32; x <<= 1) ss += __shfl_xor(ss, x);
            const float inv = 1.0f / sqrtf(ss * (1.0f / 128.0f) + LN_EPS);
            bf16_t* yrow = YC + (size_t)(U.qrow0 + wq * 32 + crow(r, hi)) * 1024 + 512 + U.h * 128 + r32;
#pragma unroll
            for (int d = 0; d < 4; ++d) yrow[32 * d] = (bf16_t)(pk2(ov[d] * inv * gv[d], 0.f) & 0xffffu);
        }
    }
}
namespace att {
__device__ __forceinline__ void stats(const f32x16& x0, const f32x16& x1, float& m, float& l) {
    float t = x0[0];
#pragma unroll
    for (int r = 1; r < 16; ++r) t = fmaxf(t, x0[r]);
#pragma unroll
    for (int r = 0; r < 16; ++r) t = fmaxf(t, x1[r]);
    t = xhalf_max(t);
    const float mn = fmaxf(m, t);
    float s = 0.f;
#pragma unroll
    for (int r = 0; r < 16; ++r) s += fast_exp2(x0[r] - mn);
#pragma unroll
    for (int r = 0; r < 16; ++r) s += fast_exp2(x1[r] - mn);
    s = xhalf_sum(s);
    l = l * fast_exp2(m - mn) + s; m = mn;
}
}

__device__ __forceinline__ void attn_unit_v1(Frame& F, ArgsP a, int l, const AttnUnit& U, float lam, float lam_init) {
    using namespace att;
    const bf16_t* Qg = (const bf16_t*)(F.ws + WS_Q); const bf16_t* Kg = (const bf16_t*)(F.ws + WS_K); const bf16_t* Vg = (const bf16_t*)(F.ws + WS_V);
    bf16_t* YC = (bf16_t*)(F.ws + WS_YCAT);
    const int tid = F.tid, wid = F.wave, lane = F.lane, r32 = lane & 31, hi = lane >> 5;
    LAS char* K_lds = (LAS char*)F.lds; LAS char* V_lds = (LAS char*)F.lds + 32768;
    bf16x8 qr[8];
    { const bf16_t* Qw = Qg + (size_t)(U.qrow0 + wid * 32 + r32) * 512 + U.h * 128 + hi * 8;
#pragma unroll
      for (int d0 = 0; d0 < 8; ++d0) qr[d0] = *(const bf16x8*)(Qw + d0 * 16); }
    const int sr = tid >> 4, sc = (tid & 15) * 8;
    const int kst0 = KSWZ(sr, sc * 2), kst1 = KSWZ(32 + sr, sc * 2), vst0 = v_st(sr, sc), vst1 = v_st(32 + sr, sc);
    const int hoff = U.h * 128 + sc;
#define KROW(j) ((j) < U.nlat ? U.klat0 + 64 * (j) : U.kctx0 + 64 * ((j) - U.nlat))
    float m0 = -1e30f, l0 = 0.f, m1 = -1e30f, l1 = 0.f;
    bf16x8 ks0, ks1, vs0, vs1;
    __syncthreads();
    { const int kr = KROW(0); ks0 = *(const bf16x8*)(Kg + (size_t)(kr + sr) * 512 + hoff); ks1 = *(const bf16x8*)(Kg + (size_t)(kr + 32 + sr) * 512 + hoff); }
    *(LAS bf16x8*)(K_lds + kst0) = ks0; *(LAS bf16x8*)(K_lds + kst1) = ks1;
    __syncthreads();
    for (int j = 0; j < U.nt; ++j) {
        const bool more = j + 1 < U.nt;
        if (more) { const int kr = KROW(j + 1); ks0 = *(const bf16x8*)(Kg + (size_t)(kr + sr) * 512 + hoff); ks1 = *(const bf16x8*)(Kg + (size_t)(kr + 32 + sr) * 512 + hoff); }
        f32x16 a0, a1, b0, b1;
        qkt2(a0, a1, b0, b1, K_lds + (j & 1) * 16384, qr, r32, hi);
        stats(a0, a1, m0, l0); stats(b0, b1, m1, l1);
        if (more) { LAS char* kb = K_lds + ((j + 1) & 1) * 16384; *(LAS bf16x8*)(kb + kst0) = ks0; *(LAS bf16x8*)(kb + kst1) = ks1; }
        __syncthreads();
    }
    const float c0 = 1.0f / l0, c1 = lam / l1;
    f32x16 o[4];
#pragma unroll
    for (int d = 0; d < 4; ++d) o[d] = (f32x16){0.f};
    const int vb0 = (int)(uintptr_t)V_lds + v_rd_base(lane);
    { const int kr = KROW(0); const size_t g0 = (size_t)(kr + sr) * 512 + hoff, g1 = (size_t)(kr + 32 + sr) * 512 + hoff;
      ks0 = *(const bf16x8*)(Kg + g0); ks1 = *(const bf16x8*)(Kg + g1); vs0 = *(const bf16x8*)(Vg + g0); vs1 = *(const bf16x8*)(Vg + g1); }
    *(LAS bf16x8*)(K_lds + kst0) = ks0; *(LAS bf16x8*)(K_lds + kst1) = ks1; *(LAS bf16x8*)(V_lds + vst0) = vs0; *(LAS bf16x8*)(V_lds + vst1) = vs1;
    __syncthreads();
    for (int j = 0; j < U.nt; ++j) {
        const bool more = j + 1 < U.nt;
        if (more) { const int kr = KROW(j + 1); const size_t g0 = (size_t)(kr + sr) * 512 + hoff, g1 = (size_t)(kr + 32 + sr) * 512 + hoff;
            ks0 = *(const bf16x8*)(Kg + g0); ks1 = *(const bf16x8*)(Kg + g1); vs0 = *(const bf16x8*)(Vg + g0); vs1 = *(const bf16x8*)(Vg + g1); }
        f32x16 a0, a1, b0, b1;
        qkt2(a0, a1, b0, b1, K_lds + (j & 1) * 16384, qr, r32, hi);
#pragma unroll
        for (int r = 0; r < 16; ++r) { a0[r] = fast_exp2(a0[r] - m0) * c0 - fast_exp2(b0[r] - m1) * c1; a1[r] = fast_exp2(a1[r] - m0) * c0 - fast_exp2(b1[r] - m1) * c1; }
        bf16x8 pa0, pa1, pa2, pa3;
#define ATT_PK4(P, BASE, OUT) do { unsigned x0_ = pk2(P[BASE + 0], P[BASE + 1]), x1_ = pk2(P[BASE + 2], P[BASE + 3]); \
            unsigned y0_ = pk2(P[BASE + 4], P[BASE + 5]), y1_ = pk2(P[BASE + 6], P[BASE + 7]); \
            auto r0_ = __builtin_amdgcn_permlane32_swap(x0_, y0_, false, false); auto r1_ = __builtin_amdgcn_permlane32_swap(x1_, y1_, false, false); \
            u32x4 w_ = {r0_[0], r1_[0], r0_[1], r1_[1]}; OUT = __builtin_bit_cast(bf16x8, w_); } while (0)
        ATT_PK4(a0, 0, pa0); ATT_PK4(a0, 8, pa1); ATT_PK4(a1, 0, pa2); ATT_PK4(a1, 8, pa3);
#undef ATT_PK4
        const int vb = vb0 + (j & 1) * 16384;
        pv_one<0>(o[0], vb, pa0, pa1, pa2, pa3); pv_one<1>(o[1], vb, pa0, pa1, pa2, pa3); pv_one<2>(o[2], vb, pa0, pa1, pa2, pa3); pv_one<3>(o[3], vb, pa0, pa1, pa2, pa3);
        if (more) { LAS char* kb = K_lds + ((j + 1) & 1) * 16384; LAS char* vbuf = V_lds + ((j + 1) & 1) * 16384;
            *(LAS bf16x8*)(kb + kst0) = ks0; *(LAS bf16x8*)(kb + kst1) = ks1; *(LAS bf16x8*)(vbuf + vst0) = vs0; *(LAS bf16x8*)(vbuf + vst1) = vs1; }
        __syncthreads();
    }
#undef KROW
    const float* gn = a->in[I_DANG] + l * 128;
    float gv[4];
#pragma unroll
    for (int d = 0; d < 4; ++d) gv[d] = gn[32 * d + r32] * (1.0f - lam_init);
#pragma unroll
    for (int r = 0; r < 16; ++r) {
        float ss = (o[0][r] * o[0][r] + o[1][r] * o[1][r]) + (o[2][r] * o[2][r] + o[3][r] * o[3][r]);
#pragma unroll
        for (int x = 1; x < 32; x <<= 1) ss += __shfl_xor(ss, x);
        const float inv = 1.0f / sqrtf(ss * (1.0f / 128.0f) + LN_EPS);
        bf16_t* yrow = YC + (size_t)(U.qrow0 + wid * 32 + crow(r, hi)) * 1024 + 512 + U.h * 128 + r32;
#pragma unroll
        for (int d = 0; d < 4; ++d) yrow[32 * d] = (bf16_t)(pk2(o[d][r] * inv * gv[d], 0.f) & 0xffffu);
    }
}


struct SchedMerge {
    int G, c, nM; const char *HB, *YCAT, *WinT, *PT;
    __device__ __forceinline__ bool next(int i, pg8::GU& u) const {
        const int tile = i / 6, sub = i - tile * 6, L = tile * G + c; if (L >= nM * 4) return false;
        int pm, pn; pg8::grid_order(L, nM, 4, pm, pn);
        const int br = sub >> 1;
        if (sub & 1) { u.A = HB + (size_t)pm * 256 * 2048; u.B = WinT + (size_t)(OFF_GATE + br * 1024 + pn * 256) * 2048; u.K = 1024; }
        else { u.A = YCAT + (size_t)pm * 256 * 2048 + (br == 0 ? 0 : (br == 1 ? 512 : 1024)); u.B = PT + (size_t)br * 1024 * 2048 + (size_t)pn * 256 * 2048; u.K = (br == 2) ? 512 : 256; }
        u.gl = nullptr; u.kind = sub; u.pm = pm; u.pn = pn; u.e = 0; u.nvalid = 256;
        return true;
    }
};
struct EpiMerge { static constexpr bool ALIGN = MK_ALIGN_EPIMERGE;
    bf16_t* MERGED; bf16_t* PSCR;
    __device__ __forceinline__ void operator()(const f32x4 (&acc)[2][2][4][2], const pg8::GU& u, int wr, int wc, int fr, int fq) const {
        const int sub = u.kind;
        int ln_; asm volatile("v_mbcnt_lo_u32_b32 %0, -1, 0\n\tv_mbcnt_hi_u32_b32 %0, -1, %0" : "=v"(ln_));
        const int rq = wr * 64 + (ln_ & 15), cq = wc * 32 + 8 * (ln_ >> 4);
        const int row0 = u.pm * 256 + rq, col0 = u.pn * 256 + cq;
        const unsigned psoff = (unsigned)(((((rq >> 6) * 4 + (cq >> 5)) * 64 + ((cq >> 3) & 3) * 16 + (rq & 63)) * 16));
#pragma unroll
        for (int ai = 0; ai < 2; ++ai)
#pragma unroll
            for (int m = 0; m < 4; ++m)
#pragma unroll
                for (int bj = 0; bj < 2; ++bj) {
                    const int chunk = (ai * 4 + m) * 2 + bj; const f32x4 v0 = acc[ai][bj][m][0], v1 = acc[ai][bj][m][1];
                    unsigned po = psoff; asm volatile("" : "+v"(po)); po += chunk * 8192; u32x4* ps = (u32x4*)((char*)PSCR + po);
                    if ((sub & 1) == 0) { u32x4 w; w.x = pk2(v0[0], v0[1]); w.y = pk2(v0[2], v0[3]); w.z = pk2(v1[0], v1[1]); w.w = pk2(v1[2], v1[3]); *ps = w; }
                    else {
                        const u32x4 p = *ps; unsigned mo = (unsigned)((row0 * 1024 + col0) * 2); asm volatile("" : "+v"(mo)); mo += (unsigned)(((ai * 128 + m * 16) * 1024 + bj * 128) * 2); u32x4* mp = (u32x4*)((char*)MERGED + mo);
                        float r[8] = {sigmoidf_(v0[0]) * bf_lo(p.x), sigmoidf_(v0[1]) * bf_hi(p.x), sigmoidf_(v0[2]) * bf_lo(p.y), sigmoidf_(v0[3]) * bf_hi(p.y),
                                      sigmoidf_(v1[0]) * bf_lo(p.z), sigmoidf_(v1[1]) * bf_hi(p.z), sigmoidf_(v1[2]) * bf_lo(p.w), sigmoidf_(v1[3]) * bf_hi(p.w)};
                        if (sub != 1) { const u32x4 o = *mp; r[0] += bf_lo(o.x); r[1] += bf_hi(o.x); r[2] += bf_lo(o.y); r[3] += bf_hi(o.y); r[4] += bf_lo(o.z); r[5] += bf_hi(o.z); r[6] += bf_lo(o.w); r[7] += bf_hi(o.w); }
                        u32x4 w; w.x = pk2(r[0], r[1]); w.y = pk2(r[2], r[3]); w.z = pk2(r[4], r[5]); w.w = pk2(r[6], r[7]); *mp = w;
                    }

                }
    }
};

struct SchedGrid {
    int G, c, nM, nN, K; const char *A, *B; size_t astep, bstep;
    __device__ __forceinline__ bool next(int i, pg8::GU& u) const {
        const int L = i * G + c; if (L >= nM * nN) return false;
        int pm, pn; pg8::grid_order(L, nM, nN, pm, pn);
        u.A = A + (size_t)pm * astep; u.B = B + (size_t)pn * bstep; u.gl = nullptr; u.K = K; u.kind = 0; u.pm = pm; u.pn = pn; u.e = 0; u.nvalid = 256;
        return true;
    }
};
struct EpiOut { static constexpr bool ALIGN = MK_ALIGN_EPIOUT;
    const float* xf; const float* ctxf; const bf16_t* xb; const float* mod; bf16_t* R1;
    __device__ __forceinline__ void operator()(const f32x4 (&acc)[2][2][4][2], const pg8::GU& u, int wr, int wc, int fr, int fq) const {
        const int rowt = u.pm * 256, col0 = u.pn * 256 + wc * 32 + 8 * fq;
        const float* g1 = mod + (size_t)mod_row(rowt) * 6144 + 2048 + col0;
        f32x4 gv[2][2];
#pragma unroll
        for (int bj = 0; bj < 2; ++bj) { gv[bj][0] = *(const f32x4*)(g1 + bj * 128); gv[bj][1] = *(const f32x4*)(g1 + bj * 128 + 4); }
#pragma unroll
        for (int ai = 0; ai < 2; ++ai)
#pragma unroll
            for (int m = 0; m < 4; ++m) { const int row = rowt + wr * 64 + fr + ai * 128 + m * 16;
#pragma unroll
                for (int bj = 0; bj < 2; ++bj) { const int col = col0 + bj * 128; f32x4 x0, x1;
                    if (xb) { const u32x4 w = *(const u32x4*)(xb + (size_t)row * 1024 + col); x0 = (f32x4){bf_lo(w.x), bf_hi(w.x), bf_lo(w.y), bf_hi(w.y)}; x1 = (f32x4){bf_lo(w.z), bf_hi(w.z), bf_lo(w.w), bf_hi(w.w)}; }
                    else { const float* xp = (row < TL) ? xf + (size_t)row * 1024 + col : ctxf + (size_t)(row - TL) * 1024 + col; x0 = *(const f32x4*)xp; x1 = *(const f32x4*)(xp + 4); }
                    const f32x4 r0 = x0 * DN_ALPHA + gv[bj][0] * acc[ai][bj][m][0], r1 = x1 * DN_ALPHA + gv[bj][1] * acc[ai][bj][m][1];
                    u32x4 w; w.x = pk2(r0[0], r0[1]); w.y = pk2(r0[2], r0[3]); w.z = pk2(r1[0], r1[1]); w.w = pk2(r1[2], r1[3]);
                    *(u32x4*)(R1 + (size_t)row * 1024 + col) = w; } }
    }
};

__device__ __forceinline__ void expert_weights_fp8(Frame& F, ArgsP a, int l, int first, int last, int widx, int nw) {
    unsigned char* W1T = F.ws + WS_EW1; unsigned char* W2T = F.ws + WS_EW2;
    LAS float* scr = (LAS float*)(F.lds + F.wave * 8448);
    __syncthreads();
    for (int it2 = first + widx; it2 < last; it2 += nw) {
        const int it = 2 * it2, e = it / 768; int r = it - e * 768; const size_t le = (size_t)l * 32 + e;
        if (r < 256) { tr_item2<1, true>(a->in[I_EXG] + le * 1024 * 512, 512, (bf16_t*)(W1T + (size_t)e * 1024 * 1024), 1024, scr, r, F.lane); continue; } r -= 256;
        if (r < 256) { tr_item2<2, true>(a->in[I_EXU] + le * 1024 * 512, 512, (bf16_t*)(W1T + (size_t)e * 1024 * 1024), 1024, scr, r, F.lane); continue; } r -= 256;
        tr_item2<0, true>(a->in[I_EXD] + le * 512 * 1024, 1024, (bf16_t*)(W2T + (size_t)e * 1024 * 512), 512, scr, r, F.lane);
    }
    __syncthreads();
}
constexpr int WR_STRIDE = 2064;
constexpr int WR_BYTES = 48 * WR_STRIDE, LG_STRIDE = 52;
__device__ __forceinline__ void phase_ln1_router(Frame& F, ArgsP a, int l, int nrows, const int mode, const int cfirst = 0) {
    if (mode & 1) expert_weights_fp8(F, a, l, cfirst, 32 * 384, F.gw, F.NGW);
    if (!(mode & 10)) return;
    if (mode & 8) {
        const float* we = a->in[I_MOEWE] + (size_t)l * 32768; const float* wg = a->in[I_MOEWG] + (size_t)l * 4096;
        f32x4 t[16], tg[2];
#pragma unroll
        for (int i = 0; i < 16; ++i) t[i] = *(const f32x4*)(we + (size_t)(i * NTHREADS + F.tid) * 4);
#pragma unroll
        for (int i = 0; i < 2; ++i) tg[i] = *(const f32x4*)(wg + (size_t)(i * NTHREADS + F.tid) * 4);
#pragma unroll
        for (int i = 0; i < 3; ++i) { const int ch = i * NTHREADS + F.tid; *(LAS u32x4*)(F.lds + (36 + (ch >> 7)) * WR_STRIDE + (ch & 127) * 16) = (u32x4){0u, 0u, 0u, 0u}; }
#pragma unroll
        for (int i = 0; i < 16; ++i) { const int idx = i * NTHREADS + F.tid, k = idx >> 3, j = idx & 7;
#pragma unroll
            for (int c = 0; c < 4; ++c) *(LAS bf16_t*)(F.lds + (4 + 4 * j + c) * WR_STRIDE + k * 2) = (bf16_t)(pk2(t[i][c], 0.f) & 0xffffu); }
#pragma unroll
        for (int i = 0; i < 2; ++i) { const int k = i * NTHREADS + F.tid;
#pragma unroll
            for (int c = 0; c < 4; ++c) *(LAS bf16_t*)(F.lds + c * WR_STRIDE + k * 2) = (bf16_t)(pk2(tg[i][c], 0.f) & 0xffffu); }
    }
    __syncthreads();
    const float* mod = (const float*)(F.ws + WS_MOD) + (size_t)l * 33 * 6144;
    const bf16_t* R1 = (const bf16_t*)(F.ws + WS_R1); bf16_t* X = (bf16_t*)(F.ws + WS_X); bf16_t* HB = (bf16_t*)(F.ws + WS_HB);
    int* LIST = (int*)(F.ws + WS_LIST); float* WT = (float*)(F.ws + WS_WTS);
    unsigned* cnt = F.ctl + CW_CNT + l * 32 * 64;
    const int lane = F.lane;
    LAS float* LG = (LAS float*)(F.lds + WR_BYTES + F.wave * (16 * LG_STRIDE * 4));
    float g[16], bb[16];
#pragma unroll
    for (int hh = 0; hh < 2; ++hh) { const int c = hh * 512 + 8 * lane;
        const f32x4 g0 = *(const f32x4*)(a->in[I_LN1G] + l * 1024 + c), g1 = *(const f32x4*)(a->in[I_LN1G] + l * 1024 + c + 4), b0 = *(const f32x4*)(a->in[I_LN1B] + l * 1024 + c), b1 = *(const f32x4*)(a->in[I_LN1B] + l * 1024 + c + 4);
#pragma unroll
        for (int j = 0; j < 4; ++j) { g[hh * 8 + j] = g0[j]; g[hh * 8 + 4 + j] = g1[j]; bb[hh * 8 + j] = b0[j]; bb[hh * 8 + 4 + j] = b1[j]; } }
    for (int grp = F.gw; grp < nrows / 16; grp += F.NGW) {
        const int r0 = grp * 16;
        const float* mrow = mod + (size_t)mod_row(r0) * 6144;
        if (mode & 2) {
        u32x4 nw[4][2];
#pragma unroll
        for (int q = 0; q < 4; ++q)
#pragma unroll
            for (int hh = 0; hh < 2; ++hh) nw[q][hh] = *(const u32x4*)(R1 + (size_t)(r0 + q) * 1024 + hh * 512 + 8 * lane);
#pragma unroll 1
        for (int rr = 0; rr < 16; rr += 4) {
            float v[4][16];
#pragma unroll
            for (int q = 0; q < 4; ++q)
#pragma unroll
                for (int hh = 0; hh < 2; ++hh) { const u32x4 w = nw[q][hh];
                    v[q][hh * 8 + 0] = bf_lo(w.x); v[q][hh * 8 + 1] = bf_hi(w.x); v[q][hh * 8 + 2] = bf_lo(w.y); v[q][hh * 8 + 3] = bf_hi(w.y); v[q][hh * 8 + 4] = bf_lo(w.z); v[q][hh * 8 + 5] = bf_hi(w.z); v[q][hh * 8 + 6] = bf_lo(w.w); v[q][hh * 8 + 7] = bf_hi(w.w); }
            if (rr + 4 < 16) {
#pragma unroll
                for (int q = 0; q < 4; ++q)
#pragma unroll
                    for (int hh = 0; hh < 2; ++hh) nw[q][hh] = *(const u32x4*)(R1 + (size_t)(r0 + rr + 4 + q) * 1024 + hh * 512 + 8 * lane); }
            float s[4], mean[4], qq[4], rstd[4];
#pragma unroll
            for (int q = 0; q < 4; ++q) { s[q] = 0.f;
#pragma unroll
                for (int j = 0; j < 16; ++j) s[q] += v[q][j]; }
#pragma unroll
            for (int o = 1; o < 64; o <<= 1)
#pragma unroll
                for (int q = 0; q < 4; ++q) s[q] += __shfl_xor(s[q], o);
#pragma unroll
            for (int q = 0; q < 4; ++q) { mean[q] = s[q] * (1.f / 1024.f); qq[q] = 0.f;
#pragma unroll
                for (int j = 0; j < 16; ++j) { v[q][j] -= mean[q]; qq[q] += v[q][j] * v[q][j]; } }
#pragma unroll
            for (int o = 1; o < 64; o <<= 1)
#pragma unroll
                for (int q = 0; q < 4; ++q) qq[q] += __shfl_xor(qq[q], o);
#pragma unroll
            for (int q = 0; q < 4; ++q) rstd[q] = 1.0f / sqrtf(qq[q] * (1.f / 1024.f) + LN_EPS);
#pragma unroll
            for (int hh = 0; hh < 2; ++hh) { const int c = hh * 512 + 8 * lane;
                const f32x4 sh0 = *(const f32x4*)(mrow + 3072 + c), sh1 = *(const f32x4*)(mrow + 3072 + c + 4), sc0 = *(const f32x4*)(mrow + 4096 + c), sc1 = *(const f32x4*)(mrow + 4096 + c + 4);
#pragma unroll
                for (int q = 0; q < 4; ++q) { const int row = r0 + rr + q;
                    float x1[8], h2[8];
#pragma unroll
                    for (int j = 0; j < 8; ++j) { x1[j] = v[q][hh * 8 + j] * rstd[q] * g[hh * 8 + j] + bb[hh * 8 + j]; const float shv = j < 4 ? sh0[j] : sh1[j - 4], scv = j < 4 ? sc0[j] : sc1[j - 4]; h2[j] = x1[j] * (1.f + scv) + shv; }
                    u32x4 w; w.x = pk2(x1[0], x1[1]); w.y = pk2(x1[2], x1[3]); w.z = pk2(x1[4], x1[5]); w.w = pk2(x1[6], x1[7]);
                    *(u32x4*)(X + (size_t)row * 1024 + c) = w;
                    u32x4 hw; hw.x = pk2(h2[0], h2[1]); hw.y = pk2(h2[2], h2[3]); hw.z = pk2(h2[4], h2[5]); hw.w = pk2(h2[6], h2[7]);
                    *(u32x4*)(HB + (size_t)row * 1024 + c) = hw;
                    *(u32x2*)(F.ws + WS_HB8 + (size_t)row * 1024 + c) = (u32x2){pk4_fp8(h2[0], h2[1], h2[2], h2[3]), pk4_fp8(h2[4], h2[5], h2[6], h2[7])}; } }
        }
        }
    }
    if (mode & 8) {
    const int ngrp = nrows / 16;
    const LAS unsigned char* wrow = F.lds + (lane & 15) * WR_STRIDE + 16 * (lane >> 4);
    bf16x8 av[32];
    { const bf16_t* hrow = HB + (size_t)((F.gw < ngrp ? F.gw : 0) * 16 + (lane & 15)) * 1024 + 8 * (lane >> 4);
#pragma unroll
      for (int ks = 0; ks < 32; ++ks) av[ks] = *(const bf16x8*)(hrow + 32 * ks); }
    for (int grp = F.gw; grp < ngrp; grp += F.NGW) {
        const int r0 = grp * 16;
        f32x4 lacc[3] = {(f32x4){0.f, 0.f, 0.f, 0.f}, (f32x4){0.f, 0.f, 0.f, 0.f}, (f32x4){0.f, 0.f, 0.f, 0.f}};
#pragma unroll
        for (int ks = 0; ks < 32; ++ks) {
#pragma unroll
            for (int nt = 0; nt < 3; ++nt) { const bf16x8 bv = *(const LAS bf16x8*)(wrow + nt * 16 * WR_STRIDE + 64 * ks); lacc[nt] = __builtin_amdgcn_mfma_f32_16x16x32_bf16(av[ks], bv, lacc[nt], 0, 0, 0); } }
        if (grp + F.NGW < ngrp) { const bf16_t* hrow = HB + (size_t)((grp + F.NGW) * 16 + (lane & 15)) * 1024 + 8 * (lane >> 4);
#pragma unroll
            for (int ks = 0; ks < 32; ++ks) av[ks] = *(const bf16x8*)(hrow + 32 * ks); }
#pragma unroll
        for (int nt = 0; nt < 3; ++nt)
#pragma unroll
            for (int r = 0; r < 4; ++r) LG[(4 * (lane >> 4) + r) * LG_STRIDE + nt * 16 + (lane & 15)] = lacc[nt][r];
        asm volatile("s_waitcnt lgkmcnt(0)" ::: "memory");
        if (lane < 16) {
            const int row = r0 + lane; float lg[36];
#pragma unroll
            for (int q4 = 0; q4 < 9; ++q4) { const f32x4 t = *(const LAS f32x4*)(LG + lane * LG_STRIDE + 4 * q4); lg[4 * q4] = t.x; lg[4 * q4 + 1] = t.y; lg[4 * q4 + 2] = t.z; lg[4 * q4 + 3] = t.w; }
            float gl[4];
#pragma unroll
            for (int j = 0; j < 4; ++j) gl[j] = lg[j] + a->in[I_MOEBG][l * 4 + j];
            int gi = 0; float gm = gl[0];
#pragma unroll
            for (int j = 1; j < 4; ++j) if (gl[j] > gm) { gm = gl[j]; gi = j; }
            float gs = 0.f;
#pragma unroll
            for (int j = 0; j < 4; ++j) gs += expf(gl[j] - gm);
            const float gprob = 1.0f / gs;
            float el[8];
#pragma unroll
            for (int j = 0; j < 8; ++j) { float t = lg[4 + j] + a->in[I_MOEBE][l * 32 + j];
#pragma unroll
                for (int gg = 1; gg < 4; ++gg) t = (gi == gg) ? (lg[4 + gg * 8 + j] + a->in[I_MOEBE][l * 32 + gg * 8 + j]) : t;
                el[j] = t; }
            int i0 = 0; float v0 = el[0];
#pragma unroll
            for (int j = 1; j < 8; ++j) if (el[j] > v0) { v0 = el[j]; i0 = j; }
            int i1 = -1; float v1 = -3.0e38f;
#pragma unroll
            for (int j = 0; j < 8; ++j) if (j != i0 && el[j] > v1) { v1 = el[j]; i1 = j; }
            const float e1 = expf(v1 - v0), w0 = gprob / (1.0f + e1), w1 = gprob * e1 / (1.0f + e1);
            const int ea = gi * 8 + i0, eb = gi * 8 + i1;
            if (!(mode & 4)) {
            const unsigned pa = __hip_atomic_fetch_add(cnt + ea * 64, 1u, __ATOMIC_RELAXED, __HIP_MEMORY_SCOPE_AGENT);
            const unsigned pb = __hip_atomic_fetch_add(cnt + eb * 64, 1u, __ATOMIC_RELAXED, __HIP_MEMORY_SCOPE_AGENT);
            LIST[(size_t)ea * TA + pa] = row * 2; LIST[(size_t)eb * TA + pb] = row * 2 + 1;
            WT[(size_t)ea * TA + pa] = w0; WT[(size_t)eb * TA + pb] = w1;
            *(u32x2*)(F.ws + WS_POS + (size_t)row * 8) = (u32x2){((unsigned)ea << 24) | pa, ((unsigned)eb << 24) | pb};
            } else if (w0 + w1 + (float)(ea + eb) == -12345.0f) WT[row] = w0;
        }
        asm volatile("s_waitcnt lgkmcnt(0)" ::: "memory");
    }
    }
    __syncthreads();
}

__device__ __forceinline__ void moe_tiles(Frame& F, int l) {
    __syncthreads();
    if (F.wave == 0) {
        const int e = F.lane & 31;
        const unsigned c = __hip_atomic_load(F.ctl + CW_CNT + (l * 32 + e) * 64, __ATOMIC_RELAXED, __HIP_MEMORY_SCOPE_AGENT);
        const int t = (int)((c + 255u) >> 8); int incl = t;
#pragma unroll
        for (int o = 1; o < 32; o <<= 1) { const int v = __shfl_up(incl, o, 32); if (e >= o) incl += v; }
        if (F.lane < 32) { F.MISC[32 + e] = (unsigned)(incl - t); F.MISC[72 + e] = c; if (e == 31) F.MISC[64] = (unsigned)incl; }
    }
    __syncthreads();
}
struct SchedMoe {
    int G, c, l, second; volatile LAS unsigned* MISC; const unsigned* cnt; const int* LIST; const char *A, *B;
    __device__ __forceinline__ bool next(int i, pg8::GU& u) const {
        const int L = i * G + c, tile = L >> 2, pn = L & 3; if (tile >= __builtin_amdgcn_readfirstlane((int)MISC[64])) return false;
        const int lj = (int)__builtin_amdgcn_mbcnt_hi(~0u, __builtin_amdgcn_mbcnt_lo(~0u, 0u)) & 31;
        const int e = __builtin_popcountll(__ballot(lj >= 1 && (int)MISC[32 + lj] <= tile) & 0xffffffffull);
        const int tl = tile - __builtin_amdgcn_readfirstlane((int)MISC[32 + e]); const int ce = __builtin_amdgcn_readfirstlane((int)MISC[72 + e]);
        u.gl = LIST + (size_t)e * TA + tl * 256; u.nvalid = ce - tl * 256 < 256 ? ce - tl * 256 : 256; u.e = e; u.pm = tile; u.pn = pn; u.kind = 0;
        if (!second) { u.A = A; u.B = B + (size_t)e * 1024 * 1024 + (size_t)pn * 256 * 1024; u.K = 1024; }
        else { u.A = A + (size_t)tile * 256 * 512; u.B = B + (size_t)e * 1024 * 512 + (size_t)pn * 256 * 512; u.K = 512; }
        return true;
    }
};
struct EpiMoe1 { static constexpr bool ALIGN = MK_ALIGN_EPIMOE1;
    unsigned char* HID; const float* WTS;
    __device__ __forceinline__ void operator()(const f32x4 (&acc)[2][2][4][2], const pg8::GU& u, int wr, int wc, int fr, int fq) const {
        int ln_; asm volatile("v_mbcnt_lo_u32_b32 %0, -1, 0\n\tv_mbcnt_hi_u32_b32 %0, -1, %0" : "=v"(ln_));
        const int rl0 = wr * 64 + (ln_ & 15), row0 = u.pm * 256 + rl0, hc0 = u.pn * 128 + wc * 16 + 4 * (ln_ >> 4);
        const float* wts = WTS + (u.gl - LISTB);
#if MK_DUP == 51
        for (int rep_ = 0; rep_ < 2; ++rep_) { asm volatile("" ::: "memory");
#else
        {
#endif
#pragma unroll
        for (int ai = 0; ai < 2; ++ai)
#pragma unroll
            for (int m = 0; m < 4; ++m) { const int rl = rl0 + ai * 128 + m * 16; const float wsc = wts[rl < u.nvalid ? rl : 0] * ((rl < u.nvalid) ? (H8S * W8R) : 0.f);
#pragma unroll
                for (int bj = 0; bj < 2; ++bj) { const f32x4 gt = acc[ai][bj][m][0] * W8R, up = acc[ai][bj][m][1] * wsc;
                    *(unsigned*)(HID + (size_t)(row0 + ai * 128 + m * 16) * 512 + hc0 + bj * 64) =
                        pk4_fp8(gt[0] * sigmoidf_(gt[0]) * up[0], gt[1] * sigmoidf_(gt[1]) * up[1], gt[2] * sigmoidf_(gt[2]) * up[2], gt[3] * sigmoidf_(gt[3]) * up[3]); } }
        }
    }
    const int* LISTB;
};
struct EpiMoe2 { static constexpr bool ALIGN = MK_ALIGN_EPIMOE2;
    unsigned char* YS;
    __device__ __forceinline__ void operator()(const f32x4 (&acc)[2][2][4][2], const pg8::GU& u, int wr, int wc, int fr, int fq) const {
        int ln_; asm volatile("v_mbcnt_lo_u32_b32 %0, -1, 0\n\tv_mbcnt_hi_u32_b32 %0, -1, %0" : "=v"(ln_));
        const int rb = wr * 64 + (ln_ & 15), cq = wc * 32 + 8 * (ln_ >> 4);
        unsigned char* dst0 = YS + (size_t)(u.pm * 256 + rb) * 1024 + u.pn * 256 + cq;
#if MK_DUP == 50
        for (int rep_ = 0; rep_ < 2; ++rep_) { asm volatile("" ::: "memory");
#else
        {
#endif
#pragma unroll
        for (int ai = 0; ai < 2; ++ai)
#pragma unroll
            for (int m = 0; m < 4; ++m) { const int r = rb + ai * 128 + m * 16;
                if (r < u.nvalid) { unsigned char* dst = dst0 + (size_t)(ai * 128 + m * 16) * 1024;
#pragma unroll
                    for (int bj = 0; bj < 2; ++bj) { const f32x4 v0 = acc[ai][bj][m][0] * W8R, v1 = acc[ai][bj][m][1] * W8R;
                        *(u32x2*)(dst + bj * 128) = (u32x2){pk4_fp8(v0[0], v0[1], v0[2], v0[3]), pk4_fp8(v1[0], v1[1], v1[2], v1[3])}; } } }
        }
    }
};

__device__ __forceinline__ void phase_ln2(Frame& F, ArgsP a, int l, int nrows) {
    const float* mod = (const float*)(F.ws + WS_MOD) + (size_t)l * 33 * 6144; const float* modn = (const float*)(F.ws + WS_MOD) + (size_t)33 * 6144;
    bf16_t* X = (bf16_t*)(F.ws + WS_X); bf16_t* HB = (bf16_t*)(F.ws + WS_HB);
    const unsigned char* YS = F.ws + WS_YS; const unsigned* POS = (const unsigned*)(F.ws + WS_POS);
    moe_tiles(F, l);
#define LN2_YROW(p) ((size_t)((int)F.MISC[32 + ((p) >> 24)] * 256 + (int)((p) & 0xFFFFFFu)) * 1024)
    const int lane = F.lane;
    f32x4 lg[2][2], lb[2][2];
#pragma unroll
    for (int hh = 0; hh < 2; ++hh) { const int c = hh * 512 + 8 * lane;
        lg[hh][0] = *(const f32x4*)(a->in[I_LN2G] + l * 1024 + c); lg[hh][1] = *(const f32x4*)(a->in[I_LN2G] + l * 1024 + c + 4); lb[hh][0] = *(const f32x4*)(a->in[I_LN2B] + l * 1024 + c); lb[hh][1] = *(const f32x4*)(a->in[I_LN2B] + l * 1024 + c + 4); }
    const int step = 2 * F.NGW;
    u32x4 pre[2][2]; u32x2 prey[2][2][2];
#pragma unroll
    for (int q = 0; q < 2; ++q)
#pragma unroll
        for (int hh = 0; hh < 2; ++hh) { const int row = F.gw + q * F.NGW; const size_t o = (size_t)row * 1024 + hh * 512 + 8 * lane; pre[q][hh] = *(const u32x4*)(X + o);
            const u32x2 p = *(const u32x2*)(POS + 2 * row); prey[q][hh][0] = *(const u32x2*)(YS + LN2_YROW(p.x) + hh * 512 + 8 * lane); prey[q][hh][1] = *(const u32x2*)(YS + LN2_YROW(p.y) + hh * 512 + 8 * lane); }
    u32x2 pp[2];
#pragma unroll
    for (int q = 0; q < 2; ++q) { const int row = F.gw + step + q * F.NGW; pp[q] = *(const u32x2*)(POS + 2 * (row < nrows ? row : 0)); }
    for (int row0 = F.gw; row0 < nrows; row0 += step) {
        float v[2][16];
#pragma unroll
        for (int q = 0; q < 2; ++q) { const int row = row0 + q * F.NGW; const float* mrow = mod + (size_t)mod_row(row) * 6144;
#pragma unroll
            for (int hh = 0; hh < 2; ++hh) { const int c = hh * 512 + 8 * lane;
                const u32x4 xw = pre[q][hh]; const u32x2 y0 = prey[q][hh][0], y1 = prey[q][hh][1];
                const f32x4 g0 = *(const f32x4*)(mrow + 5120 + c) * (1.0f / H8S), g1 = *(const f32x4*)(mrow + 5120 + c + 4) * (1.0f / H8S);
                const unsigned xs[4] = {xw.x, xw.y, xw.z, xw.w};
                float ya[8], yb[8], t4[4];
                fp8x4_to_f32(y0.x, t4); ya[0] = t4[0]; ya[1] = t4[1]; ya[2] = t4[2]; ya[3] = t4[3]; fp8x4_to_f32(y0.y, t4); ya[4] = t4[0]; ya[5] = t4[1]; ya[6] = t4[2]; ya[7] = t4[3];
                fp8x4_to_f32(y1.x, t4); yb[0] = t4[0]; yb[1] = t4[1]; yb[2] = t4[2]; yb[3] = t4[3]; fp8x4_to_f32(y1.y, t4); yb[4] = t4[0]; yb[5] = t4[1]; yb[6] = t4[2]; yb[7] = t4[3];
#pragma unroll
                for (int j = 0; j < 4; ++j) { const float ga = j < 2 ? g0[2 * j] : g1[2 * j - 4], gb = j < 2 ? g0[2 * j + 1] : g1[2 * j - 3];
                    v[q][hh * 8 + 2 * j] = DN_ALPHA * bf_lo(xs[j]) + ga * (ya[2 * j] + yb[2 * j]); v[q][hh * 8 + 2 * j + 1] = DN_ALPHA * bf_hi(xs[j]) + gb * (ya[2 * j + 1] + yb[2 * j + 1]); } } }
        if (row0 + step < nrows) {
#pragma unroll
            for (int q = 0; q < 2; ++q)
#pragma unroll
                for (int hh = 0; hh < 2; ++hh) { const size_t o = (size_t)(row0 + step + q * F.NGW) * 1024 + hh * 512 + 8 * lane; pre[q][hh] = *(const u32x4*)(X + o);
                    prey[q][hh][0] = *(const u32x2*)(YS + LN2_YROW(pp[q].x) + hh * 512 + 8 * lane); prey[q][hh][1] = *(const u32x2*)(YS + LN2_YROW(pp[q].y) + hh * 512 + 8 * lane); }
#pragma unroll
            for (int q = 0; q < 2; ++q) { const int row = row0 + 2 * step + q * F.NGW; pp[q] = *(const u32x2*)(POS + 2 * (row < nrows ? row : 0)); } }
        float s[2], mean[2], qq[2], rstd[2];
#pragma unroll
        for (int q = 0; q < 2; ++q) { s[q] = 0.f;
#pragma unroll
            for (int j = 0; j < 16; ++j) s[q] += v[q][j]; }
#pragma unroll
        for (int o = 1; o < 64; o <<= 1)
#pragma unroll
            for (int q = 0; q < 2; ++q) s[q] += __shfl_xor(s[q], o);
#pragma unroll
        for (int q = 0; q < 2; ++q) { mean[q] = s[q] * (1.f / 1024.f); qq[q] = 0.f;
#pragma unroll
            for (int j = 0; j < 16; ++j) { v[q][j] -= mean[q]; qq[q] += v[q][j] * v[q][j]; } }
#pragma unroll
        for (int o = 1; o < 64; o <<= 1)
#pragma unroll
            for (int q = 0; q < 2; ++q) qq[q] += __shfl_xor(qq[q], o);
#pragma unroll
        for (int q = 0; q < 2; ++q) rstd[q] = 1.0f / sqrtf(qq[q] * (1.f / 1024.f) + LN_EPS);
#pragma unroll
        for (int q = 0; q < 2; ++q) { const int row = row0 + q * F.NGW; const float* mn = modn + (size_t)mod_row(row) * 6144;
#pragma unroll
            for (int hh = 0; hh < 2; ++hh) { const int c = hh * 512 + 8 * lane;
                float x2[8];
#pragma unroll
                for (int j = 0; j < 8; ++j) x2[j] = v[q][hh * 8 + j] * rstd[q] * (j < 4 ? lg[hh][0][j] : lg[hh][1][j - 4]) + (j < 4 ? lb[hh][0][j] : lb[hh][1][j - 4]);
                if (l == 0) {
                    u32x4 w; w.x = pk2(x2[0], x2[1]); w.y = pk2(x2[2], x2[3]); w.z = pk2(x2[4], x2[5]); w.w = pk2(x2[6], x2[7]);
                    *(u32x4*)(X + (size_t)row * 1024 + c) = w;
                    const f32x4 sh0 = *(const f32x4*)(mn + c), sh1 = *(const f32x4*)(mn + c + 4), sc0 = *(const f32x4*)(mn + 1024 + c), sc1 = *(const f32x4*)(mn + 1024 + c + 4);
                    float hv[8];
#pragma unroll
                    for (int j = 0; j < 8; ++j) hv[j] = x2[j] * (1.f + (j < 4 ? sc0[j] : sc1[j - 4])) + (j < 4 ? sh0[j] : sh1[j - 4]);
                    u32x4 hw; hw.x = pk2(hv[0], hv[1]); hw.y = pk2(hv[2], hv[3]); hw.z = pk2(hv[4], hv[5]); hw.w = pk2(hv[6], hv[7]);
                    *(u32x4*)(HB + (size_t)row * 1024 + c) = hw;
                } else {
                    float* op = a->out + (size_t)row * 1024 + c;
                    *(f32x4*)op = (f32x4){x2[0], x2[1], x2[2], x2[3]}; *(f32x4*)(op + 4) = (f32x4){x2[4], x2[5], x2[6], x2[7]};
                }
            } }
    }
}

constexpr int NPH_L = 11, NPH = 2 + 2 * NPH_L;
__global__ void __launch_bounds__(NTHREADS, 2) mk_fwd(Args args) {
    extern __shared__ __attribute__((aligned(16))) unsigned char lds_raw[];
    Frame F;
    F.lds = (LAS unsigned char*)lds_raw;
    F.MISC = (volatile LAS unsigned*)(F.lds + MISC_OFF);
    int wave0 = __builtin_amdgcn_readfirstlane((int)threadIdx.x >> 6); asm volatile("" : "+s"(wave0));
#define LANE_ID(dst) asm volatile("v_mbcnt_lo_u32_b32 %0, -1, 0\n\tv_mbcnt_hi_u32_b32 %0, -1, %0" : "=v"(dst))
    F.wave = wave0; LANE_ID(F.lane); F.tid = wave0 * 64 + F.lane;
    F.G = gridDim.x; F.bid = blockIdx.x; F.gw = F.bid * NWAVES + F.wave; F.NGW = F.G * NWAVES;
    const int vcu = (F.G % 8 == 0) ? (F.bid % 8) * (F.G / 8) + F.bid / 8 : F.bid;
    ArgsP ap = (ArgsP)__builtin_amdgcn_kernarg_segment_ptr(); asm volatile("" : "+s"(ap));
    F.ws = ap->ws; F.ctl = (unsigned*)(F.ws + WS_CTL);
    for (int u = F.tid; u < 128; u += NTHREADS) F.MISC[u] = 0u;
    __syncthreads();
#if MK_SPLIT
#define GRID_BAR() do { } while (0)
#else
    XcdBarrier bar = xcd_barrier_post(F.ctl + CW_BAR, F.MISC + 8);
#define GRID_BAR() xcd_barrier(bar)
#endif
    const int lo = ap->ph_lo, hi = ap->ph_hi;
#ifndef MK_ATT_V1
#define MK_ATT_V1 0
#endif
#ifndef MK_PHMASK
#define MK_PHMASK 0xFFFFFF
#endif
#define PHON(p) (((MK_PHMASK) >> (p)) & 1)
#ifndef MK_DUP
#define MK_DUP -1
#endif
#define NDUP(p) ((MK_DUP) == (p) ? 2 : 1)
#define IN(k) (lo <= (k) && (k) < hi)
#define SEAM(k) do { if (IN((k) + 1)) { GRID_BAR(); if (MK_DUP == 40) GRID_BAR(); } { LANE_ID(F.lane); F.tid = wave0 * 64 + F.lane; ap = (ArgsP)__builtin_amdgcn_kernarg_segment_ptr(); asm volatile("" : "+s"(ap)); F.ws = ap->ws; F.ctl = (unsigned*)(F.ws + WS_CTL); ws = F.ws; } } while (0)
    unsigned char* ws = F.ws;

    if (PHON(0) && IN(0)) { for (int dup = 0; dup < NDUP(0); ++dup) p0a_prologue(F, ap); SEAM(0); }
    if (PHON(1) && IN(1)) { p0b_mod(F, ap); SEAM(1); }

    for (int l = 0; l < DEPTH; ++l) {
        const int pb = 2 + l * NPH_L;
        const int nrows = (l == 0) ? TA : TL;
#define wsl ((const char*)(ws + WS_WS + (size_t)l * WSL))
#define modl ((const float*)(ws + WS_MOD) + (size_t)l * 33 * 6144)
        const float lam_init = 0.8f - 0.6f * expf(-0.3f * (float)l);

        if (PHON(2) && IN(pb + 0) && l == 0) { for (int dup = 0; dup < NDUP(2); ++dup) phase_modulate0(F, ap); SEAM(pb + 0); }

        if (PHON(3) && IN(pb + 1)) {
            SchedIn S; S.G = F.G; S.c = F.bid; S.nM = nrows / 256; S.nreg = S.nM * 11; S.nctx = (l == 0) ? 0 : 128; S.A = (const char*)(ws + WS_HB); S.B = wsl;
            EpiIn E{(bf16_t*)(ws + WS_ZG), (bf16_t*)(ws + WS_ZH), (bf16_t*)(ws + WS_Q), (bf16_t*)(ws + WS_K), (bf16_t*)(ws + WS_V), (const float*)(ws + WS_ROPE)};
            for (int dup = 0; dup < NDUP(3); ++dup) pg8::gemm_phase<EpiIn, SchedIn, false>(F.lds, S, E, 2048, 2048, F.wave, F.lane);
            SEAM(pb + 1);
        }

        if (PHON(4) && IN(pb + 2)) {
            for (int dup = 0; dup < NDUP(20); ++dup) for (int u = F.bid; u < nrows / 128; u += F.G) gmlp_unit(F, ap, l, u);
            { const int nu = nrows / 128, extra = (nu > F.G && nu < 2 * F.G) ? nu - F.G : 0;
              for (int dup = 0; dup < NDUP(21); ++dup) { if (F.bid >= extra) for (int u = F.bid - extra; u < nu; u += F.G - extra) sconv_unit(F, ap, l, u); } }
            if (!MK_ROPE_EPI) for (int u = F.bid; u < TL / 128; u += F.G) rope_unit(F, u);
            SEAM(pb + 2);
        }

        if (PHON(5) && IN(pb + 3)) {
            const float* HF = (const float*)(ws + WS_HF);
#ifndef MK_NOCONV
            for (int dup = 0; dup < NDUP(22); ++dup) for (int c = F.bid; c < 256; c += F.G) {
                conv_unit<8>(F, ap, l, c, HF + (size_t)l * 2048 * 512, (const bf16_t*)(ws + WS_VT) + (size_t)c * TL, (bf16_t*)(ws + WS_YT) + (size_t)c * TL);
                if (l == 0) conv_unit<1>(F, ap, l, c, HF + (size_t)2 * 2048 * 512, (const bf16_t*)(ws + WS_VT) + (size_t)256 * TL + (size_t)c * TC, (bf16_t*)(ws + WS_YT) + (size_t)256 * TL + (size_t)c * TC);
            }
#endif
#ifndef MK_NOATT
            float s1 = 0.f, s2 = 0.f;
            for (int i = 0; i < 64; ++i) { s1 += ap->in[I_LQ1][l * 64 + i] * ap->in[I_LK1][l * 64 + i]; s2 += ap->in[I_LQ2][l * 64 + i] * ap->in[I_LK2][l * 64 + i]; }
            const float lam = expf(s1) - expf(s2) + lam_init;
#if MK_ATT_V1
            for (int u = F.bid; u < 1024; u += F.G) { const int b = u >> 5, rem = u & 31; AttnUnit U; U.qrow0 = b * SEQ + (rem & 7) * 256; U.h = rem >> 3; U.klat0 = b * SEQ; U.nlat = 32; U.kctx0 = TL + b * CTXL; U.nt = 36;
                attn_unit_v1(F, ap, l, U, lam, lam_init); }
            if (l == 0) for (int u = F.bid; u < 128; u += F.G) { const int b = u >> 2; AttnUnit U; U.qrow0 = TL + b * CTXL; U.h = u & 3; U.klat0 = 0; U.nlat = 0; U.kctx0 = TL + b * CTXL; U.nt = 4;
                attn_unit_v1(F, ap, l, U, lam, lam_init); }
#else
            for (int dup = 0; dup < NDUP(23); ++dup) for (int u = vcu; u < 2048; u += F.G) { const int b = u >> 6, rem = u & 63; AttnUnit U; U.qrow0 = b * SEQ + (rem & 15) * 128; U.h = rem >> 4; U.klat0 = b * SEQ; U.nlat = 32; U.kctx0 = TL + b * CTXL; U.nt = 36;
                attn_unit(F, ap, l, U, lam, lam_init); }
            if (l == 0) for (int u = vcu; u < 256; u += F.G) { const int b = u >> 3; AttnUnit U; U.qrow0 = TL + b * CTXL + (u & 1) * 128; U.h = (u >> 1) & 3; U.klat0 = 0; U.nlat = 0; U.kctx0 = TL + b * CTXL; U.nt = 4;
                attn_unit(F, ap, l, U, lam, lam_init); }
#endif
#endif
            SEAM(pb + 3);
        }

        if (PHON(6) && IN(pb + 4)) { for (int dup = 0; dup < NDUP(6); ++dup) for (int u = F.bid; u < nrows / 64; u += F.G) ytrans_unit<64>(F, u); __syncthreads(); SEAM(pb + 4); }

        if (PHON(7) && IN(pb + 5)) {
            SchedMerge S{F.G, F.bid, nrows / 256, (const char*)(ws + WS_HB), (const char*)(ws + WS_YCAT), wsl, wsl + 12 * MiB};
            EpiMerge E{(bf16_t*)(ws + WS_MERGED), (bf16_t*)(ws + WS_PSCR) + (size_t)F.bid * 65536};
            for (int dup = 0; dup < NDUP(7); ++dup) pg8::gemm_phase<EpiMerge, SchedMerge, false>(F.lds, S, E, 2048, 2048, F.wave, F.lane);
            { const int rem = (nrows / 256 * 4) % F.G;
              if (rem && F.bid >= rem) expert_weights_fp8(F, ap, l, 0, NCONV_E, (F.bid - rem) * NWAVES + F.wave, (F.G - rem) * NWAVES); }
            SEAM(pb + 5);
        }

        if (PHON(8) && IN(pb + 6)) {
            SchedGrid S{F.G, F.bid, nrows / 256, 4, 1024, (const char*)(ws + WS_MERGED), wsl + 18 * MiB, (size_t)256 * 2048, (size_t)256 * 2048};
            EpiOut E{ap->in[I_X], ap->in[I_CTX], (l == 0) ? nullptr : (const bf16_t*)(ws + WS_X), modl, (bf16_t*)(ws + WS_R1)};
            for (int dup = 0; dup < NDUP(8); ++dup) pg8::gemm_phase<EpiOut, SchedGrid, false>(F.lds, S, E, 2048, 2048, F.wave, F.lane);
            SEAM(pb + 6);
        }

        if (PHON(9) && IN(pb + 7)) { phase_ln1_router(F, ap, l, nrows, 3, ((nrows / 256 * 4) % F.G) ? NCONV_E : 0); if (MK_DUP == 30) phase_ln1_router(F, ap, l, nrows, 1); if (MK_DUP == 33) phase_ln1_router(F, ap, l, nrows, 2); GRID_BAR(); { LANE_ID(F.lane); F.tid = wave0 * 64 + F.lane; } phase_ln1_router(F, ap, l, nrows, 8); if (MK_DUP == 31) phase_ln1_router(F, ap, l, nrows, 12); SEAM(pb + 7); }

        if (PHON(10) && IN(pb + 8)) {
            moe_tiles(F, l);
            SchedMoe S{F.G, vcu, l, 0, F.MISC, F.ctl + CW_CNT + l * 32 * 64, (const int*)(ws + WS_LIST), (const char*)(ws + WS_HB8), (const char*)(ws + WS_EW1)};
            EpiMoe1 E{ws + WS_HID, (const float*)(ws + WS_WTS), (const int*)(ws + WS_LIST)};
            for (int dup = 0; dup < NDUP(10); ++dup) pg8::gemm_phase<EpiMoe1, SchedMoe, true, true>(F.lds, S, E, 1024, 1024, F.wave, F.lane);
            SEAM(pb + 8);
        }

        if (PHON(11) && IN(pb + 9)) {
            moe_tiles(F, l);
            SchedMoe S{F.G, vcu, l, 1, F.MISC, F.ctl + CW_CNT + l * 32 * 64, (const int*)(ws + WS_LIST), (const char*)(ws + WS_HID), (const char*)(ws + WS_EW2)};
            EpiMoe2 E{ws + WS_YS};
            for (int dup = 0; dup < NDUP(11); ++dup) pg8::gemm_phase<EpiMoe2, SchedMoe, false, true>(F.lds, S, E, 512, 512, F.wave, F.lane);
            SEAM(pb + 9);
        }

        if (PHON(12) && IN(pb + 10)) { phase_ln2(F, ap, l, nrows); if (MK_DUP == 32 && l == 1) phase_ln2(F, ap, l, nrows); SEAM(pb + 10); }
    }
#undef wsl
#undef modl
#undef IN
#undef SEAM
#undef GRID_BAR
}

extern "C" void kernel_launch(void* const* d_in, const int* in_sizes, int n_in, void* d_out, int out_size, void* d_ws, size_t ws_size, hipStream_t stream) {
    static int grid = 0;
    if (grid == 0) {
        if (n_in != 40 || out_size != TL * D || ws_size < WS_END) { fprintf(stderr, "kernel_launch: unexpected shapes: n_in %d out %d ws %zu (need %zu)\n", n_in, out_size, ws_size, (size_t)WS_END); grid = -1; return; }
        int dev = 0, cus = 0;
        if (hipGetDevice(&dev) != hipSuccess || hipDeviceGetAttribute(&cus, hipDeviceAttributeMultiprocessorCount, dev) != hipSuccess) { grid = -1; return; }
        if (hipFuncSetAttribute((const void*)mk_fwd, hipFuncAttributeMaxDynamicSharedMemorySize, LDS_BYTES) != hipSuccess) { fprintf(stderr, "kernel_launch: hipFuncSetAttribute failed\n"); grid = -1; return; }
        int per_cu = 0;
        if (hipOccupancyMaxActiveBlocksPerMultiprocessor(&per_cu, (const void*)mk_fwd, NTHREADS, LDS_BYTES) != hipSuccess || per_cu < 1) fprintf(stderr, "kernel_launch: occupancy query reports %d\n", per_cu);
        (void)hipGetLastError();
        grid = cus;
    }
    if (grid < 0) return;
    if (hipMemsetAsync((char*)d_ws + WS_CTL, 0, CTL_ZERO_BYTES, stream) != hipSuccess) return;
    Args a{};
    for (int i = 0; i < 40; ++i) a.in[i] = (const float*)d_in[i];
    a.out = (float*)d_out; a.ws = (unsigned char*)d_ws;
#if MK_SPLIT
    for (int p = 0; p < NPH; ++p) { a.ph_lo = p; a.ph_hi = p + 1; hipLaunchKernelGGL(mk_fwd, dim3(grid), dim3(NTHREADS), LDS_BYTES, stream, a); }
#else
    a.ph_lo = 0; a.ph_hi = NPH;
    hipLaunchKernelGGL(mk_fwd, dim3(grid), dim3(NTHREADS), LDS_BYTES, stream, a);
#endif
}
```

```cpp
#include <hip/hip_runtime.h>
#include <cstdio>
#include <cstdint>

#ifndef MK_SPLIT
#define MK_SPLIT 0
#endif

#ifndef MK_F8BUILTIN
#define MK_F8BUILTIN 0
#endif
#ifndef MK_ALIGN_EPIIN
#define MK_ALIGN_EPIIN 1
#endif
#ifndef MK_ALIGN_EPIMERGE
#define MK_ALIGN_EPIMERGE 1
#endif
#ifndef MK_ALIGN_EPIOUT
#define MK_ALIGN_EPIOUT 1
#endif
#ifndef MK_ALIGN_EPIMOE1
#define MK_ALIGN_EPIMOE1 1
#endif
#ifndef MK_ALIGN_EPIMOE2
#define MK_ALIGN_EPIMOE2 1
#endif
#ifndef MK_DUP
#define MK_DUP -1
#endif
#ifndef MK_ROPE_EPI
#define MK_ROPE_EPI 1
#endif
#define GAS __attribute__((address_space(1)))
#define LAS __attribute__((address_space(3)))
typedef unsigned short bf16_t;
typedef short bf16x8 __attribute__((ext_vector_type(8)));
typedef short s16x4 __attribute__((ext_vector_type(4)));
typedef float f32x2 __attribute__((ext_vector_type(2)));
typedef float f32x4 __attribute__((ext_vector_type(4)));
typedef float f32x16 __attribute__((ext_vector_type(16)));
typedef unsigned u32x2 __attribute__((ext_vector_type(2)));
typedef unsigned u32x4 __attribute__((ext_vector_type(4)));
typedef __bf16 bf16x2_t __attribute__((ext_vector_type(2)));

constexpr int D = 1024, BATCH = 32, SEQ = 2048, CTXL = 256, DEPTH = 2;
constexpr int TL = BATCH * SEQ, TC = BATCH * CTXL, TA = TL + TC;
constexpr int NIN = 5888, NZ = 2816;
constexpr int OFF_GM = 0, OFF_HY = 512, OFF_Q = 1280, OFF_K = 1792, OFF_V = 2304, OFF_GATE = 2816;
constexpr int NEXP = 32, MOEH = 512;
constexpr float LN_EPS = 1e-5f;
constexpr float DN_ALPHA = 1.4142135623730951f;
constexpr float QSCALE = 0.125f * 1.4426950408889634f;
constexpr int NWAVES = 8, NTHREADS = 512;

constexpr size_t MiB = 1u << 20;
constexpr size_t WS_CTL = 0, CTL_ZERO_BYTES = 1 * MiB;
constexpr size_t WS_MOD = 1 * MiB;
constexpr size_t WS_MODP = 3 * MiB;
constexpr size_t WS_ROPE = 16 * MiB;
constexpr size_t WS_HF = 17 * MiB;
constexpr size_t WS_LIST = 26 * MiB;
constexpr size_t WS_WT = 36 * MiB;
constexpr size_t WS_WTS = 988 * MiB;
constexpr size_t WS_WSB = 37 * MiB;
constexpr size_t WS_WS = 48 * MiB;
constexpr size_t WSL = 20 * MiB;
constexpr size_t WS_HB = 88 * MiB;
constexpr size_t WS_X = 232 * MiB;
constexpr size_t WS_ZG = 376 * MiB;
constexpr size_t WS_ZH = 448 * MiB;
constexpr size_t WS_Q = 556 * MiB;
constexpr size_t WS_K = 628 * MiB;
constexpr size_t WS_V = 700 * MiB;
constexpr size_t WS_YCAT = 772 * MiB;
constexpr size_t WS_HB8 = 772 * MiB;
constexpr size_t WS_VT = 916 * MiB;
constexpr size_t WS_X0 = 952 * MiB;
constexpr size_t WS_END = 997 * MiB;
constexpr size_t WS_YT = WS_ZG;
constexpr size_t WS_PSCR = WS_ZH;
constexpr size_t WS_MERGED = WS_Q;
constexpr size_t WS_R1 = WS_ZG;
constexpr size_t WS_EW1 = 700 * MiB;
constexpr size_t WS_EW2 = 732 * MiB;
constexpr size_t WS_HID = 604 * MiB;
constexpr size_t WS_YS = WS_ZG;
constexpr size_t WS_POS = 36 * MiB;
constexpr int CW_BAR = 4096;
constexpr int NCONV_E = 9216;
constexpr int CW_CNT = 16384;

constexpr int LDS_BYTES = 155648;
constexpr int MISC_OFF = LDS_BYTES - 512;

__device__ __forceinline__ unsigned pk2(float lo, float hi) { f32x2 v = {lo, hi}; bf16x2_t b = __builtin_convertvector(v, bf16x2_t); return __builtin_bit_cast(unsigned, b); }
__device__ __forceinline__ float sat8(float x) { return __builtin_amdgcn_fmed3f(x, -448.0f, 448.0f); }
__device__ __forceinline__ unsigned pk4_fp8(float a, float b, float c, float d) { int w = __builtin_amdgcn_cvt_pk_fp8_f32(sat8(a), sat8(b), 0, false); w = __builtin_amdgcn_cvt_pk_fp8_f32(sat8(c), sat8(d), w, true); return (unsigned)w; }
constexpr float H8S = 16.0f;
constexpr float W8S = 32.0f, W8R = 1.0f / 32.0f;
__device__ __forceinline__ void fp8x4_to_f32(unsigned w, float (&o)[4]) { const f32x2 a = __builtin_amdgcn_cvt_pk_f32_fp8((int)w, false), b = __builtin_amdgcn_cvt_pk_f32_fp8((int)w, true); o[0] = a.x; o[1] = a.y; o[2] = b.x; o[3] = b.y; }
__device__ __forceinline__ float bf_lo(unsigned w) { return __uint_as_float(w << 16); }
__device__ __forceinline__ float bf_hi(unsigned w) { return __uint_as_float(w & 0xffff0000u); }
__device__ __forceinline__ float bf1(bf16_t b) { return __uint_as_float(((unsigned)b) << 16); }
__device__ __forceinline__ float wave_sum(float v) {
#pragma unroll
    for (int o = 1; o < 64; o <<= 1) v += __shfl_xor(v, o);
    return v;
}
__device__ __forceinline__ float fast_exp2(float x) { return __builtin_amdgcn_exp2f(x); }
__device__ __forceinline__ float fast_rcp(float x) { return __builtin_amdgcn_rcpf(x); }
__device__ __forceinline__ float sigmoidf_(float x) { return fast_rcp(1.0f + fast_exp2(-1.4426950408889634f * x)); }
__device__ __forceinline__ float gelu_tanh(float x) {
    const float u = 0.7978845608028654f * (x + 0.044715f * x * x * x);
    return x * fast_rcp(1.0f + fast_exp2(-2.8853900817779268f * u));
}
#define XB_TMO      128
#define XB_XCNT(j)  (256  + 64 * (j))
#define XB_XSUB(j)  (1280 + 64 * (j))
#define XB_XGEN(j)  (2304 + 64 * (j))
#define XB_TOP      3328
#define XB_TOPGEN   3392
#define XCD_BAR_WORDS 3456
#define XB_SPIN_CAP (1u << 18)

__device__ __forceinline__ unsigned xb_ld(unsigned* p)              { return __hip_atomic_load(p, __ATOMIC_RELAXED, __HIP_MEMORY_SCOPE_AGENT); }
__device__ __forceinline__ unsigned xb_add(unsigned* p, unsigned v) { return __hip_atomic_fetch_add(p, v, __ATOMIC_RELAXED, __HIP_MEMORY_SCOPE_AGENT); }
__device__ __forceinline__ unsigned xb_xcc_id() { return (unsigned)__builtin_amdgcn_s_getreg((3 << 11) | 20) & 0xFu; }
#define XB_SPIN(cond, bar) do { unsigned _sp = 0; while (cond) { __builtin_amdgcn_s_sleep(1); \
    if ((++_sp & 255u) == 0u) { if (xb_ld(&(bar)[XB_TMO])) break; if (_sp > XB_SPIN_CAP) { atomicAdd(&(bar)[XB_TMO], 1u); break; } } } } while (0)

struct XcdBarrier {
    unsigned* bar; unsigned x;
    volatile LAS unsigned* st;
};

__device__ __forceinline__ XcdBarrier xcd_barrier_post(unsigned* bar, volatile LAS unsigned* st) {
    XcdBarrier b; b.bar = bar; b.x = xb_xcc_id(); b.st = st;
    if (threadIdx.x == 0) (void)xb_add(&bar[XB_XCNT(b.x)], 1u);
    return b;
}
__device__ __forceinline__ void xcd_barrier_complete(unsigned* bar, unsigned x, unsigned& nloc, unsigned& nx) {
    const unsigned G = gridDim.x * gridDim.y * gridDim.z;
    unsigned sum, cnt, mine, sp = 0u;
    for (;;) {
        sum = 0u; cnt = 0u; mine = 0u;
#pragma unroll
        for (unsigned j = 0; j < 16; ++j) { const unsigned c = xb_ld(&bar[XB_XCNT(j)]); sum += c; cnt += (c > 0u) ? 1u : 0u; mine = (j == x) ? c : mine; }
        if (sum == G) break;
        __builtin_amdgcn_s_sleep(1);
        if ((++sp & 255u) == 0u) { if (xb_ld(&bar[XB_TMO])) break; if (sp > XB_SPIN_CAP) { atomicAdd(&bar[XB_TMO], 1u); break; } }
    }
    nloc = mine > 0u ? mine : 1u; nx = cnt > 0u ? cnt : 1u;
}

__device__ __forceinline__ void xcd_barrier(const XcdBarrier& b) {
    asm volatile("s_waitcnt vmcnt(0)" ::: "memory");
    __syncthreads();
    if (threadIdx.x == 0) {
        unsigned* bar = b.bar;
        __builtin_amdgcn_s_waitcnt(0);
        unsigned nloc = b.st[0], nx = b.st[1];
        if (nloc == 0u) { xcd_barrier_complete(bar, b.x, nloc, nx); b.st[0] = nloc; b.st[1] = nx; }
        const unsigned old = xb_add(&bar[XB_XSUB(b.x)], 1u);
        const unsigned gen = old / nloc;
        if (old + 1u == (gen + 1u) * nloc) {
            __builtin_amdgcn_fence(__ATOMIC_RELEASE, "agent");
            asm volatile("s_waitcnt vmcnt(0)" ::: "memory");
            const unsigned og = xb_add(&bar[XB_TOP], 1u);
            const unsigned tg = og / nx;
            if (og + 1u == (tg + 1u) * nx) xb_add(&bar[XB_TOPGEN], 1u);
            else XB_SPIN(xb_ld(&bar[XB_TOPGEN]) == tg, bar);
            __builtin_amdgcn_fence(__ATOMIC_ACQUIRE, "agent");
            xb_add(&bar[XB_XGEN(b.x)], 1u);
            asm volatile("s_waitcnt vmcnt(0)" ::: "memory");
        } else {
            XB_SPIN(xb_ld(&bar[XB_XGEN(b.x)]) == gen, bar);
            __builtin_amdgcn_fence(__ATOMIC_ACQUIRE, "agent");
            asm volatile("s_waitcnt vmcnt(0)" ::: "memory");
        }
    }
    __syncthreads();
}


namespace pg8 {
constexpr int BM = 256, BK = 64, HALF = 128, HTB = HALF * BK * 2, STAGE_BYTES = 8 * HTB;
__host__ __device__ __forceinline__ int lds_byte(int r, int c) { const int st = (r >> 4) * 2 + (c >> 5), rr = r & 15, cc = c & 31, ob = rr * 64 + cc * 2; return st * 1024 + (ob ^ (((ob >> 9) & 1) << 5)); }
__host__ __device__ __forceinline__ void stage_rc(int b, int& R, int& C) { const int st = b / 1024, sb = b % 1024, swz = sb ^ (((sb >> 9) & 1) << 5); R = (st >> 1) * 16 + swz / 64; C = (st & 1) * 32 + (swz % 64) / 2; }
__host__ __device__ __forceinline__ int perm32(int rho) { const int n = rho >> 4, i = rho & 15; return 8 * (i >> 2) + 4 * n + (i & 3); }

struct GU { const char* A; const char* B; const int* gl; int K, kind, pm, pn, e, nvalid; };

__device__ __forceinline__ void grid_order(int L, int nM, int nN, int& pm, int& pn) {
    const int nwg = nM * nN; int wgid = L;
    { const int q = nwg / 8, r = nwg % 8, xcd = wgid % 8, off = wgid / 8; wgid = (xcd < r ? xcd * (q + 1) : r * (q + 1) + (xcd - r) * q) + off; }
    const int nig = 8 * nN, gid = wgid / nig, fm = gid * 8, gsz = (nM - fm) < 8 ? (nM - fm) : 8;
    pm = fm + ((wgid % nig) % gsz); pn = (wgid % nig) / gsz;
}

typedef int v8i __attribute__((ext_vector_type(8)));
typedef short bf16x16_t __attribute__((ext_vector_type(16)));
template <class Epi, class Sched, bool GATHER, bool F8 = false>
__device__ __forceinline__ void gemm_phase(LAS unsigned char* lds, const Sched& S, const Epi& E, const int lda, const int ldb, const int wid, const int lane) {
    const int tid = wid * 64 + lane;
    const int wr = wid >> 2, wc = wid & 3, fr = lane & 15, fq = lane >> 4;
    unsigned voffA[2], voffB[2]; int Rr[2], Cb[2];
#pragma unroll
    for (int i = 0; i < 2; ++i) { int R, C; stage_rc(tid * 16 + i * 8192, R, C); const int Rb = (R & ~31) + perm32(R & 31);
        Rr[i] = R; Cb[i] = C * 2; voffA[i] = (unsigned)(R * lda + C * 2); voffB[i] = (unsigned)(Rb * ldb + C * 2); }
    const size_t kstep = (size_t)(BK * 2);
    const size_t hstepA = (size_t)HALF * lda, hstepB = (size_t)HALF * ldb, qstepA = (size_t)64 * lda, qstepB = (size_t)64 * ldb;
    const unsigned ldsw = (unsigned)wid * 1024u;
    const int aoff = lds_byte(wr * 64 + fr, fq * 8), boff = lds_byte(wc * 32 + fr, fq * 8);
#define PG8_SA(b, h) (((b) * 2 + (h)) * HTB)
#define PG8_SB(b, h) ((4 + (b) * 2 + (h)) * HTB)
#define PG8_STAGE(bufoff, gbase, voff) do { _Pragma("unroll") for (int _i = 0; _i < 2; ++_i) \
        __builtin_amdgcn_global_load_lds((const unsigned*)((const char*)(gbase) + (voff)[_i]), (LAS unsigned*)(lds + (bufoff) + ldsw + _i * 8192), 16, 0, 0); } while (0)
#define PG8_STAGE1(bufoff, gbase, voff0, qstep) do { _Pragma("unroll") for (int _i = 0; _i < 2; ++_i) \
        __builtin_amdgcn_global_load_lds((const unsigned*)((const char*)(gbase) + (size_t)_i * (qstep) + (voff0)), (LAS unsigned*)(lds + (bufoff) + ldsw + _i * 8192), 16, 0, 0); } while (0)
#define PG8_STAGE_A(b, h, kp) do { if constexpr (GATHER) { if ((h) == 0) PG8_STAGE(PG8_SA(b, h), kp, gA0); else PG8_STAGE(PG8_SA(b, h), kp, gA1); } \
        else PG8_STAGE1(PG8_SA(b, h), (kp) + (h) * hstepA, voffA[0], qstepA); } while (0)
#define PG8_STAGE_B(b, h, kp) PG8_STAGE1(PG8_SB(b, h), (kp) + (h) * hstepB, voffB[0], qstepB)
#define PG8_LDA(dst, b, h) do { _Pragma("unroll") for (int m = 0; m < 4; ++m) _Pragma("unroll") for (int k = 0; k < 2; ++k) dst[m][k] = *(const LAS bf16x8*)(lds + PG8_SA(b, h) + aoff + m * 2048 + k * 1024); } while (0)
#define PG8_LDB(dst, b, h) do { _Pragma("unroll") for (int n = 0; n < 2; ++n) _Pragma("unroll") for (int k = 0; k < 2; ++k) dst[n][k] = *(const LAS bf16x8*)(lds + PG8_SB(b, h) + boff + n * 2048 + k * 1024); } while (0)
#define PG8_J8(X) __builtin_bit_cast(v8i, (bf16x16_t){X[0][0], X[0][1], X[0][2], X[0][3], X[0][4], X[0][5], X[0][6], X[0][7], X[1][0], X[1][1], X[1][2], X[1][3], X[1][4], X[1][5], X[1][6], X[1][7]})
#define PG8_MMA(ai, bj, At, Bt) do { __builtin_amdgcn_s_setprio(1); _Pragma("unroll") for (int m = 0; m < 4; ++m) _Pragma("unroll") for (int n = 0; n < 2; ++n) { \
        if constexpr (F8 && GATHER) acc[ai][bj][m][n] = __builtin_amdgcn_mfma_scale_f32_16x16x128_f8f6f4(PG8_J8(Bt[n]), PG8_J8(At[m]), acc[ai][bj][m][n], 0, 0, 0, 0x7F7F7F7F, 0, 0x7F7F7F7F); \
        else if constexpr (F8) { const v8i b8_ = PG8_J8(Bt[n]), a8_ = PG8_J8(At[m]); asm volatile("v_mfma_scale_f32_16x16x128_f8f6f4 %0, %1, %2, %0, %3, %3 op_sel_hi:[0,0,0]" : "+v"(acc[ai][bj][m][n]) : "v"(b8_), "v"(a8_), "v"(0x7F7F7F7F)); } \
        else { _Pragma("unroll") for (int k = 0; k < 2; ++k) acc[ai][bj][m][n] = __builtin_amdgcn_mfma_f32_16x16x32_bf16(Bt[n][k], At[m][k], acc[ai][bj][m][n], 0, 0, 0); } } \
        __builtin_amdgcn_s_setprio(0); } while (0)
#define PG8_WAIT_V(n) asm volatile("s_waitcnt vmcnt(" #n ")" ::: "memory")
#define PG8_WAIT_L(n) asm volatile("s_waitcnt lgkmcnt(" #n ")" ::: "memory")
#define PG8_BAR __builtin_amdgcn_s_barrier()
#define PG8_SCHED __builtin_amdgcn_sched_barrier(0)
#define PG8_GOFF(u, o0, o1) do { _Pragma("unroll") for (int _i = 0; _i < 2; ++_i) { const int _r0 = Rr[_i], _r1 = HALF + Rr[_i]; \
        const int _t0 = (_r0 < (u).nvalid) ? ((u).gl[_r0] >> 1) : 0, _t1 = (_r1 < (u).nvalid) ? ((u).gl[_r1] >> 1) : 0; \
        o0[_i] = (unsigned)_t0 * (unsigned)lda + (unsigned)Cb[_i]; o1[_i] = (unsigned)_t1 * (unsigned)lda + (unsigned)Cb[_i]; } } while (0)
    GU cur, nxt; int ui = 0;
    if (!S.next(0, cur)) return;
    f32x4 acc[2][2][4][2];
#pragma unroll
    for (int a = 0; a < 2; ++a)
#pragma unroll
        for (int b = 0; b < 2; ++b)
#pragma unroll
            for (int m = 0; m < 4; ++m)
#pragma unroll
                for (int n = 0; n < 2; ++n) acc[a][b][m][n] = (f32x4){0.f, 0.f, 0.f, 0.f};
    bf16x8 At[4][2], B0[2][2], B1[2][2];
    unsigned gA0[2] = {0u, 0u}, gA1[2] = {0u, 0u};
    if constexpr (GATHER) PG8_GOFF(cur, gA0, gA1);
    const char* cA = cur.A; const char* cB = cur.B;
    PG8_STAGE_B(0, 0, cB); PG8_STAGE_B(0, 1, cB); PG8_STAGE_A(0, 0, cA); PG8_STAGE_A(0, 1, cA);
    if (wr == 1) PG8_BAR;
    PG8_WAIT_V(2); PG8_BAR;
    PG8_STAGE_B(1, 0, cB + kstep); PG8_STAGE_A(1, 0, cA + kstep); PG8_STAGE_B(1, 1, cB + kstep);
    PG8_WAIT_V(6); PG8_BAR;
    for (;;) {
        const bool has_next = S.next(ui + 1, nxt);
        int nid[2][2] = {{0, 0}, {0, 0}};
        if constexpr (GATHER) { if (has_next) {
#pragma unroll
            for (int _i = 0; _i < 2; ++_i) { const int _r0 = Rr[_i], _r1 = HALF + Rr[_i]; nid[0][_i] = nxt.gl[_r0 < nxt.nvalid ? _r0 : 0]; nid[1][_i] = nxt.gl[_r1 < nxt.nvalid ? _r1 : 0]; } } }
        const char* nA = has_next ? nxt.A : cA; const char* nB = has_next ? nxt.B : cB;
        const int nt = F8 ? cur.K / 128 : cur.K / BK;
        for (int t = 0; t < nt; t += 2) {
            const bool last = (t == nt - 2);
            const char* a1 = cA + (size_t)(t + 1) * kstep;
            const char* a2 = last ? nA : cA + (size_t)(t + 2) * kstep; const char* b2 = last ? nB : cB + (size_t)(t + 2) * kstep;
            const char* a3 = a2 + kstep; const char* b3 = b2 + kstep;
            PG8_LDB(B0, 0, 0); PG8_LDB(B1, 0, 1); PG8_SCHED; PG8_LDA(At, 0, 0); PG8_STAGE_A(1, 1, a1);
            if constexpr (GATHER) { if (last && has_next) {
#pragma unroll
                for (int _i = 0; _i < 2; ++_i) { const int _r0 = Rr[_i], _r1 = HALF + Rr[_i];
                    const int _t0 = (_r0 < nxt.nvalid) ? (nid[0][_i] >> 1) : 0, _t1 = (_r1 < nxt.nvalid) ? (nid[1][_i] >> 1) : 0;
                    gA0[_i] = (unsigned)_t0 * (unsigned)lda + (unsigned)Cb[_i]; gA1[_i] = (unsigned)_t1 * (unsigned)lda + (unsigned)Cb[_i]; } } }
            PG8_WAIT_V(8); PG8_WAIT_L(0); PG8_BAR; PG8_MMA(0, 0, At, B0); PG8_MMA(0, 1, At, B1); PG8_BAR; PG8_SCHED;
            PG8_LDA(At, 0, 1); PG8_STAGE_B(0, 0, b2); PG8_STAGE_B(0, 1, b2); PG8_STAGE_A(0, 0, a2);
            PG8_WAIT_V(8); PG8_WAIT_L(0); PG8_BAR; PG8_MMA(1, 0, At, B0); PG8_MMA(1, 1, At, B1); PG8_BAR; PG8_SCHED;
            PG8_LDB(B0, 1, 0); PG8_LDB(B1, 1, 1); PG8_SCHED; PG8_LDA(At, 1, 0); PG8_STAGE_A(0, 1, a2);
            PG8_WAIT_V(8); PG8_WAIT_L(0); PG8_BAR; PG8_MMA(0, 0, At, B0); PG8_MMA(0, 1, At, B1); PG8_BAR; PG8_SCHED;
            PG8_LDA(At, 1, 1); PG8_STAGE_B(1, 0, b3); PG8_STAGE_B(1, 1, b3); PG8_STAGE_A(1, 0, a3);
            PG8_WAIT_V(8); PG8_WAIT_L(0); PG8_BAR; PG8_MMA(1, 0, At, B0); PG8_MMA(1, 1, At, B1); PG8_BAR; PG8_SCHED;
        }
        if ((Epi::ALIGN || !has_next) && wr == 0) PG8_BAR;
        if constexpr (F8) { asm volatile("s_nop 15\n\ts_nop 15" ::: "memory"); PG8_SCHED; }
        E(acc, cur, wr, wc, fr, fq);
        if (!has_next) break;
#pragma unroll
        for (int a = 0; a < 2; ++a)
#pragma unroll
            for (int b = 0; b < 2; ++b)
#pragma unroll
                for (int m = 0; m < 4; ++m)
#pragma unroll
                    for (int n = 0; n < 2; ++n) acc[a][b][m][n] = (f32x4){0.f, 0.f, 0.f, 0.f};
        cur = nxt; cA = nA; cB = nB; ++ui;
        if (Epi::ALIGN && wr == 1) PG8_BAR;
    }
    PG8_WAIT_V(0);
    PG8_BAR;
#undef PG8_SA
#undef PG8_SB
#undef PG8_STAGE
#undef PG8_STAGE1
#undef PG8_STAGE_A
#undef PG8_STAGE_B
#undef PG8_LDA
#undef PG8_LDB
#undef PG8_MMA
#undef PG8_J8
#undef PG8_WAIT_V
#undef PG8_WAIT_L
#undef PG8_BAR
#undef PG8_SCHED
#undef PG8_GOFF
}
}

struct Args { const float* in[40]; float* out; unsigned char* ws; int ph_lo, ph_hi; };
typedef const __attribute__((address_space(4))) Args* ArgsP;
enum InIdx { I_X = 0, I_C, I_CTX, I_CCTX, I_ADAW, I_ADAB, I_WIN, I_GMLNG, I_GMLNB, I_GMWS, I_GMBS, I_HYCW, I_HYCB, I_HYW1, I_HYB1, I_HYW2, I_HYB2, I_HYW3, I_HYB3, I_HYSKIP,
             I_LQ1, I_LK1, I_LQ2, I_LK2, I_DANG, I_PA, I_PB, I_PC, I_WOUT, I_LN1G, I_LN1B, I_MOEWG, I_MOEBG, I_MOEWE, I_MOEBE, I_EXG, I_EXU, I_EXD, I_LN2G, I_LN2B };

struct Frame {
    LAS unsigned char* lds;
    volatile LAS unsigned* MISC;
    unsigned* ctl;
    int tid, lane, wave, G, bid, gw, NGW;
    unsigned char* ws;
};

template <int MODE>
__device__ __forceinline__ void cvt_item(const float* __restrict__ W, int N, bf16_t* __restrict__ WT, int ldk, int item, int lane) {
    const int nblk = N >> 6, kb = item / nblk, nb = item - kb * nblk, n = nb * 64 + lane, k0 = kb * 64;
    int row = n; if (MODE == 1) row = 8 * (n >> 2) + (n & 3); if (MODE == 2) row = 8 * (n >> 2) + 4 + (n & 3);
    const float* src = W + (size_t)k0 * N + n;
    bf16_t* dst = WT + (size_t)row * ldk + k0;
#pragma unroll 1
    for (int q = 0; q < 8; ++q) {
        float v[8];
#pragma unroll
        for (int j = 0; j < 8; ++j) v[j] = src[(size_t)(q * 8 + j) * N];
        u32x4 o; o.x = pk2(v[0], v[1]); o.y = pk2(v[2], v[3]); o.z = pk2(v[4], v[5]); o.w = pk2(v[6], v[7]);
        *(u32x4*)(dst + q * 8) = o;
    }
}

template <int MODE, bool F8W = false>
__device__ __forceinline__ void tr_item(const float* __restrict__ W, int N, bf16_t* __restrict__ WT, int ldk, LAS float* scr, int item, int lane, int nblk = 0) {
    if (nblk == 0) nblk = N >> 5;
    const int kb = item / nblk, nb = item - kb * nblk, k0 = 64 * kb, n0 = 32 * nb;
    const float* src = W + (size_t)k0 * N + n0 + (lane & 31) + (size_t)(lane >> 5) * N;
#pragma unroll 8
    for (int i = 0; i < 32; ++i) scr[(2 * i + (lane >> 5)) * 33 + (lane & 31)] = src[(size_t)(2 * i) * N];
    asm volatile("s_waitcnt lgkmcnt(0)" ::: "memory");
    const int c = lane & 7;
#pragma unroll
    for (int j = 0; j < 4; ++j) { const int n = n0 + (lane >> 3) + 8 * j; const LAS float* s = scr + (8 * c) * 33 + (lane >> 3) + 8 * j;
        int row = n; if (MODE == 1) row = 8 * (n >> 2) + (n & 3); if (MODE == 2) row = 8 * (n >> 2) + 4 + (n & 3);
        if constexpr (F8W) { u32x2 o; o.x = pk4_fp8(s[0 * 33] * W8S, s[1 * 33] * W8S, s[2 * 33] * W8S, s[3 * 33] * W8S); o.y = pk4_fp8(s[4 * 33] * W8S, s[5 * 33] * W8S, s[6 * 33] * W8S, s[7 * 33] * W8S);
            *(u32x2*)((unsigned char*)WT + (size_t)row * ldk + k0 + 8 * c) = o; }
        else { u32x4 o; o.x = pk2(s[0 * 33], s[1 * 33]); o.y = pk2(s[2 * 33], s[3 * 33]); o.z = pk2(s[4 * 33], s[5 * 33]); o.w = pk2(s[6 * 33], s[7 * 33]);
            *(u32x4*)(WT + (size_t)row * ldk + k0 + 8 * c) = o; } }
    asm volatile("s_waitcnt lgkmcnt(0)" ::: "memory");
}

template <int MODE, bool F8W>
__device__ __forceinline__ void tr_item2(const float* __restrict__ W, int N, bf16_t* __restrict__ WT, int ldk, LAS float* scr, int item, int lane) {
    const int nblk = N >> 5;
    float v[2][32];
#pragma unroll
    for (int t = 0; t < 2; ++t) { const int it = item + t, kb = it / nblk, nb = it - kb * nblk;
        const float* src = W + (size_t)(64 * kb) * N + 32 * nb + (lane & 31) + (size_t)(lane >> 5) * N;
#pragma unroll
        for (int i = 0; i < 32; ++i) v[t][i] = src[(size_t)(2 * i) * N]; }
#pragma unroll
    for (int t = 0; t < 2; ++t) { const int it = item + t, kb = it / nblk, nb = it - kb * nblk, k0 = 64 * kb, n0 = 32 * nb;
#pragma unroll
        for (int i = 0; i < 32; ++i) scr[(2 * i + (lane >> 5)) * 33 + (lane & 31)] = v[t][i];
        asm volatile("s_waitcnt lgkmcnt(0)" ::: "memory");
        const int c = lane & 7;
#pragma unroll
        for (int j = 0; j < 4; ++j) { const int n = n0 + (lane >> 3) + 8 * j; const LAS float* s = scr + (8 * c) * 33 + (lane >> 3) + 8 * j;
            int row = n; if (MODE == 1) row = 8 * (n >> 2) + (n & 3); if (MODE == 2) row = 8 * (n >> 2) + 4 + (n & 3);
            if constexpr (F8W) { u32x2 o; o.x = pk4_fp8(s[0 * 33] * W8S, s[1 * 33] * W8S, s[2 * 33] * W8S, s[3 * 33] * W8S); o.y = pk4_fp8(s[4 * 33] * W8S, s[5 * 33] * W8S, s[6 * 33] * W8S, s[7 * 33] * W8S);
                *(u32x2*)((unsigned char*)WT + (size_t)row * ldk + k0 + 8 * c) = o; }
            else { u32x4 o; o.x = pk2(s[0 * 33], s[1 * 33]); o.y = pk2(s[2 * 33], s[3 * 33]); o.z = pk2(s[4 * 33], s[5 * 33]); o.w = pk2(s[6 * 33], s[7 * 33]);
                *(u32x4*)(WT + (size_t)row * ldk + k0 + 8 * c) = o; } }
        asm volatile("s_waitcnt lgkmcnt(0)" ::: "memory"); }
}

__device__ __forceinline__ void p0a_prologue(Frame& F, ArgsP a) {
    {
        constexpr int I_WIN_ = 16 * 184, I_PA_ = 4 * 32, I_PC_ = 8 * 32, I_WO_ = 16 * 32, PER = I_WIN_ + 2 * I_PA_ + I_PC_ + I_WO_;
        LAS float* scr = (LAS float*)(F.lds + F.wave * 8448);
        for (int it2 = F.gw; it2 < PER; it2 += F.NGW) {
            const int it = 2 * it2, l = it / PER; int r = it - l * PER;
            bf16_t* wsl = (bf16_t*)(F.ws + WS_WS + (size_t)l * WSL);
            if (r < I_WIN_) { tr_item2<0, false>(a->in[I_WIN] + (size_t)l * D * NIN, NIN, wsl, D, scr, r, F.lane); continue; } r -= I_WIN_;
            bf16_t* pt = wsl + 6 * MiB;
            if (r < I_PA_) { tr_item2<0, false>(a->in[I_PA] + (size_t)l * 256 * D, D, pt, D, scr, r, F.lane); continue; } r -= I_PA_;
            if (r < I_PA_) { tr_item2<0, false>(a->in[I_PB] + (size_t)l * 256 * D, D, pt + (size_t)D * D, D, scr, r, F.lane); continue; } r -= I_PA_;
            if (r < I_PC_) { tr_item2<0, false>(a->in[I_PC] + (size_t)l * 512 * D, D, pt + (size_t)2 * D * D, D, scr, r, F.lane); continue; } r -= I_PC_;
            tr_item2<0, false>(a->in[I_WOUT] + (size_t)l * D * D, D, wsl + 9 * MiB, D, scr, r, F.lane);
        }
        __syncthreads();
    }
    {
        LAS float* s = (LAS float*)F.lds;
        float* modp = (float*)(F.ws + WS_MODP);
        for (int u = F.bid; u < 192; u += F.G) {
            const int cb = u % 24, kc = u / 24, n = cb * 512 + F.tid, l = n / 6144, col = n - l * 6144;
            __syncthreads();
            for (int i = F.tid; i < 33 * 128; i += NTHREADS) { const int r = i >> 7, k = i & 127; const float c = (r < 32) ? a->in[I_C][r * D + kc * 128 + k] : a->in[I_CCTX][kc * 128 + k];
                s[i] = c * sigmoidf_(c); }
            __syncthreads();
            float acc[33];
#pragma unroll
            for (int r = 0; r < 33; ++r) acc[r] = 0.f;
            const float* w = a->in[I_ADAW] + ((size_t)l * D + kc * 128) * 6144 + col;
#pragma unroll 4
            for (int k = 0; k < 128; k += 4) {
                const float w0 = w[(size_t)k * 6144], w1 = w[(size_t)(k + 1) * 6144], w2 = w[(size_t)(k + 2) * 6144], w3 = w[(size_t)(k + 3) * 6144];
#pragma unroll
                for (int r = 0; r < 33; ++r) { const f32x4 sv = *(const LAS f32x4*)(s + r * 128 + k); acc[r] += sv.x * w0 + sv.y * w1 + sv.z * w2 + sv.w * w3; }
            }
#pragma unroll
            for (int r = 0; r < 33; ++r) modp[((size_t)(kc * 2 + l) * 33 + r) * 6144 + col] = acc[r];
        }
        __syncthreads();
    }
    {
        float* HF = (float*)(F.ws + WS_HF);
        for (int p = F.gw; p < 4096 + 256; p += F.NGW) {
            const bool isc = p >= 4096; const int l = isc ? 0 : (p >> 11), d = isc ? (p - 4096) : (p & 2047), L = isc ? 256 : 2048;
            const float t = (float)d / (float)(L - 1), w = 6.283185307179586f * (float)d / (float)L;
            const int lane = F.lane;
            float emb = 0.f;
            if (lane == 0) emb = t;
            else if (lane <= 32) { const int j = (lane - 1) & 15; const float f = 1e-4f + (float)j * ((15.0f - 1e-4f) / 15.0f); const float ang = f * w; emb = (lane <= 16) ? cosf(ang) : -sinf(ang); }
            const float* w1 = a->in[I_HYW1] + (size_t)l * 33 * 64; const float* w2 = a->in[I_HYW2] + (size_t)l * 64 * 64; const float* w3 = a->in[I_HYW3] + (size_t)l * 64 * 512;
            float z = a->in[I_HYB1][l * 64 + lane];
            for (int i = 0; i < 33; ++i) z += __shfl(emb, i) * w1[i * 64 + lane];
            const float h1 = sinf(z);
            z = a->in[I_HYB2][l * 64 + lane];
            for (int i = 0; i < 64; ++i) z += __shfl(h1, i) * w2[i * 64 + lane];
            const float h2 = sinf(z);
            float o[8];
#pragma unroll
            for (int m = 0; m < 8; ++m) o[m] = a->in[I_HYB3][l * 512 + lane + 64 * m];
            for (int i = 0; i < 64; ++i) { const float hv = __shfl(h2, i);
#pragma unroll
                for (int m = 0; m < 8; ++m) o[m] += hv * w3[i * 512 + lane + 64 * m]; }
            float* dst = isc ? (HF + (size_t)2 * 2048 * 512 + (size_t)d * 512) : (HF + ((size_t)l * 2048 + d) * 512);
            const float mind = -3.0701134573253945f, maxd = -15.350567286626973f;
#pragma unroll
            for (int m = 0; m < 8; ++m) { const int n = lane + 64 * m, c = n & 255; const float delta = fabsf(mind + (float)c * ((maxd - mind) / 255.0f));
                dst[n] = o[m] * (expf(-t * delta) + 0.05f); }
        }
    }
    {
        const float* src = a->in[I_GMWS]; unsigned* dst = (unsigned*)(F.ws + WS_WSB);
        for (int i = F.bid * NTHREADS + F.tid; i < 2 * 4 * 128 * 128 / 2; i += F.G * NTHREADS) dst[i] = pk2(src[2 * i], src[2 * i + 1]);
    }
    {
        float* COS = (float*)(F.ws + WS_ROPE); float* SIN = COS + 65536;
        for (int e = F.bid * NTHREADS + F.tid; e < 65536; e += F.G * NTHREADS) {
            const int t = e >> 5, ax = (e >> 4) & 1, i = e & 15; const float pos = (float)(ax ? (t & 63) : (t >> 6));
            const float inv = powf(10000.0f, -(float)i / 16.0f), ang = pos * inv;
            COS[e] = cosf(ang); SIN[e] = sinf(ang);
        }
    }
}

__device__ __forceinline__ void p0b_mod(Frame& F, ArgsP a) {
    const float* modp = (const float*)(F.ws + WS_MODP); float* mod = (float*)(F.ws + WS_MOD);
    for (int i = F.bid * NTHREADS + F.tid; i < 2 * 33 * 6144; i += F.G * NTHREADS) {
        const int l = i / (33 * 6144), rem = i - l * 33 * 6144, r = rem / 6144, col = rem - r * 6144;
        float s = a->in[I_ADAB][l * 6144 + col];
#pragma unroll
        for (int kc = 0; kc < 8; ++kc) s += modp[((size_t)(kc * 2 + l) * 33 + r) * 6144 + col];
        mod[i] = s;
    }
}

__device__ __forceinline__ int mod_row(int row) { return row < TL ? (row >> 11) : 32; }

__device__ __forceinline__ void phase_modulate0(Frame& F, ArgsP a) {
    const float* mod = (const float*)(F.ws + WS_MOD); bf16_t* HB = (bf16_t*)(F.ws + WS_HB);
    for (int row0 = F.gw; row0 < TA; row0 += 4 * F.NGW) {
        f32x4 xv[4][4];
#pragma unroll
        for (int q = 0; q < 4; ++q) { const int row = row0 + q * F.NGW; const float* src = row < TL ? a->in[I_X] + (size_t)row * D : a->in[I_CTX] + (size_t)(row - TL) * D;
#pragma unroll
            for (int j = 0; j < 4; ++j) xv[q][j] = *(const f32x4*)(src + 4 * F.lane + 256 * j); }
#pragma unroll
        for (int q = 0; q < 4; ++q) { const int row = row0 + q * F.NGW; const float* m = mod + (size_t)mod_row(row) * 6144;
            u32x2* dst = (u32x2*)(HB + (size_t)row * D);
#pragma unroll
            for (int j = 0; j < 4; ++j) { const int c = 4 * F.lane + 256 * j; const f32x4 x = xv[q][j], sh = *(const f32x4*)(m + c), sc = *(const f32x4*)(m + 1024 + c);
                const float h0 = x.x * (1.f + sc.x) + sh.x, h1 = x.y * (1.f + sc.y) + sh.y, h2 = x.z * (1.f + sc.z) + sh.z, h3 = x.w * (1.f + sc.w) + sh.w;
                u32x2 o; o.x = pk2(h0, h1); o.y = pk2(h2, h3); dst[F.lane + 64 * j] = o; } }
    }
}

struct SchedIn {
    int G, c, nreg, nctx; const char* A; const char* B;
    int nM;
    __device__ __forceinline__ bool next(int i, pg8::GU& u) const {
        const int L = i * G + c; if (L >= nreg + nctx) return false;
        int pm, pn;
        if (L < nreg) pg8::grid_order(L, nM, 11, pm, pn);
        else { const int j = L - nreg; pm = 256 + (j >> 2); pn = 7 + (j & 3); }
        u.A = A + (size_t)pm * 256 * 2048; u.B = B + (size_t)pn * 256 * 2048; u.gl = nullptr; u.K = 1024; u.kind = 0; u.pm = pm; u.pn = pn; u.e = 0; u.nvalid = 256;
        return true;
    }
};
struct EpiIn { static constexpr bool ALIGN = MK_ALIGN_EPIIN;
    bf16_t *ZG, *ZH, *Q, *K, *V; const float* COS;
    __device__ __forceinline__ void rope_store(const f32x4 (&acc)[2][2][4][2], const pg8::GU& u, int wr, int wc, int fr, int fq, bf16_t* base, int colt, float sc) const {
        const int row0 = u.pm * 256 + wr * 64 + fr, col0 = colt + wc * 32 + 8 * fq;
        const float sgn = (fq < 2) ? -1.0f : 1.0f; const bool lowhalf = fq < 2;
        const float* SIN = COS + 65536; const int toff = (wc & 1) * 16 + 8 * (fq & 1);
#pragma unroll
        for (int ai = 0; ai < 2; ++ai)
#pragma unroll
            for (int m = 0; m < 4; ++m) { const int row = row0 + ai * 128 + m * 16, t = row & (SEQ - 1);
                const f32x4 c0 = *(const f32x4*)(COS + t * 32 + toff), c1 = *(const f32x4*)(COS + t * 32 + toff + 4), s0 = *(const f32x4*)(SIN + t * 32 + toff) * sgn, s1 = *(const f32x4*)(SIN + t * 32 + toff + 4) * sgn;
#pragma unroll
                for (int bj = 0; bj < 2; ++bj) { const f32x4 v0 = acc[ai][bj][m][0], v1 = acc[ai][bj][m][1]; f32x4 p0, p1;
#pragma unroll
                    for (int j = 0; j < 4; ++j) {
                        auto ra = __builtin_amdgcn_permlane32_swap(__float_as_uint(v0[j]), __float_as_uint(v0[j]), false, false); p0[j] = __uint_as_float(lowhalf ? ra[1] : ra[0]);
                        auto rb = __builtin_amdgcn_permlane32_swap(__float_as_uint(v1[j]), __float_as_uint(v1[j]), false, false); p1[j] = __uint_as_float(lowhalf ? rb[1] : rb[0]); }
                    const f32x4 o0 = (v0 * c0 + p0 * s0) * sc, o1 = (v1 * c1 + p1 * s1) * sc;
                    u32x4 w; w.x = pk2(o0[0], o0[1]); w.y = pk2(o0[2], o0[3]); w.z = pk2(o1[0], o1[1]); w.w = pk2(o1[2], o1[3]);
                    *(u32x4*)(base + (size_t)row * 512 + col0 + bj * 128) = w; } }
    }
    __device__ __forceinline__ void operator()(const f32x4 (&acc)[2][2][4][2], const pg8::GU& u, int wr, int wc, int fr, int fq) const {
        const int pn = u.pn; bf16_t* base; int ldc, colt, act = 0; float sc = 1.f;
        if (MK_ROPE_EPI && pn >= 5 && pn < 9 && u.pm < 256) { if (pn < 7) rope_store(acc, u, wr, wc, fr, fq, Q, (pn - 5) * 256, QSCALE); else rope_store(acc, u, wr, wc, fr, fq, K, (pn - 7) * 256, 1.0f); return; }
        if (pn < 2) { base = ZG; ldc = 512; colt = pn * 256; act = 1; }
        else if (pn < 5) { base = ZH; ldc = 768; colt = (pn - 2) * 256; }
        else if (pn < 7) { base = Q; ldc = 512; colt = (pn - 5) * 256; sc = QSCALE; }
        else if (pn < 9) { base = K; ldc = 512; colt = (pn - 7) * 256; }
        else { base = V; ldc = 512; colt = (pn - 9) * 256; }
        const int row0 = u.pm * 256 + wr * 64 + fr, col0 = colt + wc * 32 + 8 * fq;
#pragma unroll
        for (int ai = 0; ai < 2; ++ai)
#pragma unroll
            for (int m = 0; m < 4; ++m) { bf16_t* rowp = base + (size_t)(row0 + ai * 128 + m * 16) * ldc + col0;
#pragma unroll
                for (int bj = 0; bj < 2; ++bj) { f32x4 v0 = acc[ai][bj][m][0], v1 = acc[ai][bj][m][1];
                    if (act) {
#pragma unroll
                        for (int j = 0; j < 4; ++j) { v0[j] = gelu_tanh(v0[j]); v1[j] = gelu_tanh(v1[j]); } }
                    else { v0 = v0 * sc; v1 = v1 * sc; }
                    u32x4 w; w.x = pk2(v0[0], v0[1]); w.y = pk2(v0[2], v0[3]); w.z = pk2(v1[0], v1[1]); w.w = pk2(v1[2], v1[3]);
                    *(u32x4*)(rowp + bj * 128) = w; } }
    }
};

__device__ __forceinline__ void gmlp_unit(Frame& F, ArgsP a, int l, int chunk) {
    const bf16_t* ZG = (const bf16_t*)(F.ws + WS_ZG); bf16_t* YC = (bf16_t*)(F.ws + WS_YCAT);
    LAS bf16_t* vT = (LAS bf16_t*)F.lds;
    const int row0 = chunk * 128, lane = F.lane;
    __syncthreads();
    {
        const f32x4 g = *(const f32x4*)(a->in[I_GMLNG] + l * 256 + 4 * lane), bb = *(const f32x4*)(a->in[I_GMLNB] + l * 256 + 4 * lane);
        u32x2 wv[16];
#pragma unroll
        for (int i = 0; i < 16; ++i) wv[i] = *(const u32x2*)(ZG + (size_t)(row0 + F.wave + 8 * i) * 512 + 256 + 4 * lane);
#pragma unroll
        for (int i0 = 0; i0 < 16; i0 += 4) {
            f32x4 v[4]; float s[4], qq[4];
#pragma unroll
            for (int k = 0; k < 4; ++k) { const u32x2 w = wv[i0 + k]; v[k] = (f32x4){bf_lo(w.x), bf_hi(w.x), bf_lo(w.y), bf_hi(w.y)}; s[k] = (v[k].x + v[k].y) + (v[k].z + v[k].w); }
#pragma unroll
            for (int o = 1; o < 64; o <<= 1)
#pragma unroll
                for (int k = 0; k < 4; ++k) s[k] += __shfl_xor(s[k], o);
#pragma unroll
            for (int k = 0; k < 4; ++k) { v[k] = v[k] - s[k] * (1.f / 256.f); qq[k] = (v[k].x * v[k].x + v[k].y * v[k].y) + (v[k].z * v[k].z + v[k].w * v[k].w); }
#pragma unroll
            for (int o = 1; o < 64; o <<= 1)
#pragma unroll
                for (int k = 0; k < 4; ++k) qq[k] += __shfl_xor(qq[k], o);
#pragma unroll
            for (int k = 0; k < 4; ++k) { const int q = F.wave + 8 * (i0 + k); const float rstd = 1.0f / sqrtf(qq[k] * (1.f / 256.f) + LN_EPS);
                const f32x4 y = v[k] * rstd * g + bb;
                const unsigned p01 = pk2(y.x, y.y), p23 = pk2(y.z, y.w);
                vT[(4 * lane + 0) * 136 + q] = (bf16_t)(p01 & 0xffffu); vT[(4 * lane + 1) * 136 + q] = (bf16_t)(p01 >> 16);
                vT[(4 * lane + 2) * 136 + q] = (bf16_t)(p23 & 0xffffu); vT[(4 * lane + 3) * 136 + q] = (bf16_t)(p23 >> 16); }
        }
    }
    __syncthreads();
    const int g = F.wave >> 1, ct = F.wave & 1, r32 = lane & 31, hi = lane >> 5;
    const bf16_t* wsb = (const bf16_t*)(F.ws + WS_WSB) + ((size_t)(l * 4 + g) * 128 + r32) * 128 + 8 * hi;
    const LAS unsigned char* vb = (const LAS unsigned char*)vT + (g * 64 + ct * 32 + r32) * 272 + 16 * hi;
    f32x16 acc[4];
#pragma unroll
    for (int pt = 0; pt < 4; ++pt) acc[pt] = (f32x16){0.f};
#pragma unroll
    for (int ks = 0; ks < 8; ++ks) { const bf16x8 B = *(const LAS bf16x8*)(vb + 32 * ks);
#pragma unroll
        for (int pt = 0; pt < 4; ++pt) { const bf16x8 A = *(const bf16x8*)(wsb + (size_t)pt * 32 * 128 + 16 * ks); acc[pt] = __builtin_amdgcn_mfma_f32_32x32x16_bf16(A, B, acc[pt], 0, 0, 0); } }
    const int c = g * 64 + ct * 32 + r32;
    const float* bsr = a->in[I_GMBS] + (l * 4 + g) * 128;
    LAS bf16_t* ot = (LAS bf16_t*)(F.lds + 73728);
#pragma unroll
    for (int pt = 0; pt < 4; ++pt)
#pragma unroll
        for (int r = 0; r < 16; ++r) { const int p = 32 * pt + (r & 3) + 8 * (r >> 2) + 4 * hi;
            ot[p * 264 + c] = (bf16_t)(pk2(acc[pt][r] + bsr[p], 0.f) & 0xffffu); }
    __syncthreads();
    for (int it = F.tid; it < 128 * 32; it += NTHREADS) { const int p = it >> 5, c8 = (it & 31) * 8;
        const u32x4 uw = *(const u32x4*)(ZG + (size_t)(row0 + p) * 512 + c8), ow = *(const LAS u32x4*)(ot + p * 264 + c8);
        u32x4 y; y.x = pk2(bf_lo(uw.x) * bf_lo(ow.x), bf_hi(uw.x) * bf_hi(ow.x)); y.y = pk2(bf_lo(uw.y) * bf_lo(ow.y), bf_hi(uw.y) * bf_hi(ow.y));
        y.z = pk2(bf_lo(uw.z) * bf_lo(ow.z), bf_hi(uw.z) * bf_hi(ow.z)); y.w = pk2(bf_lo(uw.w) * bf_lo(ow.w), bf_hi(uw.w) * bf_hi(ow.w));
        *(u32x4*)(YC + (size_t)(row0 + p) * 1024 + c8) = y; }
}

__device__ __forceinline__ void sconv_unit(Frame& F, ArgsP a, int l, int blk) {
    const bf16_t* ZH = (const bf16_t*)(F.ws + WS_ZH); bf16_t* X0 = (bf16_t*)(F.ws + WS_X0); bf16_t* VT = (bf16_t*)(F.ws + WS_VT);
    LAS bf16_t* vt = (LAS bf16_t*)F.lds;
    const int row0 = blk * 128; const bool lat = row0 < TL;
    const int Lseq = lat ? SEQ : CTXL, seq0 = lat ? (row0 & ~(SEQ - 1)) : TL + ((row0 - TL) & ~(CTXL - 1));
    const float* cw = a->in[I_HYCW] + (size_t)l * 3 * 768; const float* cb = a->in[I_HYCB] + (size_t)l * 768;
    __syncthreads();
    const int c = (F.tid & 31) * 8;
    float wt[3][4][8];
#pragma unroll
    for (int part = 0; part < 3; ++part)
#pragma unroll
        for (int k = 0; k < 4; ++k) { const float* s = (k < 3 ? cw + k * 768 : cb) + part * 256 + c; const f32x4 lo = *(const f32x4*)s, hi4 = *(const f32x4*)(s + 4);
#pragma unroll
            for (int j = 0; j < 4; ++j) { wt[part][k][j] = lo[j]; wt[part][k][4 + j] = hi4[j]; } }
    for (int it = F.tid; it < 128 * 32; it += NTHREADS) {
        const int rl = it >> 5, row = row0 + rl;
        const bool hasp = row > seq0, hasn = row < seq0 + Lseq - 1;
        float zc[3][8];
#pragma unroll
        for (int part = 0; part < 3; ++part) {
            const int col = part * 256 + c; const bf16_t* zp = ZH + (size_t)row * 768 + col;
            const u32x4 zero = {0u, 0u, 0u, 0u};
            const u32x4 z1 = *(const u32x4*)zp; const u32x4 z0 = hasp ? *(const u32x4*)(zp - 768) : zero; const u32x4 z2 = hasn ? *(const u32x4*)(zp + 768) : zero;
            const unsigned a0[4] = {z0.x, z0.y, z0.z, z0.w}, a1[4] = {z1.x, z1.y, z1.z, z1.w}, a2[4] = {z2.x, z2.y, z2.z, z2.w};
#pragma unroll
            for (int j = 0; j < 4; ++j) {
                zc[part][2 * j] = bf_lo(a0[j]) * wt[part][0][2 * j] + bf_lo(a1[j]) * wt[part][1][2 * j] + bf_lo(a2[j]) * wt[part][2][2 * j] + wt[part][3][2 * j];
                zc[part][2 * j + 1] = bf_hi(a0[j]) * wt[part][0][2 * j + 1] + bf_hi(a1[j]) * wt[part][1][2 * j + 1] + bf_hi(a2[j]) * wt[part][2][2 * j + 1] + wt[part][3][2 * j + 1];
            }
        }
        u32x4 o; o.x = pk2(zc[0][0], zc[0][1]); o.y = pk2(zc[0][2], zc[0][3]); o.z = pk2(zc[0][4], zc[0][5]); o.w = pk2(zc[0][6], zc[0][7]);
        *(u32x4*)(X0 + (size_t)row * 256 + c) = o;
#pragma unroll
        for (int j = 0; j < 8; ++j) vt[(c + j) * 136 + rl] = (bf16_t)(pk2(zc[2][j] * zc[1][j], 0.f) & 0xffffu);
    }
    __syncthreads();
    const size_t cstride = lat ? (size_t)TL : (size_t)TC; bf16_t* vbase = lat ? VT + row0 : VT + (size_t)256 * TL + (row0 - TL);
    for (int it = F.tid; it < 256 * 16; it += NTHREADS) {
        const int c = it >> 4, ch = it & 15;
        const u32x4 v = *(const LAS u32x4*)(vt + c * 136 + ch * 8);
        *(u32x4*)(vbase + (size_t)c * cstride + ch * 8) = v;
    }
}

__device__ __forceinline__ void rope_unit(Frame& F, int blk, const float sgn = 1.0f) {
    bf16_t* Q = (bf16_t*)(F.ws + WS_Q); bf16_t* K = (bf16_t*)(F.ws + WS_K);
    const float* COS = (const float*)(F.ws + WS_ROPE); const float* SIN = COS + 65536;
    const int row0 = blk * 128;
    for (int it = F.tid; it < 128 * 16; it += NTHREADS) {
        const int rl = it >> 4, which = (it >> 3) & 1, hm = it & 7, row = row0 + rl, t = row & (SEQ - 1);
        bf16_t* p = (which ? K : Q) + (size_t)row * 512 + hm * 64;
#pragma unroll
        for (int ax = 0; ax < 2; ++ax) {
            u32x4 x1[2], x2[2];
            x1[0] = *(const u32x4*)(p + ax * 32); x1[1] = *(const u32x4*)(p + ax * 32 + 8); x2[0] = *(const u32x4*)(p + ax * 32 + 16); x2[1] = *(const u32x4*)(p + ax * 32 + 24);
            const float* cs = COS + t * 32 + ax * 16; const float* sn = SIN + t * 32 + ax * 16;
            u32x4 o1[2], o2[2];
#pragma unroll
            for (int hh = 0; hh < 2; ++hh) {
                const unsigned a[4] = {x1[hh].x, x1[hh].y, x1[hh].z, x1[hh].w}, b[4] = {x2[hh].x, x2[hh].y, x2[hh].z, x2[hh].w}; unsigned r1[4], r2[4];
#pragma unroll
                for (int j = 0; j < 4; ++j) { const int i0 = hh * 8 + 2 * j; const float c0 = cs[i0], s0 = sgn * sn[i0], c1 = cs[i0 + 1], s1 = sgn * sn[i0 + 1];
                    const float a0 = bf_lo(a[j]), a1 = bf_hi(a[j]), b0 = bf_lo(b[j]), b1 = bf_hi(b[j]);
                    r1[j] = pk2(a0 * c0 - b0 * s0, a1 * c1 - b1 * s1); r2[j] = pk2(b0 * c0 + a0 * s0, b1 * c1 + a1 * s1); }
                o1[hh] = (u32x4){r1[0], r1[1], r1[2], r1[3]}; o2[hh] = (u32x4){r2[0], r2[1], r2[2], r2[3]};
            }
            *(u32x4*)(p + ax * 32) = o1[0]; *(u32x4*)(p + ax * 32 + 8) = o1[1]; *(u32x4*)(p + ax * 32 + 16) = o2[0]; *(u32x4*)(p + ax * 32 + 24) = o2[1];
        }
    }
}

constexpr int VX_STRIDE = 4112, PKT_OFF = 32 * VX_STRIDE;
template <int NTW>
__device__ __forceinline__ void conv_unit(Frame& F, ArgsP a, int l, int c, const float* HFsrc, const bf16_t* VTc, bf16_t* YTc) {
    constexpr int Lseq = NTW * 256, NS = Lseq / 16;
    LAS unsigned char* lds = F.lds;
    LAS unsigned* pkt = (LAS unsigned*)(lds + PKT_OFF);
    __syncthreads();
    const float skip = a->in[I_HYSKIP][l * 256 + c];
    for (int m = F.tid; m < 2 * Lseq; m += NTHREADS) {
        float r[2];
#pragma unroll
        for (int k = 0; k < 2; ++k) { const int d = Lseq - (m + k); float v = 0.f;
            if (d >= 0 && d < Lseq) { v = HFsrc[(size_t)d * 512 + c]; if (d == 0) v += skip; }
            else if (d < 0 && d > -Lseq) v = HFsrc[(size_t)(-d) * 512 + 256 + c];
            r[k] = v; }
        pkt[m] = pk2(r[0], r[1]);
    }
    for (int it = F.tid; it < 32 * (Lseq / 8); it += NTHREADS) { const int b = it / (Lseq / 8), ch = it % (Lseq / 8);
        *(LAS u32x4*)(lds + b * VX_STRIDE + ch * 16) = *(const u32x4*)(VTc + (size_t)b * Lseq + ch * 8); }
    __syncthreads();
    const int i = F.lane & 31, h = F.lane >> 5, w = F.wave;
    f32x16 acc[NTW];
#pragma unroll
    for (int ti = 0; ti < NTW; ++ti) acc[ti] = (f32x16){0.f};
    const LAS unsigned char* bbase = lds + i * VX_STRIDE + h * 16;
    const int dlo = 2 * NTW * w - (NS - 1), dhi = 2 * (NTW * w + NTW - 1);
#define CV_LOAD(AF, BF, DL) do { const int ms_ = Lseq - 16 * (DL) - i + 8 * h; u32x4 af_; af_.x = pkt[ms_]; af_.y = pkt[ms_ + 2]; af_.z = pkt[ms_ + 4]; af_.w = pkt[ms_ + 6]; AF = __builtin_bit_cast(bf16x8, af_); \
        _Pragma("unroll") for (int ti = 0; ti < NTW; ++ti) { const int sj_ = 2 * (NTW * w + ti) - (DL), sjc_ = sj_ < 0 ? 0 : (sj_ >= NS ? NS - 1 : sj_); BF[ti] = *(const LAS bf16x8*)(bbase + sjc_ * 32); } } while (0)
#define CV_MMA(AF, BF, DL) do { _Pragma("unroll") for (int ti = 0; ti < NTW; ++ti) { const int sj_ = 2 * (NTW * w + ti) - (DL); \
        if (sj_ >= 0 && sj_ < NS) acc[ti] = __builtin_amdgcn_mfma_f32_32x32x16_bf16(AF, BF[ti], acc[ti], 0, 0, 0); } } while (0)
    bf16x8 A0, A1, B0[NTW], B1[NTW];
    CV_LOAD(A0, B0, dlo);
    for (int dl = dlo; dl <= dhi; dl += 2) {
        CV_LOAD(A1, B1, dl + 1);
        CV_MMA(A0, B0, dl);
        if (dl + 2 <= dhi) CV_LOAD(A0, B0, dl + 2);
        CV_MMA(A1, B1, dl + 1);
    }
#undef CV_LOAD
#undef CV_MMA
#pragma unroll
    for (int ti = 0; ti < NTW; ++ti)
#pragma unroll
        for (int g = 0; g < 4; ++g) { const int t = 32 * (NTW * w + ti) + 8 * g + 4 * h;
            u32x2 o; o.x = pk2(acc[ti][4 * g], acc[ti][4 * g + 1]); o.y = pk2(acc[ti][4 * g + 2], acc[ti][4 * g + 3]);
            *(u32x2*)(YTc + (size_t)i * Lseq + t) = o; }
}

template <int R>
__device__ __forceinline__ void ytrans_unit(Frame& F, int blk) {
    const bf16_t* YT = (const bf16_t*)(F.ws + WS_YT); const bf16_t* X0 = (const bf16_t*)(F.ws + WS_X0); bf16_t* YC = (bf16_t*)(F.ws + WS_YCAT);
    LAS bf16_t* tl = (LAS bf16_t*)F.lds;
    const int row0 = blk * R; const bool lat = row0 < TL;
    const size_t cstride = lat ? (size_t)TL : (size_t)TC; const bf16_t* ybase = lat ? YT + row0 : YT + (size_t)256 * TL + (row0 - TL);
    __syncthreads();
    for (int it = F.tid; it < 256 * (R / 8); it += NTHREADS) { const int c = it / (R / 8), ch = it % (R / 8);
        *(LAS u32x4*)(tl + c * (R + 8) + ch * 8) = *(const u32x4*)(ybase + (size_t)c * cstride + ch * 8); }
    __syncthreads();
    for (int it = F.tid; it < R * 32; it += NTHREADS) {
        const int cg = it / R, rl = it % R, row = row0 + rl, c = cg * 8;
        const u32x4 x = *(const u32x4*)(X0 + (size_t)row * 256 + c); const unsigned xs[4] = {x.x, x.y, x.z, x.w}; unsigned o[4];
#pragma unroll
        for (int j = 0; j < 4; ++j) o[j] = pk2(bf1(tl[(c + 2 * j) * (R + 8) + rl]) * bf_lo(xs[j]), bf1(tl[(c + 2 * j + 1) * (R + 8) + rl]) * bf_hi(xs[j]));
        *(u32x4*)(YC + (size_t)row * 1024 + 256 + c) = (u32x4){o[0], o[1], o[2], o[3]};
    }
}

namespace att {
#define KSWZ(row, colB) ((row) * 256 + ((colB) ^ (((row) & 7) << 4)))
__device__ __forceinline__ int crow(int r, int hi) { return (r & 3) + 8 * (r >> 2) + 4 * hi; }
__device__ __forceinline__ int v_st(int k, int c) { const int kk = (k & ~0xC) | ((k & 4) << 1) | ((k & 8) >> 1); return ((kk >> 3) * 4 + (c >> 5)) * 512 + ((kk & 7) * 32 + (c & 31)) * 2; }
__device__ __forceinline__ int v_rd_base(int lane) { return ((lane & 3) << 3) | (((lane >> 2) & 3) << 6) | (((lane >> 4) & 1) << 5) | (((lane >> 5) & 1) << 8); }
constexpr int v_rd_off(int d0, int ks, int half) { return d0 * 512 + ks * 4096 + half * 2048; }
template <int OFF> __device__ __forceinline__ s16x4 tr_read(int vb) {
    s16x4 r; asm volatile("ds_read_b64_tr_b16 %0, %1 offset:%2" : "=&v"(r) : "v"(vb), "i"(OFF) : "memory"); return r;
}
template <int D0> __device__ __forceinline__ void pv_one(f32x16& od, int vb, bf16x8 pa0, bf16x8 pa1, bf16x8 pa2, bf16x8 pa3) {
    const s16x4 l0 = tr_read<v_rd_off(D0, 0, 0)>(vb), h0 = tr_read<v_rd_off(D0, 0, 1)>(vb), l1 = tr_read<v_rd_off(D0, 1, 0)>(vb), h1 = tr_read<v_rd_off(D0, 1, 1)>(vb);
    const s16x4 l2 = tr_read<v_rd_off(D0, 2, 0)>(vb), h2 = tr_read<v_rd_off(D0, 2, 1)>(vb), l3 = tr_read<v_rd_off(D0, 3, 0)>(vb), h3 = tr_read<v_rd_off(D0, 3, 1)>(vb);
    asm volatile("s_waitcnt lgkmcnt(0)" ::: "memory"); __builtin_amdgcn_sched_barrier(0);
#define ATT_PK(L, H) (bf16x8){L[0], L[1], L[2], L[3], H[0], H[1], H[2], H[3]}
    od = __builtin_amdgcn_mfma_f32_32x32x16_bf16(pa0, ATT_PK(l0, h0), od, 0, 0, 0);
    od = __builtin_amdgcn_mfma_f32_32x32x16_bf16(pa1, ATT_PK(l1, h1), od, 0, 0, 0);
    od = __builtin_amdgcn_mfma_f32_32x32x16_bf16(pa2, ATT_PK(l2, h2), od, 0, 0, 0);
    od = __builtin_amdgcn_mfma_f32_32x32x16_bf16(pa3, ATT_PK(l3, h3), od, 0, 0, 0);
#undef ATT_PK
}
__device__ __forceinline__ void qkt2(f32x16& a0, f32x16& a1, f32x16& b0, f32x16& b1, const LAS char* Ks, const bf16x8 (&qr)[8], int r32, int hi) {
    a0 = (f32x16){0.f}; a1 = (f32x16){0.f}; b0 = (f32x16){0.f}; b1 = (f32x16){0.f};
#pragma unroll
    for (int d0 = 0; d0 < 4; ++d0) { const int cb = (d0 * 16 + hi * 8) * 2;
        const bf16x8 k0 = *(const LAS bf16x8*)(Ks + KSWZ(r32, cb)), k1 = *(const LAS bf16x8*)(Ks + KSWZ(32 + r32, cb));
        a0 = __builtin_amdgcn_mfma_f32_32x32x16_bf16(k0, qr[d0], a0, 0, 0, 0); a1 = __builtin_amdgcn_mfma_f32_32x32x16_bf16(k1, qr[d0], a1, 0, 0, 0); }
#pragma unroll
    for (int d0 = 4; d0 < 8; ++d0) { const int cb = (d0 * 16 + hi * 8) * 2;
        const bf16x8 k0 = *(const LAS bf16x8*)(Ks + KSWZ(r32, cb)), k1 = *(const LAS bf16x8*)(Ks + KSWZ(32 + r32, cb));
        b0 = __builtin_amdgcn_mfma_f32_32x32x16_bf16(k0, qr[d0], b0, 0, 0, 0); b1 = __builtin_amdgcn_mfma_f32_32x32x16_bf16(k1, qr[d0], b1, 0, 0, 0); }
}
__device__ __forceinline__ float xhalf_max(float v) { auto rr = __builtin_amdgcn_permlane32_swap(__float_as_uint(v), __float_as_uint(v), false, false); return fmaxf(__uint_as_float(rr[0]), __uint_as_float(rr[1])); }
__device__ __forceinline__ float xhalf_sum(float v) { auto rr = __builtin_amdgcn_permlane32_swap(__float_as_uint(v), __float_as_uint(v), false, false); return __uint_as_float(rr[0]) + __uint_as_float(rr[1]); }
constexpr float THR2 = 8.0f;
__device__ __forceinline__ void partialSM(f32x16& p0, f32x16& p1, float& m_reg, float& mn, float& alpha) {
    float pmax = p0[0];
#pragma unroll
    for (int r = 1; r < 16; ++r) pmax = fmaxf(pmax, p0[r]);
#pragma unroll
    for (int r = 0; r < 16; ++r) pmax = fmaxf(pmax, p1[r]);
    pmax = xhalf_max(pmax);
    if (__builtin_expect(__all(pmax - m_reg <= THR2), 1)) { mn = m_reg; alpha = 1.f; }
    else { mn = fmaxf(m_reg, pmax); alpha = fast_exp2(m_reg - mn); m_reg = mn; }
#pragma unroll
    for (int r = 0; r < 16; ++r) p0[r] -= mn;
#pragma unroll
    for (int r = 0; r < 16; ++r) p1[r] -= mn;
#pragma unroll
    for (int r = 0; r < 16; ++r) p0[r] = fast_exp2(p0[r]);
}
__device__ __forceinline__ void finishSM(f32x16& p0, f32x16& p1, float alpha, float& l_reg, bf16x8& pa0, bf16x8& pa1, bf16x8& pa2, bf16x8& pa3) {
#pragma unroll
    for (int r = 0; r < 16; ++r) p1[r] = fast_exp2(p1[r]);
    float ps = 0.f;
#pragma unroll
    for (int r = 0; r < 16; ++r) ps += p0[r];
#pragma unroll
    for (int r = 0; r < 16; ++r) ps += p1[r];
    ps = xhalf_sum(ps);
    l_reg = l_reg * alpha + ps;
#define ATT_PK4(P, BASE, OUT) do { unsigned x0_ = pk2(P[BASE + 0], P[BASE + 1]), x1_ = pk2(P[BASE + 2], P[BASE + 3]); \
        unsigned y0_ = pk2(P[BASE + 4], P[BASE + 5]), y1_ = pk2(P[BASE + 6], P[BASE + 7]); \
        auto r0_ = __builtin_amdgcn_permlane32_swap(x0_, y0_, false, false); auto r1_ = __builtin_amdgcn_permlane32_swap(x1_, y1_, false, false); \
        u32x4 w_ = {r0_[0], r1_[0], r0_[1], r1_[1]}; OUT = __builtin_bit_cast(bf16x8, w_); } while (0)
    ATT_PK4(p0, 0, pa0); ATT_PK4(p0, 8, pa1); ATT_PK4(p1, 0, pa2); ATT_PK4(p1, 8, pa3);
#undef ATT_PK4
}
__device__ __forceinline__ void qkt1(f32x16& p0, f32x16& p1, const LAS char* Ks, const bf16x8 (&qr)[4], int r32, int hi, int mcb) {
    p0 = (f32x16){0.f}; p1 = (f32x16){0.f};
#pragma unroll
    for (int d0 = 0; d0 < 4; ++d0) { const int cb = mcb + (d0 * 16 + hi * 8) * 2;
        const bf16x8 k0 = *(const LAS bf16x8*)(Ks + KSWZ(r32, cb)), k1 = *(const LAS bf16x8*)(Ks + KSWZ(32 + r32, cb));
        p0 = __builtin_amdgcn_mfma_f32_32x32x16_bf16(k0, qr[d0], p0, 0, 0, 0); p1 = __builtin_amdgcn_mfma_f32_32x32x16_bf16(k1, qr[d0], p1, 0, 0, 0); }
}
template <int KS> __device__ __forceinline__ void pv_step(f32x16 (&o)[4], int vb, bf16x8 pa) {
    const s16x4 l0 = tr_read<v_rd_off(0, KS, 0)>(vb), h0 = tr_read<v_rd_off(0, KS, 1)>(vb), l1 = tr_read<v_rd_off(1, KS, 0)>(vb), h1 = tr_read<v_rd_off(1, KS, 1)>(vb);
    const s16x4 l2 = tr_read<v_rd_off(2, KS, 0)>(vb), h2 = tr_read<v_rd_off(2, KS, 1)>(vb), l3 = tr_read<v_rd_off(3, KS, 0)>(vb), h3 = tr_read<v_rd_off(3, KS, 1)>(vb);
    asm volatile("s_waitcnt lgkmcnt(0)" ::: "memory"); __builtin_amdgcn_sched_barrier(0);
#define ATT_PK(L, H) (bf16x8){L[0], L[1], L[2], L[3], H[0], H[1], H[2], H[3]}
    o[0] = __builtin_amdgcn_mfma_f32_32x32x16_bf16(pa, ATT_PK(l0, h0), o[0], 0, 0, 0);
    o[1] = __builtin_amdgcn_mfma_f32_32x32x16_bf16(pa, ATT_PK(l1, h1), o[1], 0, 0, 0);
    o[2] = __builtin_amdgcn_mfma_f32_32x32x16_bf16(pa, ATT_PK(l2, h2), o[2], 0, 0, 0);
    o[3] = __builtin_amdgcn_mfma_f32_32x32x16_bf16(pa, ATT_PK(l3, h3), o[3], 0, 0, 0);
#undef ATT_PK
}
__device__ __forceinline__ void pv_d0(f32x16 (&o)[4], int vb, bf16x8 pa0, bf16x8 pa1, bf16x8 pa2, bf16x8 pa3) {
    pv_step<0>(o, vb, pa0); pv_step<1>(o, vb, pa1); pv_step<2>(o, vb, pa2); pv_step<3>(o, vb, pa3);
}
}

struct AttnUnit { int qrow0, h, klat0, nlat, kctx0, nt; };

constexpr int ATT_V = 0, ATT_K = 32768, ATT_WS = 65536, ATT_XCH = 65536 + 2048;
__device__ __forceinline__ void attn_unit(Frame& F, ArgsP a, int l, const AttnUnit& U, float lam, float lam_init) {
    using namespace att;
    const bf16_t* Qg = (const bf16_t*)(F.ws + WS_Q); const bf16_t* Kg = (const bf16_t*)(F.ws + WS_K); const bf16_t* Vg = (const bf16_t*)(F.ws + WS_V);
    bf16_t* YC = (bf16_t*)(F.ws + WS_YCAT);
    const int tid = F.tid, wid = F.wave, lane = F.lane, r32 = lane & 31, hi = lane >> 5, mp = wid >> 2, wq = wid & 3, mcb = mp * 128;
    LAS char* V_lds = (LAS char*)F.lds + ATT_V; LAS char* K_lds = (LAS char*)F.lds + ATT_K;
    LAS float* wsf = (LAS float*)(F.lds + ATT_WS) + wid * 64; LAS float* li_l = wsf; LAS float* al_l = wsf + 32;
    float m_reg = -1e30f, l_reg = 0.f; f32x16 o[4];
#pragma unroll
    for (int d = 0; d < 4; ++d) o[d] = (f32x16){0.f};
    bf16x8 qr[4];
    { const bf16_t* Qw = Qg + (size_t)(U.qrow0 + wq * 32 + r32) * 512 + U.h * 128 + mp * 64 + hi * 8;
#pragma unroll
      for (int d0 = 0; d0 < 4; ++d0) qr[d0] = *(const bf16x8*)(Qw + d0 * 16); }
    const int sr = tid >> 4, sc = (tid & 15) * 8;
    const int kst0 = KSWZ(sr, sc * 2), kst1 = KSWZ(32 + sr, sc * 2), vst0 = v_st(sr, sc), vst1 = v_st(32 + sr, sc);
    const int hoff = U.h * 128 + sc;
    const int vb0 = (int)(uintptr_t)V_lds + v_rd_base(lane);
#define KROW(j) ((j) < U.nlat ? U.klat0 + 64 * (j) : U.kctx0 + 64 * ((j) - U.nlat))
    bf16x8 s0v0, s0v1, s0k0, s0k1, s1v0, s1v1, s1k0, s1k1;
#define SLOAD0(j) do { const int kr_ = KROW(j); const size_t g0_ = (size_t)(kr_ + sr) * 512 + hoff, g1_ = (size_t)(kr_ + 32 + sr) * 512 + hoff; \
        s0v0 = *(const bf16x8*)(Vg + g0_); s0v1 = *(const bf16x8*)(Vg + g1_); s0k0 = *(const bf16x8*)(Kg + g0_); s0k1 = *(const bf16x8*)(Kg + g1_); } while (0)
#define SLOAD1(j) do { const int kr_ = KROW(j); const size_t g0_ = (size_t)(kr_ + sr) * 512 + hoff, g1_ = (size_t)(kr_ + 32 + sr) * 512 + hoff; \
        s1v0 = *(const bf16x8*)(Vg + g0_); s1v1 = *(const bf16x8*)(Vg + g1_); s1k0 = *(const bf16x8*)(Kg + g0_); s1k1 = *(const bf16x8*)(Kg + g1_); } while (0)
#define SWRITE0(b) do { *(LAS bf16x8*)(V_lds + (b) * 16384 + vst0) = s0v0; *(LAS bf16x8*)(V_lds + (b) * 16384 + vst1) = s0v1; \
        *(LAS bf16x8*)(K_lds + (b) * 16384 + kst0) = s0k0; *(LAS bf16x8*)(K_lds + (b) * 16384 + kst1) = s0k1; } while (0)
#define SWRITE1(b) do { *(LAS bf16x8*)(V_lds + (b) * 16384 + vst0) = s1v0; *(LAS bf16x8*)(V_lds + (b) * 16384 + vst1) = s1v1; \
        *(LAS bf16x8*)(K_lds + (b) * 16384 + kst0) = s1k0; *(LAS bf16x8*)(K_lds + (b) * 16384 + kst1) = s1k1; } while (0)
#define SWAIT() asm volatile("s_waitcnt vmcnt(4)" ::: "memory")
#define SBAR() __builtin_amdgcn_sched_barrier(0)
#define LBAR() do { asm volatile("s_waitcnt lgkmcnt(0)" ::: "memory"); __builtin_amdgcn_s_barrier(); asm volatile("" ::: "memory"); } while (0)
#define RESC(av) do { if (__any((av) < 1.f)) { if (hi == 0) al_l[r32] = (av); asm volatile("s_waitcnt lgkmcnt(0)" ::: "memory"); \
        _Pragma("unroll") for (int d_ = 0; d_ < 4; ++d_) _Pragma("unroll") for (int r_ = 0; r_ < 16; ++r_) o[d_][r_] *= al_l[crow(r_, hi)]; } } while (0)
    f32x16 pA0, pA1, pB0, pB1; float mnA, mnB, alA, alB; bf16x8 pa0, pa1, pa2, pa3; const int NT = U.nt;
    __syncthreads();
    SLOAD0(0); asm volatile("s_waitcnt vmcnt(0)" ::: "memory"); SWRITE0(0); __syncthreads();
    qkt1(pA0, pA1, K_lds, qr, r32, hi, mcb); partialSM(pA0, pA1, m_reg, mnA, alA);
    SLOAD1(1); if (2 < NT) SLOAD0(2);
    SWAIT(); SWRITE1(1); __syncthreads();
    for (int j = 1; j + 1 < NT; j += 2) {
        SBAR(); qkt1(pB0, pB1, K_lds + 16384, qr, r32, hi, mcb);
        finishSM(pA0, pA1, alA, l_reg, pa0, pa1, pa2, pa3); SBAR();
        SLOAD1(j + 2); SBAR();
        pv_d0(o, vb0, pa0, pa1, pa2, pa3); partialSM(pB0, pB1, m_reg, mnB, alB);
        __syncthreads(); SWAIT(); SWRITE0(0);
        RESC(alB); __syncthreads();
        SBAR(); qkt1(pA0, pA1, K_lds, qr, r32, hi, mcb);
        finishSM(pB0, pB1, alB, l_reg, pa0, pa1, pa2, pa3); SBAR();
        if (j + 3 < NT) SLOAD0(j + 3);
        SBAR();
        pv_d0(o, vb0 + 16384, pa0, pa1, pa2, pa3); partialSM(pA0, pA1, m_reg, mnA, alA);
        __syncthreads(); SWAIT(); SWRITE1(1);
        RESC(alA); __syncthreads();
    }
    SBAR(); qkt1(pB0, pB1, K_lds + 16384, qr, r32, hi, mcb);
    finishSM(pA0, pA1, alA, l_reg, pa0, pa1, pa2, pa3); SBAR();
    pv_d0(o, vb0, pa0, pa1, pa2, pa3); partialSM(pB0, pB1, m_reg, mnB, alB);
    __syncthreads(); RESC(alB);
    finishSM(pB0, pB1, alB, l_reg, pa0, pa1, pa2, pa3); SBAR();
    pv_d0(o, vb0 + 16384, pa0, pa1, pa2, pa3);
#undef KROW
#undef SLOAD0
#undef SLOAD1
#undef SWRITE0
#undef SWRITE1
#undef SWAIT
#undef SBAR
#undef LBAR
#undef RESC
    if (hi == 0) li_l[r32] = l_reg;
    asm volatile("s_waitcnt lgkmcnt(0)" ::: "memory");
    const float fac = mp ? lam : 1.0f;
    float rli[16];
#pragma unroll
    for (int r = 0; r < 16; ++r) rli[r] = fac * fast_rcp(li_l[crow(r, hi)]);
    LAS float* xch = (LAS float*)(F.lds + ATT_XCH) + wq * 4096;
    if (mp == 1) {
#pragma unroll
        for (int r = 0; r < 16; ++r)
#pragma unroll
            for (int d = 0; d < 4; ++d) xch[crow(r, hi) * 128 + 32 * d + r32] = o[d][r] * rli[r];
    }
    __syncthreads();
    if (mp == 0) {
        const float* gn = a->in[I_DANG] + l * 128;
        float gv[4];
#pragma unroll
        for (int d = 0; d < 4; ++d) gv[d] = gn[32 * d + r32] * (1.0f - lam_init);
#pragma unroll
        for (int r = 0; r < 16; ++r) {
            float ov[4];
#pragma unroll
            for (int d = 0; d < 4; ++d) ov[d] = o[d][r] * rli[r] - xch[crow(r, hi) * 128 + 32 * d + r32];
            float ss = (ov[0] * ov[0] + ov[1] * ov[1]) + (ov[2] * ov[2] + ov[3] * ov[3]);
#pragma unroll
            for (int x = 1; x < 32; x <<= 1) ss += __shfl_xor(ss, x);
            const float inv = 1.0f / sqrtf(ss * (1.0f / 128.0f) + LN_EPS);
            bf16_t* yrow = YC + (size_t)(U.qrow0 + wq * 32 + crow(r, hi)) * 1024 + 512 + U.h * 128 + r32;
#pragma unroll
            for (int d = 0; d < 4; ++d) yrow[32 * d] = (bf16_t)(pk2(ov[d] * inv * gv[d], 0.f) & 0xffffu);
        }
    }
}
namespace att {
__device__ __forceinline__ void stats(const f32x16& x0, const f32x16& x1, float& m, float& l) {
    float t = x0[0];
#pragma unroll
    for (int r = 1; r < 16; ++r) t = fmaxf(t, x0[r]);
#pragma unroll
    for (int r = 0; r < 16; ++r) t = fmaxf(t, x1[r]);
    t = xhalf_max(t);
    const float mn = fmaxf(m, t);
    float s = 0.f;
#pragma unroll
    for (int r = 0; r < 16; ++r) s += fast_exp2(x0[r] - mn);
#pragma unroll
    for (int r = 0; r < 16; ++r) s += fast_exp2(x1[r] - mn);
    s = xhalf_sum(s);
    l = l * fast_exp2(m - mn) + s; m = mn;
}
}

__device__ __forceinline__ void attn_unit_v1(Frame& F, ArgsP a, int l, const AttnUnit& U, float lam, float lam_init) {
    using namespace att;
    const bf16_t* Qg = (const bf16_t*)(F.ws + WS_Q); const bf16_t* Kg = (const bf16_t*)(F.ws + WS_K); const bf16_t* Vg = (const bf16_t*)(F.ws + WS_V);
    bf16_t* YC = (bf16_t*)(F.ws + WS_YCAT);
    const int tid = F.tid, wid = F.wave, lane = F.lane, r32 = lane & 31, hi = lane >> 5;
    LAS char* K_lds = (LAS char*)F.lds; LAS char* V_lds = (LAS char*)F.lds + 32768;
    bf16x8 qr[8];
    { const bf16_t* Qw = Qg + (size_t)(U.qrow0 + wid * 32 + r32) * 512 + U.h * 128 + hi * 8;
#pragma unroll
      for (int d0 = 0; d0 < 8; ++d0) qr[d0] = *(const bf16x8*)(Qw + d0 * 16); }
    const int sr = tid >> 4, sc = (tid & 15) * 8;
    const int kst0 = KSWZ(sr, sc * 2), kst1 = KSWZ(32 + sr, sc * 2), vst0 = v_st(sr, sc), vst1 = v_st(32 + sr, sc);
    const int hoff = U.h * 128 + sc;
#define KROW(j) ((j) < U.nlat ? U.klat0 + 64 * (j) : U.kctx0 + 64 * ((j) - U.nlat))
    float m0 = -1e30f, l0 = 0.f, m1 = -1e30f, l1 = 0.f;
    bf16x8 ks0, ks1, vs0, vs1;
    __syncthreads();
    { const int kr = KROW(0); ks0 = *(const bf16x8*)(Kg + (size_t)(kr + sr) * 512 + hoff); ks1 = *(const bf16x8*)(Kg + (size_t)(kr + 32 + sr) * 512 + hoff); }
    *(LAS bf16x8*)(K_lds + kst0) = ks0; *(LAS bf16x8*)(K_lds + kst1) = ks1;
    __syncthreads();
    for (int j = 0; j < U.nt; ++j) {
        const bool more = j + 1 < U.nt;
        if (more) { const int kr = KROW(j + 1); ks0 = *(const bf16x8*)(Kg + (size_t)(kr + sr) * 512 + hoff); ks1 = *(const bf16x8*)(Kg + (size_t)(kr + 32 + sr) * 512 + hoff); }
        f32x16 a0, a1, b0, b1;
        qkt2(a0, a1, b0, b1, K_lds + (j & 1) * 16384, qr, r32, hi);
        stats(a0, a1, m0, l0); stats(b0, b1, m1, l1);
        if (more) { LAS char* kb = K_lds + ((j + 1) & 1) * 16384; *(LAS bf16x8*)(kb + kst0) = ks0; *(LAS bf16x8*)(kb + kst1) = ks1; }
        __syncthreads();
    }
    const float c0 = 1.0f / l0, c1 = lam / l1;
    f32x16 o[4];
#pragma unroll
    for (int d = 0; d < 4; ++d) o[d] = (f32x16){0.f};
    const int vb0 = (int)(uintptr_t)V_lds + v_rd_base(lane);
    { const int kr = KROW(0); const size_t g0 = (size_t)(kr + sr) * 512 + hoff, g1 = (size_t)(kr + 32 + sr) * 512 + hoff;
      ks0 = *(const bf16x8*)(Kg + g0); ks1 = *(const bf16x8*)(Kg + g1); vs0 = *(const bf16x8*)(Vg + g0); vs1 = *(const bf16x8*)(Vg + g1); }
    *(LAS bf16x8*)(K_lds + kst0) = ks0; *(LAS bf16x8*)(K_lds + kst1) = ks1; *(LAS bf16x8*)(V_lds + vst0) = vs0; *(LAS bf16x8*)(V_lds + vst1) = vs1;
    __syncthreads();
    for (int j = 0; j < U.nt; ++j) {
        const bool more = j + 1 < U.nt;
        if (more) { const int kr = KROW(j + 1); const size_t g0 = (size_t)(kr + sr) * 512 + hoff, g1 = (size_t)(kr + 32 + sr) * 512 + hoff;
            ks0 = *(const bf16x8*)(Kg + g0); ks1 = *(const bf16x8*)(Kg + g1); vs0 = *(const bf16x8*)(Vg + g0); vs1 = *(const bf16x8*)(Vg + g1); }
        f32x16 a0, a1, b0, b1;
        qkt2(a0, a1, b0, b1, K_lds + (j & 1) * 16384, qr, r32, hi);
#pragma unroll
        for (int r = 0; r < 16; ++r) { a0[r] = fast_exp2(a0[r] - m0) * c0 - fast_exp2(b0[r] - m1) * c1; a1[r] = fast_exp2(a1[r] - m0) * c0 - fast_exp2(b1[r] - m1) * c1; }
        bf16x8 pa0, pa1, pa2, pa3;
#define ATT_PK4(P, BASE, OUT) do { unsigned x0_ = pk2(P[BASE + 0], P[BASE + 1]), x1_ = pk2(P[BASE + 2], P[BASE + 3]); \
            unsigned y0_ = pk2(P[BASE + 4], P[BASE + 5]), y1_ = pk2(P[BASE + 6], P[BASE + 7]); \
            auto r0_ = __builtin_amdgcn_permlane32_swap(x0_, y0_, false, false); auto r1_ = __builtin_amdgcn_permlane32_swap(x1_, y1_, false, false); \
            u32x4 w_ = {r0_[0], r1_[0], r0_[1], r1_[1]}; OUT = __builtin_bit_cast(bf16x8, w_); } while (0)
        ATT_PK4(a0, 0, pa0); ATT_PK4(a0, 8, pa1); ATT_PK4(a1, 0, pa2); ATT_PK4(a1, 8, pa3);
#undef ATT_PK4
        const int vb = vb0 + (j & 1) * 16384;
        pv_one<0>(o[0], vb, pa0, pa1, pa2, pa3); pv_one<1>(o[1], vb, pa0, pa1, pa2, pa3); pv_one<2>(o[2], vb, pa0, pa1, pa2, pa3); pv_one<3>(o[3], vb, pa0, pa1, pa2, pa3);
        if (more) { LAS char* kb = K_lds + ((j + 1) & 1) * 16384; LAS char* vbuf = V_lds + ((j + 1) & 1) * 16384;
            *(LAS bf16x8*)(kb + kst0) = ks0; *(LAS bf16x8*)(kb + kst1) = ks1; *(LAS bf16x8*)(vbuf + vst0) = vs0; *(LAS bf16x8*)(vbuf + vst1) = vs1; }
        __syncthreads();
    }
#undef KROW
    const float* gn = a->in[I_DANG] + l * 128;
    float gv[4];
#pragma unroll
    for (int d = 0; d < 4; ++d) gv[d] = gn[32 * d + r32] * (1.0f - lam_init);
#pragma unroll
    for (int r = 0; r < 16; ++r) {
        float ss = (o[0][r] * o[0][r] + o[1][r] * o[1][r]) + (o[2][r] * o[2][r] + o[3][r] * o[3][r]);
#pragma unroll
        for (int x = 1; x < 32; x <<= 1) ss += __shfl_xor(ss, x);
        const float inv = 1.0f / sqrtf(ss * (1.0f / 128.0f) + LN_EPS);
        bf16_t* yrow = YC + (size_t)(U.qrow0 + wid * 32 + crow(r, hi)) * 1024 + 512 + U.h * 128 + r32;
#pragma unroll
        for (int d = 0; d < 4; ++d) yrow[32 * d] = (bf16_t)(pk2(o[d][r] * inv * gv[d], 0.f) & 0xffffu);
    }
}


struct SchedMerge {
    int G, c, nM; const char *HB, *YCAT, *WinT, *PT;
    __device__ __forceinline__ bool next(int i, pg8::GU& u) const {
        const int tile = i / 6, sub = i - tile * 6, L = tile * G + c; if (L >= nM * 4) return false;
        int pm, pn; pg8::grid_order(L, nM, 4, pm, pn);
        const int br = sub >> 1;
        if (sub & 1) { u.A = HB + (size_t)pm * 256 * 2048; u.B = WinT + (size_t)(OFF_GATE + br * 1024 + pn * 256) * 2048; u.K = 1024; }
        else { u.A = YCAT + (size_t)pm * 256 * 2048 + (br == 0 ? 0 : (br == 1 ? 512 : 1024)); u.B = PT + (size_t)br * 1024 * 2048 + (size_t)pn * 256 * 2048; u.K = (br == 2) ? 512 : 256; }
        u.gl = nullptr; u.kind = sub; u.pm = pm; u.pn = pn; u.e = 0; u.nvalid = 256;
        return true;
    }
};
struct EpiMerge { static constexpr bool ALIGN = MK_ALIGN_EPIMERGE;
    bf16_t* MERGED; bf16_t* PSCR;
    __device__ __forceinline__ void operator()(const f32x4 (&acc)[2][2][4][2], const pg8::GU& u, int wr, int wc, int fr, int fq) const {
        const int sub = u.kind;
        int ln_; asm volatile("v_mbcnt_lo_u32_b32 %0, -1, 0\n\tv_mbcnt_hi_u32_b32 %0, -1, %0" : "=v"(ln_));
        const int rq = wr * 64 + (ln_ & 15), cq = wc * 32 + 8 * (ln_ >> 4);
        const int row0 = u.pm * 256 + rq, col0 = u.pn * 256 + cq;
        const unsigned psoff = (unsigned)(((((rq >> 6) * 4 + (cq >> 5)) * 64 + ((cq >> 3) & 3) * 16 + (rq & 63)) * 16));
#pragma unroll
        for (int ai = 0; ai < 2; ++ai)
#pragma unroll
            for (int m = 0; m < 4; ++m)
#pragma unroll
                for (int bj = 0; bj < 2; ++bj) {
                    const int chunk = (ai * 4 + m) * 2 + bj; const f32x4 v0 = acc[ai][bj][m][0], v1 = acc[ai][bj][m][1];
                    unsigned po = psoff; asm volatile("" : "+v"(po)); po += chunk * 8192; u32x4* ps = (u32x4*)((char*)PSCR + po);
                    if ((sub & 1) == 0) { u32x4 w; w.x = pk2(v0[0], v0[1]); w.y = pk2(v0[2], v0[3]); w.z = pk2(v1[0], v1[1]); w.w = pk2(v1[2], v1[3]); *ps = w; }
                    else {
                        const u32x4 p = *ps; unsigned mo = (unsigned)((row0 * 1024 + col0) * 2); asm volatile("" : "+v"(mo)); mo += (unsigned)(((ai * 128 + m * 16) * 1024 + bj * 128) * 2); u32x4* mp = (u32x4*)((char*)MERGED + mo);
                        float r[8] = {sigmoidf_(v0[0]) * bf_lo(p.x), sigmoidf_(v0[1]) * bf_hi(p.x), sigmoidf_(v0[2]) * bf_lo(p.y), sigmoidf_(v0[3]) * bf_hi(p.y),
                                      sigmoidf_(v1[0]) * bf_lo(p.z), sigmoidf_(v1[1]) * bf_hi(p.z), sigmoidf_(v1[2]) * bf_lo(p.w), sigmoidf_(v1[3]) * bf_hi(p.w)};
                        if (sub != 1) { const u32x4 o = *mp; r[0] += bf_lo(o.x); r[1] += bf_hi(o.x); r[2] += bf_lo(o.y); r[3] += bf_hi(o.y); r[4] += bf_lo(o.z); r[5] += bf_hi(o.z); r[6] += bf_lo(o.w); r[7] += bf_hi(o.w); }
                        u32x4 w; w.x = pk2(r[0], r[1]); w.y = pk2(r[2], r[3]); w.z = pk2(r[4], r[5]); w.w = pk2(r[6], r[7]); *mp = w;
                    }

                }
    }
};

struct SchedGrid {
    int G, c, nM, nN, K; const char *A, *B; size_t astep, bstep;
    __device__ __forceinline__ bool next(int i, pg8::GU& u) const {
        const int L = i * G + c; if (L >= nM * nN) return false;
        int pm, pn; pg8::grid_order(L, nM, nN, pm, pn);
        u.A = A + (size_t)pm * astep; u.B = B + (size_t)pn * bstep; u.gl = nullptr; u.K = K; u.kind = 0; u.pm = pm; u.pn = pn; u.e = 0; u.nvalid = 256;
        return true;
    }
};
struct EpiOut { static constexpr bool ALIGN = MK_ALIGN_EPIOUT;
    const float* xf; const float* ctxf; const bf16_t* xb; const float* mod; bf16_t* R1;
    __device__ __forceinline__ void operator()(const f32x4 (&acc)[2][2][4][2], const pg8::GU& u, int wr, int wc, int fr, int fq) const {
        const int rowt = u.pm * 256, col0 = u.pn * 256 + wc * 32 + 8 * fq;
        const float* g1 = mod + (size_t)mod_row(rowt) * 6144 + 2048 + col0;
        f32x4 gv[2][2];
#pragma unroll
        for (int bj = 0; bj < 2; ++bj) { gv[bj][0] = *(const f32x4*)(g1 + bj * 128); gv[bj][1] = *(const f32x4*)(g1 + bj * 128 + 4); }
#pragma unroll
        for (int ai = 0; ai < 2; ++ai)
#pragma unroll
            for (int m = 0; m < 4; ++m) { const int row = rowt + wr * 64 + fr + ai * 128 + m * 16;
#pragma unroll
                for (int bj = 0; bj < 2; ++bj) { const int col = col0 + bj * 128; f32x4 x0, x1;
                    if (xb) { const u32x4 w = *(const u32x4*)(xb + (size_t)row * 1024 + col); x0 = (f32x4){bf_lo(w.x), bf_hi(w.x), bf_lo(w.y), bf_hi(w.y)}; x1 = (f32x4){bf_lo(w.z), bf_hi(w.z), bf_lo(w.w), bf_hi(w.w)}; }
                    else { const float* xp = (row < TL) ? xf + (size_t)row * 1024 + col : ctxf + (size_t)(row - TL) * 1024 + col; x0 = *(const f32x4*)xp; x1 = *(const f32x4*)(xp + 4); }
                    const f32x4 r0 = x0 * DN_ALPHA + gv[bj][0] * acc[ai][bj][m][0], r1 = x1 * DN_ALPHA + gv[bj][1] * acc[ai][bj][m][1];
                    u32x4 w; w.x = pk2(r0[0], r0[1]); w.y = pk2(r0[2], r0[3]); w.z = pk2(r1[0], r1[1]); w.w = pk2(r1[2], r1[3]);
                    *(u32x4*)(R1 + (size_t)row * 1024 + col) = w; } }
    }
};

__device__ __forceinline__ void expert_weights_fp8(Frame& F, ArgsP a, int l, int first, int last, int widx, int nw) {
    unsigned char* W1T = F.ws + WS_EW1; unsigned char* W2T = F.ws + WS_EW2;
    LAS float* scr = (LAS float*)(F.lds + F.wave * 8448);
    __syncthreads();
    for (int it2 = first + widx; it2 < last; it2 += nw) {
        const int it = 2 * it2, e = it / 768; int r = it - e * 768; const size_t le = (size_t)l * 32 + e;
        if (r < 256) { tr_item2<1, true>(a->in[I_EXG] + le * 1024 * 512, 512, (bf16_t*)(W1T + (size_t)e * 1024 * 1024), 1024, scr, r, F.lane); continue; } r -= 256;
        if (r < 256) { tr_item2<2, true>(a->in[I_EXU] + le * 1024 * 512, 512, (bf16_t*)(W1T + (size_t)e * 1024 * 1024), 1024, scr, r, F.lane); continue; } r -= 256;
        tr_item2<0, true>(a->in[I_EXD] + le * 512 * 1024, 1024, (bf16_t*)(W2T + (size_t)e * 1024 * 512), 512, scr, r, F.lane);
    }
    __syncthreads();
}
constexpr int WR_STRIDE = 2064;
constexpr int WR_BYTES = 48 * WR_STRIDE, LG_STRIDE = 52;
__device__ __forceinline__ void phase_ln1_router(Frame& F, ArgsP a, int l, int nrows, const int mode, const int cfirst = 0) {
    if (mode & 1) expert_weights_fp8(F, a, l, cfirst, 32 * 384, F.gw, F.NGW);
    if (!(mode & 10)) return;
    if (mode & 8) {
        const float* we = a->in[I_MOEWE] + (size_t)l * 32768; const float* wg = a->in[I_MOEWG] + (size_t)l * 4096;
        f32x4 t[16], tg[2];
#pragma unroll
        for (int i = 0; i < 16; ++i) t[i] = *(const f32x4*)(we + (size_t)(i * NTHREADS + F.tid) * 4);
#pragma unroll
        for (int i = 0; i < 2; ++i) tg[i] = *(const f32x4*)(wg + (size_t)(i * NTHREADS + F.tid) * 4);
#pragma unroll
        for (int i = 0; i < 3; ++i) { const int ch = i * NTHREADS + F.tid; *(LAS u32x4*)(F.lds + (36 + (ch >> 7)) * WR_STRIDE + (ch & 127) * 16) = (u32x4){0u, 0u, 0u, 0u}; }
#pragma unroll
        for (int i = 0; i < 16; ++i) { const int idx = i * NTHREADS + F.tid, k = idx >> 3, j = idx & 7;
#pragma unroll
            for (int c = 0; c < 4; ++c) *(LAS bf16_t*)(F.lds + (4 + 4 * j + c) * WR_STRIDE + k * 2) = (bf16_t)(pk2(t[i][c], 0.f) & 0xffffu); }
#pragma unroll
        for (int i = 0; i < 2; ++i) { const int k = i * NTHREADS + F.tid;
#pragma unroll
            for (int c = 0; c < 4; ++c) *(LAS bf16_t*)(F.lds + c * WR_STRIDE + k * 2) = (bf16_t)(pk2(tg[i][c], 0.f) & 0xffffu); }
    }
    __syncthreads();
    const float* mod = (const float*)(F.ws + WS_MOD) + (size_t)l * 33 * 6144;
    const bf16_t* R1 = (const bf16_t*)(F.ws + WS_R1); bf16_t* X = (bf16_t*)(F.ws + WS_X); bf16_t* HB = (bf16_t*)(F.ws + WS_HB);
    int* LIST = (int*)(F.ws + WS_LIST); float* WT = (float*)(F.ws + WS_WTS);
    unsigned* cnt = F.ctl + CW_CNT + l * 32 * 64;
    const int lane = F.lane;
    LAS float* LG = (LAS float*)(F.lds + WR_BYTES + F.wave * (16 * LG_STRIDE * 4));
    float g[16], bb[16];
#pragma unroll
    for (int hh = 0; hh < 2; ++hh) { const int c = hh * 512 + 8 * lane;
        const f32x4 g0 = *(const f32x4*)(a->in[I_LN1G] + l * 1024 + c), g1 = *(const f32x4*)(a->in[I_LN1G] + l * 1024 + c + 4), b0 = *(const f32x4*)(a->in[I_LN1B] + l * 1024 + c), b1 = *(const f32x4*)(a->in[I_LN1B] + l * 1024 + c + 4);
#pragma unroll
        for (int j = 0; j < 4; ++j) { g[hh * 8 + j] = g0[j]; g[hh * 8 + 4 + j] = g1[j]; bb[hh * 8 + j] = b0[j]; bb[hh * 8 + 4 + j] = b1[j]; } }
    for (int grp = F.gw; grp < nrows / 16; grp += F.NGW) {
        const int r0 = grp * 16;
        const float* mrow = mod + (size_t)mod_row(r0) * 6144;
        if (mode & 2) {
        u32x4 nw[4][2];
#pragma unroll
        for (int q = 0; q < 4; ++q)
#pragma unroll
            for (int hh = 0; hh < 2; ++hh) nw[q][hh] = *(const u32x4*)(R1 + (size_t)(r0 + q) * 1024 + hh * 512 + 8 * lane);
#pragma unroll 1
        for (int rr = 0; rr < 16; rr += 4) {
            float v[4][16];
#pragma unroll
            for (int q = 0; q < 4; ++q)
#pragma unroll
                for (int hh = 0; hh < 2; ++hh) { const u32x4 w = nw[q][hh];
                    v[q][hh * 8 + 0] = bf_lo(w.x); v[q][hh * 8 + 1] = bf_hi(w.x); v[q][hh * 8 + 2] = bf_lo(w.y); v[q][hh * 8 + 3] = bf_hi(w.y); v[q][hh * 8 + 4] = bf_lo(w.z); v[q][hh * 8 + 5] = bf_hi(w.z); v[q][hh * 8 + 6] = bf_lo(w.w); v[q][hh * 8 + 7] = bf_hi(w.w); }
            if (rr + 4 < 16) {
#pragma unroll
                for (int q = 0; q < 4; ++q)
#pragma unroll
                    for (int hh = 0; hh < 2; ++hh) nw[q][hh] = *(const u32x4*)(R1 + (size_t)(r0 + rr + 4 + q) * 1024 + hh * 512 + 8 * lane); }
            float s[4], mean[4], qq[4], rstd[4];
#pragma unroll
            for (int q = 0; q < 4; ++q) { s[q] = 0.f;
#pragma unroll
                for (int j = 0; j < 16; ++j) s[q] += v[q][j]; }
#pragma unroll
            for (int o = 1; o < 64; o <<= 1)
#pragma unroll
                for (int q = 0; q < 4; ++q) s[q] += __shfl_xor(s[q], o);
#pragma unroll
            for (int q = 0; q < 4; ++q) { mean[q] = s[q] * (1.f / 1024.f); qq[q] = 0.f;
#pragma unroll
                for (int j = 0; j < 16; ++j) { v[q][j] -= mean[q]; qq[q] += v[q][j] * v[q][j]; } }
#pragma unroll
            for (int o = 1; o < 64; o <<= 1)
#pragma unroll
                for (int q = 0; q < 4; ++q) qq[q] += __shfl_xor(qq[q], o);
#pragma unroll
            for (int q = 0; q < 4; ++q) rstd[q] = 1.0f / sqrtf(qq[q] * (1.f / 1024.f) + LN_EPS);
#pragma unroll
            for (int hh = 0; hh < 2; ++hh) { const int c = hh * 512 + 8 * lane;
                const f32x4 sh0 = *(const f32x4*)(mrow + 3072 + c), sh1 = *(const f32x4*)(mrow + 3072 + c + 4), sc0 = *(const f32x4*)(mrow + 4096 + c), sc1 = *(const f32x4*)(mrow + 4096 + c + 4);
#pragma unroll
                for (int q = 0; q < 4; ++q) { const int row = r0 + rr + q;
                    float x1[8], h2[8];
#pragma unroll
                    for (int j = 0; j < 8; ++j) { x1[j] = v[q][hh * 8 + j] * rstd[q] * g[hh * 8 + j] + bb[hh * 8 + j]; const float shv = j < 4 ? sh0[j] : sh1[j - 4], scv = j < 4 ? sc0[j] : sc1[j - 4]; h2[j] = x1[j] * (1.f + scv) + shv; }
                    u32x4 w; w.x = pk2(x1[0], x1[1]); w.y = pk2(x1[2], x1[3]); w.z = pk2(x1[4], x1[5]); w.w = pk2(x1[6], x1[7]);
                    *(u32x4*)(X + (size_t)row * 1024 + c) = w;
                    u32x4 hw; hw.x = pk2(h2[0], h2[1]); hw.y = pk2(h2[2], h2[3]); hw.z = pk2(h2[4], h2[5]); hw.w = pk2(h2[6], h2[7]);
                    *(u32x4*)(HB + (size_t)row * 1024 + c) = hw;
                    *(u32x2*)(F.ws + WS_HB8 + (size_t)row * 1024 + c) = (u32x2){pk4_fp8(h2[0], h2[1], h2[2], h2[3]), pk4_fp8(h2[4], h2[5], h2[6], h2[7])}; } }
        }
        }
    }
    if (mode & 8) {
    const int ngrp = nrows / 16;
    const LAS unsigned char* wrow = F.lds + (lane & 15) * WR_STRIDE + 16 * (lane >> 4);
    bf16x8 av[32];
    { const bf16_t* hrow = HB + (size_t)((F.gw < ngrp ? F.gw : 0) * 16 + (lane & 15)) * 1024 + 8 * (lane >> 4);
#pragma unroll
      for (int ks = 0; ks < 32; ++ks) av[ks] = *(const bf16x8*)(hrow + 32 * ks); }
    for (int grp = F.gw; grp < ngrp; grp += F.NGW) {
        const int r0 = grp * 16;
        f32x4 lacc[3] = {(f32x4){0.f, 0.f, 0.f, 0.f}, (f32x4){0.f, 0.f, 0.f, 0.f}, (f32x4){0.f, 0.f, 0.f, 0.f}};
#pragma unroll
        for (int ks = 0; ks < 32; ++ks) {
#pragma unroll
            for (int nt = 0; nt < 3; ++nt) { const bf16x8 bv = *(const LAS bf16x8*)(wrow + nt * 16 * WR_STRIDE + 64 * ks); lacc[nt] = __builtin_amdgcn_mfma_f32_16x16x32_bf16(av[ks], bv, lacc[nt], 0, 0, 0); } }
        if (grp + F.NGW < ngrp) { const bf16_t* hrow = HB + (size_t)((grp + F.NGW) * 16 + (lane & 15)) * 1024 + 8 * (lane >> 4);
#pragma unroll
            for (int ks = 0; ks < 32; ++ks) av[ks] = *(const bf16x8*)(hrow + 32 * ks); }
#pragma unroll
        for (int nt = 0; nt < 3; ++nt)
#pragma unroll
            for (int r = 0; r < 4; ++r) LG[(4 * (lane >> 4) + r) * LG_STRIDE + nt * 16 + (lane & 15)] = lacc[nt][r];
        asm volatile("s_waitcnt lgkmcnt(0)" ::: "memory");
        if (lane < 16) {
            const int row = r0 + lane; float lg[36];
#pragma unroll
            for (int q4 = 0; q4 < 9; ++q4) { const f32x4 t = *(const LAS f32x4*)(LG + lane * LG_STRIDE + 4 * q4); lg[4 * q4] = t.x; lg[4 * q4 + 1] = t.y; lg[4 * q4 + 2] = t.z; lg[4 * q4 + 3] = t.w; }
            float gl[4];
#pragma unroll
            for (int j = 0; j < 4; ++j) gl[j] = lg[j] + a->in[I_MOEBG][l * 4 + j];
            int gi = 0; float gm = gl[0];
#pragma unroll
            for (int j = 1; j < 4; ++j) if (gl[j] > gm) { gm = gl[j]; gi = j; }
            float gs = 0.f;
#pragma unroll
            for (int j = 0; j < 4; ++j) gs += expf(gl[j] - gm);
            const float gprob = 1.0f / gs;
            float el[8];
#pragma unroll
            for (int j = 0; j < 8; ++j) { float t = lg[4 + j] + a->in[I_MOEBE][l * 32 + j];
#pragma unroll
                for (int gg = 1; gg < 4; ++gg) t = (gi == gg) ? (lg[4 + gg * 8 + j] + a->in[I_MOEBE][l * 32 + gg * 8 + j]) : t;
                el[j] = t; }
            int i0 = 0; float v0 = el[0];
#pragma unroll
            for (int j = 1; j < 8; ++j) if (el[j] > v0) { v0 = el[j]; i0 = j; }
            int i1 = -1; float v1 = -3.0e38f;
#pragma unroll
            for (int j = 0; j < 8; ++j) if (j != i0 && el[j] > v1) { v1 = el[j]; i1 = j; }
            const float e1 = expf(v1 - v0), w0 = gprob / (1.0f + e1), w1 = gprob * e1 / (1.0f + e1);
            const int ea = gi * 8 + i0, eb = gi * 8 + i1;
            if (!(mode & 4)) {
            const unsigned pa = __hip_atomic_fetch_add(cnt + ea * 64, 1u, __ATOMIC_RELAXED, __HIP_MEMORY_SCOPE_AGENT);
            const unsigned pb = __hip_atomic_fetch_add(cnt + eb * 64, 1u, __ATOMIC_RELAXED, __HIP_MEMORY_SCOPE_AGENT);
            LIST[(size_t)ea * TA + pa] = row * 2; LIST[(size_t)eb * TA + pb] = row * 2 + 1;
            WT[(size_t)ea * TA + pa] = w0; WT[(size_t)eb * TA + pb] = w1;
            *(u32x2*)(F.ws + WS_POS + (size_t)row * 8) = (u32x2){((unsigned)ea << 24) | pa, ((unsigned)eb << 24) | pb};
            } else if (w0 + w1 + (float)(ea + eb) == -12345.0f) WT[row] = w0;
        }
        asm volatile("s_waitcnt lgkmcnt(0)" ::: "memory");
    }
    }
    __syncthreads();
}

__device__ __forceinline__ void moe_tiles(Frame& F, int l) {
    __syncthreads();
    if (F.wave == 0) {
        const int e = F.lane & 31;
        const unsigned c = __hip_atomic_load(F.ctl + CW_CNT + (l * 32 + e) * 64, __ATOMIC_RELAXED, __HIP_MEMORY_SCOPE_AGENT);
        const int t = (int)((c + 255u) >> 8); int incl = t;
#pragma unroll
        for (int o = 1; o < 32; o <<= 1) { const int v = __shfl_up(incl, o, 32); if (e >= o) incl += v; }
        if (F.lane < 32) { F.MISC[32 + e] = (unsigned)(incl - t); F.MISC[72 + e] = c; if (e == 31) F.MISC[64] = (unsigned)incl; }
    }
    __syncthreads();
}
struct SchedMoe {
    int G, c, l, second; volatile LAS unsigned* MISC; const unsigned* cnt; const int* LIST; const char *A, *B;
    __device__ __forceinline__ bool next(int i, pg8::GU& u) const {
        const int L = i * G + c, tile = L >> 2, pn = L & 3; if (tile >= __builtin_amdgcn_readfirstlane((int)MISC[64])) return false;
        const int lj = (int)__builtin_amdgcn_mbcnt_hi(~0u, __builtin_amdgcn_mbcnt_lo(~0u, 0u)) & 31;
        const int e = __builtin_popcountll(__ballot(lj >= 1 && (int)MISC[32 + lj] <= tile) & 0xffffffffull);
        const int tl = tile - __builtin_amdgcn_readfirstlane((int)MISC[32 + e]); const int ce = __builtin_amdgcn_readfirstlane((int)MISC[72 + e]);
        u.gl = LIST + (size_t)e * TA + tl * 256; u.nvalid = ce - tl * 256 < 256 ? ce - tl * 256 : 256; u.e = e; u.pm = tile; u.pn = pn; u.kind = 0;
        if (!second) { u.A = A; u.B = B + (size_t)e * 1024 * 1024 + (size_t)pn * 256 * 1024; u.K = 1024; }
        else { u.A = A + (size_t)tile * 256 * 512; u.B = B + (size_t)e * 1024 * 512 + (size_t)pn * 256 * 512; u.K = 512; }
        return true;
    }
};
struct EpiMoe1 { static constexpr bool ALIGN = MK_ALIGN_EPIMOE1;
    unsigned char* HID; const float* WTS;
    __device__ __forceinline__ void operator()(const f32x4 (&acc)[2][2][4][2], const pg8::GU& u, int wr, int wc, int fr, int fq) const {
        int ln_; asm volatile("v_mbcnt_lo_u32_b32 %0, -1, 0\n\tv_mbcnt_hi_u32_b32 %0, -1, %0" : "=v"(ln_));
        const int rl0 = wr * 64 + (ln_ & 15), row0 = u.pm * 256 + rl0, hc0 = u.pn * 128 + wc * 16 + 4 * (ln_ >> 4);
        const float* wts = WTS + (u.gl - LISTB);
#if MK_DUP == 51
        for (int rep_ = 0; rep_ < 2; ++rep_) { asm volatile("" ::: "memory");
#else
        {
#endif
#pragma unroll
        for (int ai = 0; ai < 2; ++ai)
#pragma unroll
            for (int m = 0; m < 4; ++m) { const int rl = rl0 + ai * 128 + m * 16; const float wsc = wts[rl < u.nvalid ? rl : 0] * ((rl < u.nvalid) ? (H8S * W8R) : 0.f);
#pragma unroll
                for (int bj = 0; bj < 2; ++bj) { const f32x4 gt = acc[ai][bj][m][0] * W8R, up = acc[ai][bj][m][1] * wsc;
                    *(unsigned*)(HID + (size_t)(row0 + ai * 128 + m * 16) * 512 + hc0 + bj * 64) =
                        pk4_fp8(gt[0] * sigmoidf_(gt[0]) * up[0], gt[1] * sigmoidf_(gt[1]) * up[1], gt[2] * sigmoidf_(gt[2]) * up[2], gt[3] * sigmoidf_(gt[3]) * up[3]); } }
        }
    }
    const int* LISTB;
};
struct EpiMoe2 { static constexpr bool ALIGN = MK_ALIGN_EPIMOE2;
    unsigned char* YS;
    __device__ __forceinline__ void operator()(const f32x4 (&acc)[2][2][4][2], const pg8::GU& u, int wr, int wc, int fr, int fq) const {
        int ln_; asm volatile("v_mbcnt_lo_u32_b32 %0, -1, 0\n\tv_mbcnt_hi_u32_b32 %0, -1, %0" : "=v"(ln_));
        const int rb = wr * 64 + (ln_ & 15), cq = wc * 32 + 8 * (ln_ >> 4);
        unsigned char* dst0 = YS + (size_t)(u.pm * 256 + rb) * 1024 + u.pn * 256 + cq;
#if MK_DUP == 50
        for (int rep_ = 0; rep_ < 2; ++rep_) { asm volatile("" ::: "memory");
#else
        {
#endif
#pragma unroll
        for (int ai = 0; ai < 2; ++ai)
#pragma unroll
            for (int m = 0; m < 4; ++m) { const int r = rb + ai * 128 + m * 16;
                if (r < u.nvalid) { unsigned char* dst = dst0 + (size_t)(ai * 128 + m * 16) * 1024;
#pragma unroll
                    for (int bj = 0; bj < 2; ++bj) { const f32x4 v0 = acc[ai][bj][m][0] * W8R, v1 = acc[ai][bj][m][1] * W8R;
                        *(u32x2*)(dst + bj * 128) = (u32x2){pk4_fp8(v0[0], v0[1], v0[2], v0[3]), pk4_fp8(v1[0], v1[1], v1[2], v1[3])}; } } }
        }
    }
};

__device__ __forceinline__ void phase_ln2(Frame& F, ArgsP a, int l, int nrows) {
    const float* mod = (const float*)(F.ws + WS_MOD) + (size_t)l * 33 * 6144; const float* modn = (const float*)(F.ws + WS_MOD) + (size_t)33 * 6144;
    bf16_t* X = (bf16_t*)(F.ws + WS_X); bf16_t* HB = (bf16_t*)(F.ws + WS_HB);
    const unsigned char* YS = F.ws + WS_YS; const unsigned* POS = (const unsigned*)(F.ws + WS_POS);
    moe_tiles(F, l);
#define LN2_YROW(p) ((size_t)((int)F.MISC[32 + ((p) >> 24)] * 256 + (int)((p) & 0xFFFFFFu)) * 1024)
    const int lane = F.lane;
    f32x4 lg[2][2], lb[2][2];
#pragma unroll
    for (int hh = 0; hh < 2; ++hh) { const int c = hh * 512 + 8 * lane;
        lg[hh][0] = *(const f32x4*)(a->in[I_LN2G] + l * 1024 + c); lg[hh][1] = *(const f32x4*)(a->in[I_LN2G] + l * 1024 + c + 4); lb[hh][0] = *(const f32x4*)(a->in[I_LN2B] + l * 1024 + c); lb[hh][1] = *(const f32x4*)(a->in[I_LN2B] + l * 1024 + c + 4); }
    const int step = 2 * F.NGW;
    u32x4 pre[2][2]; u32x2 prey[2][2][2];
#pragma unroll
    for (int q = 0; q < 2; ++q)
#pragma unroll
        for (int hh = 0; hh < 2; ++hh) { const int row = F.gw + q * F.NGW; const size_t o = (size_t)row * 1024 + hh * 512 + 8 * lane; pre[q][hh] = *(const u32x4*)(X + o);
            const u32x2 p = *(const u32x2*)(POS + 2 * row); prey[q][hh][0] = *(const u32x2*)(YS + LN2_YROW(p.x) + hh * 512 + 8 * lane); prey[q][hh][1] = *(const u32x2*)(YS + LN2_YROW(p.y) + hh * 512 + 8 * lane); }
    u32x2 pp[2];
#pragma unroll
    for (int q = 0; q < 2; ++q) { const int row = F.gw + step + q * F.NGW; pp[q] = *(const u32x2*)(POS + 2 * (row < nrows ? row : 0)); }
    for (int row0 = F.gw; row0 < nrows; row0 += step) {
        float v[2][16];
#pragma unroll
        for (int q = 0; q < 2; ++q) { const int row = row0 + q * F.NGW; const float* mrow = mod + (size_t)mod_row(row) * 6144;
#pragma unroll
            for (int hh = 0; hh < 2; ++hh) { const int c = hh * 512 + 8 * lane;
                const u32x4 xw = pre[q][hh]; const u32x2 y0 = prey[q][hh][0], y1 = prey[q][hh][1];
                const f32x4 g0 = *(const f32x4*)(mrow + 5120 + c) * (1.0f / H8S), g1 = *(const f32x4*)(mrow + 5120 + c + 4) * (1.0f / H8S);
                const unsigned xs[4] = {xw.x, xw.y, xw.z, xw.w};
                float ya[8], yb[8], t4[4];
                fp8x4_to_f32(y0.x, t4); ya[0] = t4[0]; ya[1] = t4[1]; ya[2] = t4[2]; ya[3] = t4[3]; fp8x4_to_f32(y0.y, t4); ya[4] = t4[0]; ya[5] = t4[1]; ya[6] = t4[2]; ya[7] = t4[3];
                fp8x4_to_f32(y1.x, t4); yb[0] = t4[0]; yb[1] = t4[1]; yb[2] = t4[2]; yb[3] = t4[3]; fp8x4_to_f32(y1.y, t4); yb[4] = t4[0]; yb[5] = t4[1]; yb[6] = t4[2]; yb[7] = t4[3];
#pragma unroll
                for (int j = 0; j < 4; ++j) { const float ga = j < 2 ? g0[2 * j] : g1[2 * j - 4], gb = j < 2 ? g0[2 * j + 1] : g1[2 * j - 3];
                    v[q][hh * 8 + 2 * j] = DN_ALPHA * bf_lo(xs[j]) + ga * (ya[2 * j] + yb[2 * j]); v[q][hh * 8 + 2 * j + 1] = DN_ALPHA * bf_hi(xs[j]) + gb * (ya[2 * j + 1] + yb[2 * j + 1]); } } }
        if (row0 + step < nrows) {
#pragma unroll
            for (int q = 0; q < 2; ++q)
#pragma unroll
                for (int hh = 0; hh < 2; ++hh) { const size_t o = (size_t)(row0 + step + q * F.NGW) * 1024 + hh * 512 + 8 * lane; pre[q][hh] = *(const u32x4*)(X + o);
                    prey[q][hh][0] = *(const u32x2*)(YS + LN2_YROW(pp[q].x) + hh * 512 + 8 * lane); prey[q][hh][1] = *(const u32x2*)(YS + LN2_YROW(pp[q].y) + hh * 512 + 8 * lane); }
#pragma unroll
            for (int q = 0; q < 2; ++q) { const int row = row0 + 2 * step + q * F.NGW; pp[q] = *(const u32x2*)(POS + 2 * (row < nrows ? row : 0)); } }
        float s[2], mean[2], qq[2], rstd[2];
#pragma unroll
        for (int q = 0; q < 2; ++q) { s[q] = 0.f;
#pragma unroll
            for (int j = 0; j < 16; ++j) s[q] += v[q][j]; }
#pragma unroll
        for (int o = 1; o < 64; o <<= 1)
#pragma unroll
            for (int q = 0; q < 2; ++q) s[q] += __shfl_xor(s[q], o);
#pragma unroll
        for (int q = 0; q < 2; ++q) { mean[q] = s[q] * (1.f / 1024.f); qq[q] = 0.f;
#pragma unroll
            for (int j = 0; j < 16; ++j) { v[q][j] -= mean[q]; qq[q] += v[q][j] * v[q][j]; } }
#pragma unroll
        for (int o = 1; o < 64; o <<= 1)
#pragma unroll
            for (int q = 0; q < 2; ++q) qq[q] += __shfl_xor(qq[q], o);
#pragma unroll
        for (int q = 0; q < 2; ++q) rstd[q] = 1.0f / sqrtf(qq[q] * (1.f / 1024.f) + LN_EPS);
#pragma unroll
        for (int q = 0; q < 2; ++q) { const int row = row0 + q * F.NGW; const float* mn = modn + (size_t)mod_row(row) * 6144;
#pragma unroll
            for (int hh = 0; hh < 2; ++hh) { const int c = hh * 512 + 8 * lane;
                float x2[8];
#pragma unroll
                for (int j = 0; j < 8; ++j) x2[j] = v[q][hh * 8 + j] * rstd[q] * (j < 4 ? lg[hh][0][j] : lg[hh][1][j - 4]) + (j < 4 ? lb[hh][0][j] : lb[hh][1][j - 4]);
                if (l == 0) {
                    u32x4 w; w.x = pk2(x2[0], x2[1]); w.y = pk2(x2[2], x2[3]); w.z = pk2(x2[4], x2[5]); w.w = pk2(x2[6], x2[7]);
                    *(u32x4*)(X + (size_t)row * 1024 + c) = w;
                    const f32x4 sh0 = *(const f32x4*)(mn + c), sh1 = *(const f32x4*)(mn + c + 4), sc0 = *(const f32x4*)(mn + 1024 + c), sc1 = *(const f32x4*)(mn + 1024 + c + 4);
                    float hv[8];
#pragma unroll
                    for (int j = 0; j < 8; ++j) hv[j] = x2[j] * (1.f + (j < 4 ? sc0[j] : sc1[j - 4])) + (j < 4 ? sh0[j] : sh1[j - 4]);
                    u32x4 hw; hw.x = pk2(hv[0], hv[1]); hw.y = pk2(hv[2], hv[3]); hw.z = pk2(hv[4], hv[5]); hw.w = pk2(hv[6], hv[7]);
                    *(u32x4*)(HB + (size_t)row * 1024 + c) = hw;
                } else {
                    float* op = a->out + (size_t)row * 1024 + c;
                    *(f32x4*)op = (f32x4){x2[0], x2[1], x2[2], x2[3]}; *(f32x4*)(op + 4) = (f32x4){x2[4], x2[5], x2[6], x2[7]};
                }
            } }
    }
}

constexpr int NPH_L = 11, NPH = 2 + 2 * NPH_L;
__global__ void __launch_bounds__(NTHREADS, 2) mk_fwd(Args args) {
    extern __shared__ __attribute__((aligned(16))) unsigned char lds_raw[];
    Frame F;
    F.lds = (LAS unsigned char*)lds_raw;
    F.MISC = (volatile LAS unsigned*)(F.lds + MISC_OFF);
    int wave0 = __builtin_amdgcn_readfirstlane((int)threadIdx.x >> 6); asm volatile("" : "+s"(wave0));
#define LANE_ID(dst) asm volatile("v_mbcnt_lo_u32_b32 %0, -1, 0\n\tv_mbcnt_hi_u32_b32 %0, -1, %0" : "=v"(dst))
    F.wave = wave0; LANE_ID(F.lane); F.tid = wave0 * 64 + F.lane;
    F.G = gridDim.x; F.bid = blockIdx.x; F.gw = F.bid * NWAVES + F.wave; F.NGW = F.G * NWAVES;
    const int vcu = (F.G % 8 == 0) ? (F.bid % 8) * (F.G / 8) + F.bid / 8 : F.bid;
    ArgsP ap = (ArgsP)__builtin_amdgcn_kernarg_segment_ptr(); asm volatile("" : "+s"(ap));
    F.ws = ap->ws; F.ctl = (unsigned*)(F.ws + WS_CTL);
    for (int u = F.tid; u < 128; u += NTHREADS) F.MISC[u] = 0u;
    __syncthreads();
#if MK_SPLIT
#define GRID_BAR() do { } while (0)
#else
    XcdBarrier bar = xcd_barrier_post(F.ctl + CW_BAR, F.MISC + 8);
#define GRID_BAR() xcd_barrier(bar)
#endif
    const int lo = ap->ph_lo, hi = ap->ph_hi;
#ifndef MK_ATT_V1
#define MK_ATT_V1 0
#endif
#ifndef MK_PHMASK
#define MK_PHMASK 0xFFFFFF
#endif
#define PHON(p) (((MK_PHMASK) >> (p)) & 1)
#ifndef MK_DUP
#define MK_DUP -1
#endif
#define NDUP(p) ((MK_DUP) == (p) ? 2 : 1)
#define IN(k) (lo <= (k) && (k) < hi)
#define SEAM(k) do { if (IN((k) + 1)) { GRID_BAR(); if (MK_DUP == 40) GRID_BAR(); } { LANE_ID(F.lane); F.tid = wave0 * 64 + F.lane; ap = (ArgsP)__builtin_amdgcn_kernarg_segment_ptr(); asm volatile("" : "+s"(ap)); F.ws = ap->ws; F.ctl = (unsigned*)(F.ws + WS_CTL); ws = F.ws; } } while (0)
    unsigned char* ws = F.ws;

    if (PHON(0) && IN(0)) { for (int dup = 0; dup < NDUP(0); ++dup) p0a_prologue(F, ap); SEAM(0); }
    if (PHON(1) && IN(1)) { p0b_mod(F, ap); SEAM(1); }

    for (int l = 0; l < DEPTH; ++l) {
        const int pb = 2 + l * NPH_L;
        const int nrows = (l == 0) ? TA : TL;
#define wsl ((const char*)(ws + WS_WS + (size_t)l * WSL))
#define modl ((const float*)(ws + WS_MOD) + (size_t)l * 33 * 6144)
        const float lam_init = 0.8f - 0.6f * expf(-0.3f * (float)l);

        if (PHON(2) && IN(pb + 0) && l == 0) { for (int dup = 0; dup < NDUP(2); ++dup) phase_modulate0(F, ap); SEAM(pb + 0); }

        if (PHON(3) && IN(pb + 1)) {
            SchedIn S; S.G = F.G; S.c = F.bid; S.nM = nrows / 256; S.nreg = S.nM * 11; S.nctx = (l == 0) ? 0 : 128; S.A = (const char*)(ws + WS_HB); S.B = wsl;
            EpiIn E{(bf16_t*)(ws + WS_ZG), (bf16_t*)(ws + WS_ZH), (bf16_t*)(ws + WS_Q), (bf16_t*)(ws + WS_K), (bf16_t*)(ws + WS_V), (const float*)(ws + WS_ROPE)};
            for (int dup = 0; dup < NDUP(3); ++dup) pg8::gemm_phase<EpiIn, SchedIn, false>(F.lds, S, E, 2048, 2048, F.wave, F.lane);
            SEAM(pb + 1);
        }

        if (PHON(4) && IN(pb + 2)) {
            for (int dup = 0; dup < NDUP(20); ++dup) for (int u = F.bid; u < nrows / 128; u += F.G) gmlp_unit(F, ap, l, u);
            { const int nu = nrows / 128, extra = (nu > F.G && nu < 2 * F.G) ? nu - F.G : 0;
              for (int dup = 0; dup < NDUP(21); ++dup) { if (F.bid >= extra) for (int u = F.bid - extra; u < nu; u += F.G - extra) sconv_unit(F, ap, l, u); } }
            if (!MK_ROPE_EPI) for (int u = F.bid; u < TL / 128; u += F.G) rope_unit(F, u);
            SEAM(pb + 2);
        }

        if (PHON(5) && IN(pb + 3)) {
            const float* HF = (const float*)(ws + WS_HF);
#ifndef MK_NOCONV
            for (int dup = 0; dup < NDUP(22); ++dup) for (int c = F.bid; c < 256; c += F.G) {
                conv_unit<8>(F, ap, l, c, HF + (size_t)l * 2048 * 512, (const bf16_t*)(ws + WS_VT) + (size_t)c * TL, (bf16_t*)(ws + WS_YT) + (size_t)c * TL);
                if (l == 0) conv_unit<1>(F, ap, l, c, HF + (size_t)2 * 2048 * 512, (const bf16_t*)(ws + WS_VT) + (size_t)256 * TL + (size_t)c * TC, (bf16_t*)(ws + WS_YT) + (size_t)256 * TL + (size_t)c * TC);
            }
#endif
#ifndef MK_NOATT
            float s1 = 0.f, s2 = 0.f;
            for (int i = 0; i < 64; ++i) { s1 += ap->in[I_LQ1][l * 64 + i] * ap->in[I_LK1][l * 64 + i]; s2 += ap->in[I_LQ2][l * 64 + i] * ap->in[I_LK2][l * 64 + i]; }
            const float lam = expf(s1) - expf(s2) + lam_init;
#if MK_ATT_V1
            for (int u = F.bid; u < 1024; u += F.G) { const int b = u >> 5, rem = u & 31; AttnUnit U; U.qrow0 = b * SEQ + (rem & 7) * 256; U.h = rem >> 3; U.klat0 = b * SEQ; U.nlat = 32; U.kctx0 = TL + b * CTXL; U.nt = 36;
                attn_unit_v1(F, ap, l, U, lam, lam_init); }
            if (l == 0) for (int u = F.bid; u < 128; u += F.G) { const int b = u >> 2; AttnUnit U; U.qrow0 = TL + b * CTXL; U.h = u & 3; U.klat0 = 0; U.nlat = 0; U.kctx0 = TL + b * CTXL; U.nt = 4;
                attn_unit_v1(F, ap, l, U, lam, lam_init); }
#else
            for (int dup = 0; dup < NDUP(23); ++dup) for (int u = vcu; u < 2048; u += F.G) { const int b = u >> 6, rem = u & 63; AttnUnit U; U.qrow0 = b * SEQ + (rem & 15) * 128; U.h = rem >> 4; U.klat0 = b * SEQ; U.nlat = 32; U.kctx0 = TL + b * CTXL; U.nt = 36;
                attn_unit(F, ap, l, U, lam, lam_init); }
            if (l == 0) for (int u = vcu; u < 256; u += F.G) { const int b = u >> 3; AttnUnit U; U.qrow0 = TL + b * CTXL + (u & 1) * 128; U.h = (u >> 1) & 3; U.klat0 = 0; U.nlat = 0; U.kctx0 = TL + b * CTXL; U.nt = 4;
                attn_unit(F, ap, l, U, lam, lam_init); }
#endif
#endif
            SEAM(pb + 3);
        }

        if (PHON(6) && IN(pb + 4)) { for (int dup = 0; dup < NDUP(6); ++dup) for (int u = F.bid; u < nrows / 64; u += F.G) ytrans_unit<64>(F, u); __syncthreads(); SEAM(pb + 4); }

        if (PHON(7) && IN(pb + 5)) {
            SchedMerge S{F.G, F.bid, nrows / 256, (const char*)(ws + WS_HB), (const char*)(ws + WS_YCAT), wsl, wsl + 12 * MiB};
            EpiMerge E{(bf16_t*)(ws + WS_MERGED), (bf16_t*)(ws + WS_PSCR) + (size_t)F.bid * 65536};
            for (int dup = 0; dup < NDUP(7); ++dup) pg8::gemm_phase<EpiMerge, SchedMerge, false>(F.lds, S, E, 2048, 2048, F.wave, F.lane);
            { const int rem = (nrows / 256 * 4) % F.G;
              if (rem && F.bid >= rem) expert_weights_fp8(F, ap, l, 0, NCONV_E, (F.bid - rem) * NWAVES + F.wave, (F.G - rem) * NWAVES); }
            SEAM(pb + 5);
        }

        if (PHON(8) && IN(pb + 6)) {
            SchedGrid S{F.G, F.bid, nrows / 256, 4, 1024, (const char*)(ws + WS_MERGED), wsl + 18 * MiB, (size_t)256 * 2048, (size_t)256 * 2048};
            EpiOut E{ap->in[I_X], ap->in[I_CTX], (l == 0) ? nullptr : (const bf16_t*)(ws + WS_X), modl, (bf16_t*)(ws + WS_R1)};
            for (int dup = 0; dup < NDUP(8); ++dup) pg8::gemm_phase<EpiOut, SchedGrid, false>(F.lds, S, E, 2048, 2048, F.wave, F.lane);
            SEAM(pb + 6);
        }

        if (PHON(9) && IN(pb + 7)) { phase_ln1_router(F, ap, l, nrows, 3, ((nrows / 256 * 4) % F.G) ? NCONV_E : 0); if (MK_DUP == 30) phase_ln1_router(F, ap, l, nrows, 1); if (MK_DUP == 33) phase_ln1_router(F, ap, l, nrows, 2); GRID_BAR(); { LANE_ID(F.lane); F.tid = wave0 * 64 + F.lane; } phase_ln1_router(F, ap, l, nrows, 8); if (MK_DUP == 31) phase_ln1_router(F, ap, l, nrows, 12); SEAM(pb + 7); }

        if (PHON(10) && IN(pb + 8)) {
            moe_tiles(F, l);
            SchedMoe S{F.G, vcu, l, 0, F.MISC, F.ctl + CW_CNT + l * 32 * 64, (const int*)(ws + WS_LIST), (const char*)(ws + WS_HB8), (const char*)(ws + WS_EW1)};
            EpiMoe1 E{ws + WS_HID, (const float*)(ws + WS_WTS), (const int*)(ws + WS_LIST)};
            for (int dup = 0; dup < NDUP(10); ++dup) pg8::gemm_phase<EpiMoe1, SchedMoe, true, true>(F.lds, S, E, 1024, 1024, F.wave, F.lane);
            SEAM(pb + 8);
        }

        if (PHON(11) && IN(pb + 9)) {
            moe_tiles(F, l);
            SchedMoe S{F.G, vcu, l, 1, F.MISC, F.ctl + CW_CNT + l * 32 * 64, (const int*)(ws + WS_LIST), (const char*)(ws + WS_HID), (const char*)(ws + WS_EW2)};
            EpiMoe2 E{ws + WS_YS};
            for (int dup = 0; dup < NDUP(11); ++dup) pg8::gemm_phase<EpiMoe2, SchedMoe, false, true>(F.lds, S, E, 512, 512, F.wave, F.lane);
            SEAM(pb + 9);
        }

        if (PHON(12) && IN(pb + 10)) { phase_ln2(F, ap, l, nrows); if (MK_DUP == 32 && l == 1) phase_ln2(F, ap, l, nrows); SEAM(pb + 10); }
    }
#undef wsl
#undef modl
#undef IN
#undef SEAM
#undef GRID_BAR
}

extern "C" void kernel_launch(void* const* d_in, const int* in_sizes, int n_in, void* d_out, int out_size, void* d_ws, size_t ws_size, hipStream_t stream) {
    static int grid = 0;
    if (grid == 0) {
        if (n_in != 40 || out_size != TL * D || ws_size < WS_END) { fprintf(stderr, "kernel_launch: unexpected shapes: n_in %d out %d ws %zu (need %zu)\n", n_in, out_size, ws_size, (size_t)WS_END); grid = -1; return; }
        int dev = 0, cus = 0;
        if (hipGetDevice(&dev) != hipSuccess || hipDeviceGetAttribute(&cus, hipDeviceAttributeMultiprocessorCount, dev) != hipSuccess) { grid = -1; return; }
        if (hipFuncSetAttribute((const void*)mk_fwd, hipFuncAttributeMaxDynamicSharedMemorySize, LDS_BYTES) != hipSuccess) { fprintf(stderr, "kernel_launch: hipFuncSetAttribute failed\n"); grid = -1; return; }
        int per_cu = 0;
        if (hipOccupancyMaxActiveBlocksPerMultiprocessor(&per_cu, (const void*)mk_fwd, NTHREADS, LDS_BYTES) != hipSuccess || per_cu < 1) fprintf(stderr, "kernel_launch: occupancy query reports %d\n", per_cu);
        (void)hipGetLastError();
        grid = cus;
    }
    if (grid < 0) return;
    if (hipMemsetAsync((char*)d_ws + WS_CTL, 0, CTL_ZERO_BYTES, stream) != hipSuccess) return;
    Args a{};
    for (int i = 0; i < 40; ++i) a.in[i] = (const float*)d_in[i];
    a.out = (float*)d_out; a.ws = (unsigned char*)d_ws;
#if MK_SPLIT
    for (int p = 0; p < NPH; ++p) { a.ph_lo = p; a.ph_hi = p + 1; hipLaunchKernelGGL(mk_fwd, dim3(grid), dim3(NTHREADS), LDS_BYTES, stream, a); }
#else
    a.ph_lo = 0; a.ph_hi = NPH;
    hipLaunchKernelGGL(mk_fwd, dim3(grid), dim3(NTHREADS), LDS_BYTES, stream, a);
#endif
}
```

```cpp
#include <hip/hip_runtime.h>
#include <cstdio>
#include <cstdint>

#ifndef MK_SPLIT
#define MK_SPLIT 0
#endif

#ifndef MK_F8BUILTIN
#define MK_F8BUILTIN 0
#endif
#ifndef MK_PROBE_BLOCK
#define MK_PROBE_BLOCK 255
#endif
#ifndef MK_DUP
#define MK_DUP -1
#endif
#ifndef MK_ROPE_EPI
#define MK_ROPE_EPI 1
#endif
#define GAS __attribute__((address_space(1)))
#define LAS __attribute__((address_space(3)))
typedef unsigned short bf16_t;
typedef short bf16x8 __attribute__((ext_vector_type(8)));
typedef short s16x4 __attribute__((ext_vector_type(4)));
typedef float f32x2 __attribute__((ext_vector_type(2)));
typedef float f32x4 __attribute__((ext_vector_type(4)));
typedef float f32x16 __attribute__((ext_vector_type(16)));
typedef unsigned u32x2 __attribute__((ext_vector_type(2)));
typedef unsigned u32x4 __attribute__((ext_vector_type(4)));
typedef __bf16 bf16x2_t __attribute__((ext_vector_type(2)));

constexpr int D = 1024, BATCH = 32, SEQ = 2048, CTXL = 256, DEPTH = 2;
constexpr int TL = BATCH * SEQ, TC = BATCH * CTXL, TA = TL + TC;
constexpr int NIN = 5888, NZ = 2816;
constexpr int OFF_GM = 0, OFF_HY = 512, OFF_Q = 1280, OFF_K = 1792, OFF_V = 2304, OFF_GATE = 2816;
constexpr int NEXP = 32, MOEH = 512;
constexpr float LN_EPS = 1e-5f;
constexpr float DN_ALPHA = 1.4142135623730951f;
constexpr float QSCALE = 0.125f * 1.4426950408889634f;
constexpr int NWAVES = 8, NTHREADS = 512;

constexpr size_t MiB = 1u << 20;
constexpr size_t WS_CTL = 0, CTL_ZERO_BYTES = 1 * MiB;
constexpr size_t WS_MOD = 1 * MiB;
constexpr size_t WS_MODP = 3 * MiB;
constexpr size_t WS_ROPE = 16 * MiB;
constexpr size_t WS_HF = 17 * MiB;
constexpr size_t WS_LIST = 26 * MiB;
constexpr size_t WS_WT = 36 * MiB;
constexpr size_t WS_WTS = 988 * MiB;
constexpr size_t WS_WSB = 37 * MiB;
constexpr size_t WS_WS = 48 * MiB;
constexpr size_t WSL = 20 * MiB;
constexpr size_t WS_HB = 88 * MiB;
constexpr size_t WS_X = 232 * MiB;
constexpr size_t WS_ZG = 376 * MiB;
constexpr size_t WS_ZH = 448 * MiB;
constexpr size_t WS_Q = 556 * MiB;
constexpr size_t WS_K = 628 * MiB;
constexpr size_t WS_V = 700 * MiB;
constexpr size_t WS_YCAT = 772 * MiB;
constexpr size_t WS_HB8 = 772 * MiB;
constexpr size_t WS_VT = 916 * MiB;
constexpr size_t WS_X0 = 952 * MiB;
constexpr size_t WS_END = 997 * MiB;
constexpr size_t WS_YT = WS_ZG;
constexpr size_t WS_PSCR = WS_ZH;
constexpr size_t WS_MERGED = WS_Q;
constexpr size_t WS_R1 = WS_ZG;
constexpr size_t WS_EW1 = 700 * MiB;
constexpr size_t WS_EW2 = 732 * MiB;
constexpr size_t WS_HID = 604 * MiB;
constexpr size_t WS_YS = WS_ZG;
constexpr size_t WS_POS = 36 * MiB;
constexpr int CW_BAR = 4096;
constexpr int NCONV_E = 9216;
constexpr int CW_CNT = 16384;

constexpr int LDS_BYTES = 155648;
constexpr int MISC_OFF = LDS_BYTES - 512;

__device__ __forceinline__ unsigned pk2(float lo, float hi) { f32x2 v = {lo, hi}; bf16x2_t b = __builtin_convertvector(v, bf16x2_t); return __builtin_bit_cast(unsigned, b); }
__device__ __forceinline__ float sat8(float x) { return __builtin_amdgcn_fmed3f(x, -448.0f, 448.0f); }
__device__ __forceinline__ unsigned pk4_fp8(float a, float b, float c, float d) { int w = __builtin_amdgcn_cvt_pk_fp8_f32(sat8(a), sat8(b), 0, false); w = __builtin_amdgcn_cvt_pk_fp8_f32(sat8(c), sat8(d), w, true); return (unsigned)w; }
constexpr float H8S = 16.0f;
constexpr float W8S = 32.0f, W8R = 1.0f / 32.0f;
__device__ __forceinline__ void fp8x4_to_f32(unsigned w, float (&o)[4]) { const f32x2 a = __builtin_amdgcn_cvt_pk_f32_fp8((int)w, false), b = __builtin_amdgcn_cvt_pk_f32_fp8((int)w, true); o[0] = a.x; o[1] = a.y; o[2] = b.x; o[3] = b.y; }
__device__ __forceinline__ float bf_lo(unsigned w) { return __uint_as_float(w << 16); }
__device__ __forceinline__ float bf_hi(unsigned w) { return __uint_as_float(w & 0xffff0000u); }
__device__ __forceinline__ float bf1(bf16_t b) { return __uint_as_float(((unsigned)b) << 16); }
__device__ __forceinline__ float wave_sum(float v) {
#pragma unroll
    for (int o = 1; o < 64; o <<= 1) v += __shfl_xor(v, o);
    return v;
}
__device__ __forceinline__ float fast_exp2(float x) { return __builtin_amdgcn_exp2f(x); }
__device__ __forceinline__ float fast_rcp(float x) { return __builtin_amdgcn_rcpf(x); }
__device__ __forceinline__ float sigmoidf_(float x) { return fast_rcp(1.0f + fast_exp2(-1.4426950408889634f * x)); }
__device__ __forceinline__ float gelu_tanh(float x) {
    const float u = 0.7978845608028654f * (x + 0.044715f * x * x * x);
    return x * fast_rcp(1.0f + fast_exp2(-2.8853900817779268f * u));
}
#define XB_TMO      128
#define XB_XCNT(j)  (256  + 64 * (j))
#define XB_XSUB(j)  (1280 + 64 * (j))
#define XB_XGEN(j)  (2304 + 64 * (j))
#define XB_TOP      3328
#define XB_TOPGEN   3392
#define XCD_BAR_WORDS 3456
#define XB_SPIN_CAP (1u << 18)

__device__ __forceinline__ unsigned xb_ld(unsigned* p)              { return __hip_atomic_load(p, __ATOMIC_RELAXED, __HIP_MEMORY_SCOPE_AGENT); }
__device__ __forceinline__ unsigned xb_add(unsigned* p, unsigned v) { return __hip_atomic_fetch_add(p, v, __ATOMIC_RELAXED, __HIP_MEMORY_SCOPE_AGENT); }
__device__ __forceinline__ unsigned xb_xcc_id() { return (unsigned)__builtin_amdgcn_s_getreg((3 << 11) | 20) & 0xFu; }
#define XB_SPIN(cond, bar) do { unsigned _sp = 0; while (cond) { __builtin_amdgcn_s_sleep(1); \
    if ((++_sp & 255u) == 0u) { if (xb_ld(&(bar)[XB_TMO])) break; if (_sp > XB_SPIN_CAP) { atomicAdd(&(bar)[XB_TMO], 1u); break; } } } } while (0)

struct XcdBarrier {
    unsigned* bar; unsigned x;
    volatile LAS unsigned* st;
};

__device__ __forceinline__ XcdBarrier xcd_barrier_post(unsigned* bar, volatile LAS unsigned* st) {
    XcdBarrier b; b.bar = bar; b.x = xb_xcc_id(); b.st = st;
    if (threadIdx.x == 0) (void)xb_add(&bar[XB_XCNT(b.x)], 1u);
    return b;
}
__device__ __forceinline__ void xcd_barrier_complete(unsigned* bar, unsigned x, unsigned& nloc, unsigned& nx) {
    const unsigned G = gridDim.x * gridDim.y * gridDim.z;
    unsigned sum, cnt, mine, sp = 0u;
    for (;;) {
        sum = 0u; cnt = 0u; mine = 0u;
#pragma unroll
        for (unsigned j = 0; j < 16; ++j) { const unsigned c = xb_ld(&bar[XB_XCNT(j)]); sum += c; cnt += (c > 0u) ? 1u : 0u; mine = (j == x) ? c : mine; }
        if (sum == G) break;
        __builtin_amdgcn_s_sleep(1);
        if ((++sp & 255u) == 0u) { if (xb_ld(&bar[XB_TMO])) break; if (sp > XB_SPIN_CAP) { atomicAdd(&bar[XB_TMO], 1u); break; } }
    }
    nloc = mine > 0u ? mine : 1u; nx = cnt > 0u ? cnt : 1u;
}

__device__ __forceinline__ void xcd_barrier(const XcdBarrier& b) {
    asm volatile("s_waitcnt vmcnt(0)" ::: "memory");
    __syncthreads();
    if (threadIdx.x == 0) {
        unsigned* bar = b.bar;
        __builtin_amdgcn_s_waitcnt(0);
        unsigned nloc = b.st[0], nx = b.st[1];
        if (nloc == 0u) { xcd_barrier_complete(bar, b.x, nloc, nx); b.st[0] = nloc; b.st[1] = nx; }
        const unsigned old = xb_add(&bar[XB_XSUB(b.x)], 1u);
        const unsigned gen = old / nloc;
        if (old + 1u == (gen + 1u) * nloc) {
            __builtin_amdgcn_fence(__ATOMIC_RELEASE, "agent");
            asm volatile("s_waitcnt vmcnt(0)" ::: "memory");
            const unsigned og = xb_add(&bar[XB_TOP], 1u);
            const unsigned tg = og / nx;
            if (og + 1u == (tg + 1u) * nx) xb_add(&bar[XB_TOPGEN], 1u);
            else XB_SPIN(xb_ld(&bar[XB_TOPGEN]) == tg, bar);
            __builtin_amdgcn_fence(__ATOMIC_ACQUIRE, "agent");
            xb_add(&bar[XB_XGEN(b.x)], 1u);
            asm volatile("s_waitcnt vmcnt(0)" ::: "memory");
        } else {
            XB_SPIN(xb_ld(&bar[XB_XGEN(b.x)]) == gen, bar);
            __builtin_amdgcn_fence(__ATOMIC_ACQUIRE, "agent");
            asm volatile("s_waitcnt vmcnt(0)" ::: "memory");
        }
    }
    __syncthreads();
}


namespace pg8 {
constexpr int BM = 256, BK = 64, HALF = 128, HTB = HALF * BK * 2, STAGE_BYTES = 8 * HTB;
__host__ __device__ __forceinline__ int lds_byte(int r, int c) { const int st = (r >> 4) * 2 + (c >> 5), rr = r & 15, cc = c & 31, ob = rr * 64 + cc * 2; return st * 1024 + (ob ^ (((ob >> 9) & 1) << 5)); }
__host__ __device__ __forceinline__ void stage_rc(int b, int& R, int& C) { const int st = b / 1024, sb = b % 1024, swz = sb ^ (((sb >> 9) & 1) << 5); R = (st >> 1) * 16 + swz / 64; C = (st & 1) * 32 + (swz % 64) / 2; }
__host__ __device__ __forceinline__ int perm32(int rho) { const int n = rho >> 4, i = rho & 15; return 8 * (i >> 2) + 4 * n + (i & 3); }

struct GU { const char* A; const char* B; const int* gl; int K, kind, pm, pn, e, nvalid; };

__device__ __forceinline__ void grid_order(int L, int nM, int nN, int& pm, int& pn) {
    const int nwg = nM * nN; int wgid = L;
    { const int q = nwg / 8, r = nwg % 8, xcd = wgid % 8, off = wgid / 8; wgid = (xcd < r ? xcd * (q + 1) : r * (q + 1) + (xcd - r) * q) + off; }
    const int nig = 8 * nN, gid = wgid / nig, fm = gid * 8, gsz = (nM - fm) < 8 ? (nM - fm) : 8;
    pm = fm + ((wgid % nig) % gsz); pn = (wgid % nig) / gsz;
}

typedef int v8i __attribute__((ext_vector_type(8)));
typedef short bf16x16_t __attribute__((ext_vector_type(16)));
template <class Epi, class Sched, bool GATHER, bool F8 = false>
__device__ __forceinline__ void gemm_phase(LAS unsigned char* lds, const Sched& S, const Epi& E, const int lda, const int ldb, const int wid, const int lane) {
    const int tid = wid * 64 + lane;
    const int wr = wid >> 2, wc = wid & 3, fr = lane & 15, fq = lane >> 4;
    unsigned voffA[2], voffB[2]; int Rr[2], Cb[2];
#pragma unroll
    for (int i = 0; i < 2; ++i) { int R, C; stage_rc(tid * 16 + i * 8192, R, C); const int Rb = (R & ~31) + perm32(R & 31);
        Rr[i] = R; Cb[i] = C * 2; voffA[i] = (unsigned)(R * lda + C * 2); voffB[i] = (unsigned)(Rb * ldb + C * 2); }
    const size_t kstep = (size_t)(BK * 2);
    const size_t hstepA = (size_t)HALF * lda, hstepB = (size_t)HALF * ldb, qstepA = (size_t)64 * lda, qstepB = (size_t)64 * ldb;
    const unsigned ldsw = (unsigned)wid * 1024u;
    const int aoff = lds_byte(wr * 64 + fr, fq * 8), boff = lds_byte(wc * 32 + fr, fq * 8);
#define PG8_SA(b, h) (((b) * 2 + (h)) * HTB)
#define PG8_SB(b, h) ((4 + (b) * 2 + (h)) * HTB)
#define PG8_STAGE(bufoff, gbase, voff) do { _Pragma("unroll") for (int _i = 0; _i < 2; ++_i) \
        __builtin_amdgcn_global_load_lds((const unsigned*)((const char*)(gbase) + (voff)[_i]), (LAS unsigned*)(lds + (bufoff) + ldsw + _i * 8192), 16, 0, 0); } while (0)
#define PG8_STAGE1(bufoff, gbase, voff0, qstep) do { _Pragma("unroll") for (int _i = 0; _i < 2; ++_i) \
        __builtin_amdgcn_global_load_lds((const unsigned*)((const char*)(gbase) + (size_t)_i * (qstep) + (voff0)), (LAS unsigned*)(lds + (bufoff) + ldsw + _i * 8192), 16, 0, 0); } while (0)
#define PG8_STAGE_A(b, h, kp) do { if constexpr (GATHER) { if ((h) == 0) PG8_STAGE(PG8_SA(b, h), kp, gA0); else PG8_STAGE(PG8_SA(b, h), kp, gA1); } \
        else PG8_STAGE1(PG8_SA(b, h), (kp) + (h) * hstepA, voffA[0], qstepA); } while (0)
#define PG8_STAGE_B(b, h, kp) PG8_STAGE1(PG8_SB(b, h), (kp) + (h) * hstepB, voffB[0], qstepB)
#define PG8_LDA(dst, b, h) do { _Pragma("unroll") for (int m = 0; m < 4; ++m) _Pragma("unroll") for (int k = 0; k < 2; ++k) dst[m][k] = *(const LAS bf16x8*)(lds + PG8_SA(b, h) + aoff + m * 2048 + k * 1024); } while (0)
#define PG8_LDB(dst, b, h) do { _Pragma("unroll") for (int n = 0; n < 2; ++n) _Pragma("unroll") for (int k = 0; k < 2; ++k) dst[n][k] = *(const LAS bf16x8*)(lds + PG8_SB(b, h) + boff + n * 2048 + k * 1024); } while (0)
#define PG8_J8(X) __builtin_bit_cast(v8i, (bf16x16_t){X[0][0], X[0][1], X[0][2], X[0][3], X[0][4], X[0][5], X[0][6], X[0][7], X[1][0], X[1][1], X[1][2], X[1][3], X[1][4], X[1][5], X[1][6], X[1][7]})
#define PG8_MMA(ai, bj, At, Bt) do { __builtin_amdgcn_s_setprio(1); _Pragma("unroll") for (int m = 0; m < 4; ++m) _Pragma("unroll") for (int n = 0; n < 2; ++n) { \
        if constexpr (F8 && GATHER) acc[ai][bj][m][n] = __builtin_amdgcn_mfma_scale_f32_16x16x128_f8f6f4(PG8_J8(Bt[n]), PG8_J8(At[m]), acc[ai][bj][m][n], 0, 0, 0, 0x7F7F7F7F, 0, 0x7F7F7F7F); \
        else if constexpr (F8) { const v8i b8_ = PG8_J8(Bt[n]), a8_ = PG8_J8(At[m]); asm volatile("v_mfma_scale_f32_16x16x128_f8f6f4 %0, %1, %2, %0, %3, %3 op_sel_hi:[0,0,0]" : "+v"(acc[ai][bj][m][n]) : "v"(b8_), "v"(a8_), "v"(0x7F7F7F7F)); } \
        else { _Pragma("unroll") for (int k = 0; k < 2; ++k) acc[ai][bj][m][n] = __builtin_amdgcn_mfma_f32_16x16x32_bf16(Bt[n][k], At[m][k], acc[ai][bj][m][n], 0, 0, 0); } } \
        __builtin_amdgcn_s_setprio(0); } while (0)
#define PG8_WAIT_V(n) asm volatile("s_waitcnt vmcnt(" #n ")" ::: "memory")
#define PG8_WAIT_L(n) asm volatile("s_waitcnt lgkmcnt(" #n ")" ::: "memory")
#define PG8_BAR __builtin_amdgcn_s_barrier()
#define PG8_SCHED __builtin_amdgcn_sched_barrier(0)
#define PG8_GOFF(u, o0, o1) do { _Pragma("unroll") for (int _i = 0; _i < 2; ++_i) { const int _r0 = Rr[_i], _r1 = HALF + Rr[_i]; \
        const int _t0 = (_r0 < (u).nvalid) ? ((u).gl[_r0] >> 1) : 0, _t1 = (_r1 < (u).nvalid) ? ((u).gl[_r1] >> 1) : 0; \
        o0[_i] = (unsigned)_t0 * (unsigned)lda + (unsigned)Cb[_i]; o1[_i] = (unsigned)_t1 * (unsigned)lda + (unsigned)Cb[_i]; } } while (0)
    GU cur, nxt; int ui = 0;
    if (!S.next(0, cur)) return;
    f32x4 acc[2][2][4][2];
#pragma unroll
    for (int a = 0; a < 2; ++a)
#pragma unroll
        for (int b = 0; b < 2; ++b)
#pragma unroll
            for (int m = 0; m < 4; ++m)
#pragma unroll
                for (int n = 0; n < 2; ++n) acc[a][b][m][n] = (f32x4){0.f, 0.f, 0.f, 0.f};
    bf16x8 At[4][2], B0[2][2], B1[2][2];
    unsigned gA0[2] = {0u, 0u}, gA1[2] = {0u, 0u};
    if constexpr (GATHER) PG8_GOFF(cur, gA0, gA1);
    const char* cA = cur.A; const char* cB = cur.B;
    PG8_STAGE_B(0, 0, cB); PG8_STAGE_B(0, 1, cB); PG8_STAGE_A(0, 0, cA); PG8_STAGE_A(0, 1, cA);
    if (wr == 1) PG8_BAR;
    PG8_WAIT_V(2); PG8_BAR;
    PG8_STAGE_B(1, 0, cB + kstep); PG8_STAGE_A(1, 0, cA + kstep); PG8_STAGE_B(1, 1, cB + kstep);
    PG8_WAIT_V(6); PG8_BAR;
    for (;;) {
        const bool has_next = S.next(ui + 1, nxt);
        int nid[2][2] = {{0, 0}, {0, 0}};
        if constexpr (GATHER) { if (has_next) {
#pragma unroll
            for (int _i = 0; _i < 2; ++_i) { const int _r0 = Rr[_i], _r1 = HALF + Rr[_i]; nid[0][_i] = nxt.gl[_r0 < nxt.nvalid ? _r0 : 0]; nid[1][_i] = nxt.gl[_r1 < nxt.nvalid ? _r1 : 0]; } } }
        const char* nA = has_next ? nxt.A : cA; const char* nB = has_next ? nxt.B : cB;
        const int nt = F8 ? cur.K / 128 : cur.K / BK;
        for (int t = 0; t < nt; t += 2) {
            const bool last = (t == nt - 2);
            const char* a1 = cA + (size_t)(t + 1) * kstep;
            const char* a2 = last ? nA : cA + (size_t)(t + 2) * kstep; const char* b2 = last ? nB : cB + (size_t)(t + 2) * kstep;
            const char* a3 = a2 + kstep; const char* b3 = b2 + kstep;
            PG8_LDB(B0, 0, 0); PG8_LDB(B1, 0, 1); PG8_SCHED; PG8_LDA(At, 0, 0); PG8_STAGE_A(1, 1, a1);
            if constexpr (GATHER) { if (last && has_next) {
#pragma unroll
                for (int _i = 0; _i < 2; ++_i) { const int _r0 = Rr[_i], _r1 = HALF + Rr[_i];
                    const int _t0 = (_r0 < nxt.nvalid) ? (nid[0][_i] >> 1) : 0, _t1 = (_r1 < nxt.nvalid) ? (nid[1][_i] >> 1) : 0;
                    gA0[_i] = (unsigned)_t0 * (unsigned)lda + (unsigned)Cb[_i]; gA1[_i] = (unsigned)_t1 * (unsigned)lda + (unsigned)Cb[_i]; } } }
            PG8_WAIT_V(8); PG8_WAIT_L(0); PG8_BAR; PG8_MMA(0, 0, At, B0); PG8_MMA(0, 1, At, B1); PG8_BAR; PG8_SCHED;
            PG8_LDA(At, 0, 1); PG8_STAGE_B(0, 0, b2); PG8_STAGE_B(0, 1, b2); PG8_STAGE_A(0, 0, a2);
            PG8_WAIT_V(8); PG8_WAIT_L(0); PG8_BAR; PG8_MMA(1, 0, At, B0); PG8_MMA(1, 1, At, B1); PG8_BAR; PG8_SCHED;
            PG8_LDB(B0, 1, 0); PG8_LDB(B1, 1, 1); PG8_SCHED; PG8_LDA(At, 1, 0); PG8_STAGE_A(0, 1, a2);
            PG8_WAIT_V(8); PG8_WAIT_L(0); PG8_BAR; PG8_MMA(0, 0, At, B0); PG8_MMA(0, 1, At, B1); PG8_BAR; PG8_SCHED;
            PG8_LDA(At, 1, 1); PG8_STAGE_B(1, 0, b3); PG8_STAGE_B(1, 1, b3); PG8_STAGE_A(1, 0, a3);
            PG8_WAIT_V(8); PG8_WAIT_L(0); PG8_BAR; PG8_MMA(1, 0, At, B0); PG8_MMA(1, 1, At, B1); PG8_BAR; PG8_SCHED;
        }
        if (wr == 0) PG8_BAR;
        if constexpr (F8) { asm volatile("s_nop 15\n\ts_nop 15" ::: "memory"); PG8_SCHED; }
        E(acc, cur, wr, wc, fr, fq);
        if (!has_next) break;
#pragma unroll
        for (int a = 0; a < 2; ++a)
#pragma unroll
            for (int b = 0; b < 2; ++b)
#pragma unroll
                for (int m = 0; m < 4; ++m)
#pragma unroll
                    for (int n = 0; n < 2; ++n) acc[a][b][m][n] = (f32x4){0.f, 0.f, 0.f, 0.f};
        cur = nxt; cA = nA; cB = nB; ++ui;
        if (wr == 1) PG8_BAR;
    }
    PG8_WAIT_V(0);
    PG8_BAR;
#undef PG8_SA
#undef PG8_SB
#undef PG8_STAGE
#undef PG8_STAGE1
#undef PG8_STAGE_A
#undef PG8_STAGE_B
#undef PG8_LDA
#undef PG8_LDB
#undef PG8_MMA
#undef PG8_J8
#undef PG8_WAIT_V
#undef PG8_WAIT_L
#undef PG8_BAR
#undef PG8_SCHED
#undef PG8_GOFF
}
}

struct Args { const float* in[40]; float* out; unsigned char* ws; int ph_lo, ph_hi; };
typedef const __attribute__((address_space(4))) Args* ArgsP;
enum InIdx { I_X = 0, I_C, I_CTX, I_CCTX, I_ADAW, I_ADAB, I_WIN, I_GMLNG, I_GMLNB, I_GMWS, I_GMBS, I_HYCW, I_HYCB, I_HYW1, I_HYB1, I_HYW2, I_HYB2, I_HYW3, I_HYB3, I_HYSKIP,
             I_LQ1, I_LK1, I_LQ2, I_LK2, I_DANG, I_PA, I_PB, I_PC, I_WOUT, I_LN1G, I_LN1B, I_MOEWG, I_MOEBG, I_MOEWE, I_MOEBE, I_EXG, I_EXU, I_EXD, I_LN2G, I_LN2B };

struct Frame {
    LAS unsigned char* lds;
    volatile LAS unsigned* MISC;
    unsigned* ctl;
    int tid, lane, wave, G, bid, gw, NGW;
    unsigned char* ws;
};

template <int MODE>
__device__ __forceinline__ void cvt_item(const float* __restrict__ W, int N, bf16_t* __restrict__ WT, int ldk, int item, int lane) {
    const int nblk = N >> 6, kb = item / nblk, nb = item - kb * nblk, n = nb * 64 + lane, k0 = kb * 64;
    int row = n; if (MODE == 1) row = 8 * (n >> 2) + (n & 3); if (MODE == 2) row = 8 * (n >> 2) + 4 + (n & 3);
    const float* src = W + (size_t)k0 * N + n;
    bf16_t* dst = WT + (size_t)row * ldk + k0;
#pragma unroll 1
    for (int q = 0; q < 8; ++q) {
        float v[8];
#pragma unroll
        for (int j = 0; j < 8; ++j) v[j] = src[(size_t)(q * 8 + j) * N];
        u32x4 o; o.x = pk2(v[0], v[1]); o.y = pk2(v[2], v[3]); o.z = pk2(v[4], v[5]); o.w = pk2(v[6], v[7]);
        *(u32x4*)(dst + q * 8) = o;
    }
}

template <int MODE, bool F8W = false>
__device__ __forceinline__ void tr_item(const float* __restrict__ W, int N, bf16_t* __restrict__ WT, int ldk, LAS float* scr, int item, int lane, int nblk = 0) {
    if (nblk == 0) nblk = N >> 5;
    const int kb = item / nblk, nb = item - kb * nblk, k0 = 64 * kb, n0 = 32 * nb;
    const float* src = W + (size_t)k0 * N + n0 + (lane & 31) + (size_t)(lane >> 5) * N;
#pragma unroll 8
    for (int i = 0; i < 32; ++i) scr[(2 * i + (lane >> 5)) * 33 + (lane & 31)] = src[(size_t)(2 * i) * N];
    asm volatile("s_waitcnt lgkmcnt(0)" ::: "memory");
    const int c = lane & 7;
#pragma unroll
    for (int j = 0; j < 4; ++j) { const int n = n0 + (lane >> 3) + 8 * j; const LAS float* s = scr + (8 * c) * 33 + (lane >> 3) + 8 * j;
        int row = n; if (MODE == 1) row = 8 * (n >> 2) + (n & 3); if (MODE == 2) row = 8 * (n >> 2) + 4 + (n & 3);
        if constexpr (F8W) { u32x2 o; o.x = pk4_fp8(s[0 * 33] * W8S, s[1 * 33] * W8S, s[2 * 33] * W8S, s[3 * 33] * W8S); o.y = pk4_fp8(s[4 * 33] * W8S, s[5 * 33] * W8S, s[6 * 33] * W8S, s[7 * 33] * W8S);
            *(u32x2*)((unsigned char*)WT + (size_t)row * ldk + k0 + 8 * c) = o; }
        else { u32x4 o; o.x = pk2(s[0 * 33], s[1 * 33]); o.y = pk2(s[2 * 33], s[3 * 33]); o.z = pk2(s[4 * 33], s[5 * 33]); o.w = pk2(s[6 * 33], s[7 * 33]);
            *(u32x4*)(WT + (size_t)row * ldk + k0 + 8 * c) = o; } }
    asm volatile("s_waitcnt lgkmcnt(0)" ::: "memory");
}

template <int MODE, bool F8W>
__device__ __forceinline__ void tr_item2(const float* __restrict__ W, int N, bf16_t* __restrict__ WT, int ldk, LAS float* scr, int item, int lane) {
    const int nblk = N >> 5;
    float v[2][32];
#pragma unroll
    for (int t = 0; t < 2; ++t) { const int it = item + t, kb = it / nblk, nb = it - kb * nblk;
        const float* src = W + (size_t)(64 * kb) * N + 32 * nb + (lane & 31) + (size_t)(lane >> 5) * N;
#pragma unroll
        for (int i = 0; i < 32; ++i) v[t][i] = src[(size_t)(2 * i) * N]; }
#pragma unroll
    for (int t = 0; t < 2; ++t) { const int it = item + t, kb = it / nblk, nb = it - kb * nblk, k0 = 64 * kb, n0 = 32 * nb;
#pragma unroll
        for (int i = 0; i < 32; ++i) scr[(2 * i + (lane >> 5)) * 33 + (lane & 31)] = v[t][i];
        asm volatile("s_waitcnt lgkmcnt(0)" ::: "memory");
        const int c = lane & 7;
#pragma unroll
        for (int j = 0; j < 4; ++j) { const int n = n0 + (lane >> 3) + 8 * j; const LAS float* s = scr + (8 * c) * 33 + (lane >> 3) + 8 * j;
            int row = n; if (MODE == 1) row = 8 * (n >> 2) + (n & 3); if (MODE == 2) row = 8 * (n >> 2) + 4 + (n & 3);
            if constexpr (F8W) { u32x2 o; o.x = pk4_fp8(s[0 * 33] * W8S, s[1 * 33] * W8S, s[2 * 33] * W8S, s[3 * 33] * W8S); o.y = pk4_fp8(s[4 * 33] * W8S, s[5 * 33] * W8S, s[6 * 33] * W8S, s[7 * 33] * W8S);
                *(u32x2*)((unsigned char*)WT + (size_t)row * ldk + k0 + 8 * c) = o; }
            else { u32x4 o; o.x = pk2(s[0 * 33], s[1 * 33]); o.y = pk2(s[2 * 33], s[3 * 33]); o.z = pk2(s[4 * 33], s[5 * 33]); o.w = pk2(s[6 * 33], s[7 * 33]);
                *(u32x4*)(WT + (size_t)row * ldk + k0 + 8 * c) = o; } }
        asm volatile("s_waitcnt lgkmcnt(0)" ::: "memory"); }
}

__device__ __forceinline__ void p0a_prologue(Frame& F, ArgsP a) {
    {
        constexpr int I_WIN_ = 16 * 184, I_PA_ = 4 * 32, I_PC_ = 8 * 32, I_WO_ = 16 * 32, PER = I_WIN_ + 2 * I_PA_ + I_PC_ + I_WO_;
        LAS float* scr = (LAS float*)(F.lds + F.wave * 8448);
        for (int it = F.gw; it < 2 * PER; it += F.NGW) {
            const int l = it / PER; int r = it - l * PER;
            bf16_t* wsl = (bf16_t*)(F.ws + WS_WS + (size_t)l * WSL);
            if (r < I_WIN_) { tr_item<0>(a->in[I_WIN] + (size_t)l * D * NIN, NIN, wsl, D, scr, r, F.lane); continue; } r -= I_WIN_;
            bf16_t* pt = wsl + 6 * MiB;
            if (r < I_PA_) { tr_item<0>(a->in[I_PA] + (size_t)l * 256 * D, D, pt, D, scr, r, F.lane); continue; } r -= I_PA_;
            if (r < I_PA_) { tr_item<0>(a->in[I_PB] + (size_t)l * 256 * D, D, pt + (size_t)D * D, D, scr, r, F.lane); continue; } r -= I_PA_;
            if (r < I_PC_) { tr_item<0>(a->in[I_PC] + (size_t)l * 512 * D, D, pt + (size_t)2 * D * D, D, scr, r, F.lane); continue; } r -= I_PC_;
            tr_item<0>(a->in[I_WOUT] + (size_t)l * D * D, D, wsl + 9 * MiB, D, scr, r, F.lane);
        }
        __syncthreads();
    }
    {
        LAS float* s = (LAS float*)F.lds;
        float* modp = (float*)(F.ws + WS_MODP);
        for (int u = F.bid; u < 192; u += F.G) {
            const int cb = u % 24, kc = u / 24, n = cb * 512 + F.tid, l = n / 6144, col = n - l * 6144;
            __syncthreads();
            for (int i = F.tid; i < 33 * 128; i += NTHREADS) { const int r = i >> 7, k = i & 127; const float c = (r < 32) ? a->in[I_C][r * D + kc * 128 + k] : a->in[I_CCTX][kc * 128 + k];
                s[i] = c * sigmoidf_(c); }
            __syncthreads();
            float acc[33];
#pragma unroll
            for (int r = 0; r < 33; ++r) acc[r] = 0.f;
            const float* w = a->in[I_ADAW] + ((size_t)l * D + kc * 128) * 6144 + col;
            for (int k = 0; k < 128; k += 4) {
                const float w0 = w[(size_t)k * 6144], w1 = w[(size_t)(k + 1) * 6144], w2 = w[(size_t)(k + 2) * 6144], w3 = w[(size_t)(k + 3) * 6144];
#pragma unroll
                for (int r = 0; r < 33; ++r) { const f32x4 sv = *(const LAS f32x4*)(s + r * 128 + k); acc[r] += sv.x * w0 + sv.y * w1 + sv.z * w2 + sv.w * w3; }
            }
#pragma unroll
            for (int r = 0; r < 33; ++r) modp[((size_t)(kc * 2 + l) * 33 + r) * 6144 + col] = acc[r];
        }
        __syncthreads();
    }
    {
        float* HF = (float*)(F.ws + WS_HF);
        for (int p = F.gw; p < 4096 + 256; p += F.NGW) {
            const bool isc = p >= 4096; const int l = isc ? 0 : (p >> 11), d = isc ? (p - 4096) : (p & 2047), L = isc ? 256 : 2048;
            const float t = (float)d / (float)(L - 1), w = 6.283185307179586f * (float)d / (float)L;
            const int lane = F.lane;
            float emb = 0.f;
            if (lane == 0) emb = t;
            else if (lane <= 32) { const int j = (lane - 1) & 15; const float f = 1e-4f + (float)j * ((15.0f - 1e-4f) / 15.0f); const float ang = f * w; emb = (lane <= 16) ? cosf(ang) : -sinf(ang); }
            const float* w1 = a->in[I_HYW1] + (size_t)l * 33 * 64; const float* w2 = a->in[I_HYW2] + (size_t)l * 64 * 64; const float* w3 = a->in[I_HYW3] + (size_t)l * 64 * 512;
            float z = a->in[I_HYB1][l * 64 + lane];
            for (int i = 0; i < 33; ++i) z += __shfl(emb, i) * w1[i * 64 + lane];
            const float h1 = sinf(z);
            z = a->in[I_HYB2][l * 64 + lane];
            for (int i = 0; i < 64; ++i) z += __shfl(h1, i) * w2[i * 64 + lane];
            const float h2 = sinf(z);
            float o[8];
#pragma unroll
            for (int m = 0; m < 8; ++m) o[m] = a->in[I_HYB3][l * 512 + lane + 64 * m];
            for (int i = 0; i < 64; ++i) { const float hv = __shfl(h2, i);
#pragma unroll
                for (int m = 0; m < 8; ++m) o[m] += hv * w3[i * 512 + lane + 64 * m]; }
            float* dst = (isc ? (HF + (size_t)2 * 2048 * 512) : (HF + (size_t)l * 2048 * 512)) + d;
            const float mind = -3.0701134573253945f, maxd = -15.350567286626973f;
#pragma unroll
            for (int m = 0; m < 8; ++m) { const int n = lane + 64 * m, c = n & 255; const float delta = fabsf(mind + (float)c * ((maxd - mind) / 255.0f));
                dst[(size_t)n * L] = o[m] * (expf(-t * delta) + 0.05f); }
        }
    }
    {
        const float* src = a->in[I_GMWS]; unsigned* dst = (unsigned*)(F.ws + WS_WSB);
        for (int i = F.bid * NTHREADS + F.tid; i < 2 * 4 * 128 * 128 / 2; i += F.G * NTHREADS) dst[i] = pk2(src[2 * i], src[2 * i + 1]);
    }
    {
        float* COS = (float*)(F.ws + WS_ROPE); float* SIN = COS + 65536;
        for (int e = F.bid * NTHREADS + F.tid; e < 65536; e += F.G * NTHREADS) {
            const int t = e >> 5, ax = (e >> 4) & 1, i = e & 15; const float pos = (float)(ax ? (t & 63) : (t >> 6));
            const float inv = powf(10000.0f, -(float)i / 16.0f), ang = pos * inv;
            COS[e] = cosf(ang); SIN[e] = sinf(ang);
        }
    }
}

__device__ __forceinline__ void p0b_mod(Frame& F, ArgsP a) {
    const float* modp = (const float*)(F.ws + WS_MODP); float* mod = (float*)(F.ws + WS_MOD);
    for (int i = F.bid * NTHREADS + F.tid; i < 2 * 33 * 6144; i += F.G * NTHREADS) {
        const int l = i / (33 * 6144), rem = i - l * 33 * 6144, r = rem / 6144, col = rem - r * 6144;
        float s = a->in[I_ADAB][l * 6144 + col];
#pragma unroll
        for (int kc = 0; kc < 8; ++kc) s += modp[((size_t)(kc * 2 + l) * 33 + r) * 6144 + col];
        mod[i] = s;
    }
}

__device__ __forceinline__ int mod_row(int row) { return row < TL ? (row >> 11) : 32; }

__device__ __forceinline__ void phase_modulate0(Frame& F, ArgsP a) {
    const float* mod = (const float*)(F.ws + WS_MOD); bf16_t* HB = (bf16_t*)(F.ws + WS_HB);
    for (int row0 = F.gw; row0 < TA; row0 += 4 * F.NGW) {
        f32x4 xv[4][4];
#pragma unroll
        for (int q = 0; q < 4; ++q) { const int row = row0 + q * F.NGW; const float* src = row < TL ? a->in[I_X] + (size_t)row * D : a->in[I_CTX] + (size_t)(row - TL) * D;
#pragma unroll
            for (int j = 0; j < 4; ++j) xv[q][j] = *(const f32x4*)(src + 4 * F.lane + 256 * j); }
#pragma unroll
        for (int q = 0; q < 4; ++q) { const int row = row0 + q * F.NGW; const float* m = mod + (size_t)mod_row(row) * 6144;
            u32x2* dst = (u32x2*)(HB + (size_t)row * D);
#pragma unroll
            for (int j = 0; j < 4; ++j) { const int c = 4 * F.lane + 256 * j; const f32x4 x = xv[q][j], sh = *(const f32x4*)(m + c), sc = *(const f32x4*)(m + 1024 + c);
                const float h0 = x.x * (1.f + sc.x) + sh.x, h1 = x.y * (1.f + sc.y) + sh.y, h2 = x.z * (1.f + sc.z) + sh.z, h3 = x.w * (1.f + sc.w) + sh.w;
                u32x2 o; o.x = pk2(h0, h1); o.y = pk2(h2, h3); dst[F.lane + 64 * j] = o; } }
    }
}

struct SchedIn {
    int G, c, nreg, nctx; const char* A; const char* B;
    int nM;
    __device__ __forceinline__ bool next(int i, pg8::GU& u) const {
        const int L = i * G + c; if (L >= nreg + nctx) return false;
        int pm, pn;
        if (L < nreg) pg8::grid_order(L, nM, 11, pm, pn);
        else { const int j = L - nreg; pm = 256 + (j >> 2); pn = 7 + (j & 3); }
        u.A = A + (size_t)pm * 256 * 2048; u.B = B + (size_t)pn * 256 * 2048; u.gl = nullptr; u.K = 1024; u.kind = 0; u.pm = pm; u.pn = pn; u.e = 0; u.nvalid = 256;
        return true;
    }
};
struct EpiIn {
    bf16_t *ZG, *ZH, *Q, *K, *V; const float* COS;
    __device__ __forceinline__ void rope_store(const f32x4 (&acc)[2][2][4][2], const pg8::GU& u, int wr, int wc, int fr, int fq, bf16_t* base, int colt, float sc) const {
        const int row0 = u.pm * 256 + wr * 64 + fr, col0 = colt + wc * 32 + 8 * fq;
        const float sgn = (fq < 2) ? -1.0f : 1.0f; const bool lowhalf = fq < 2;
        const float* SIN = COS + 65536; const int toff = (wc & 1) * 16 + 8 * (fq & 1);
#pragma unroll
        for (int ai = 0; ai < 2; ++ai)
#pragma unroll
            for (int m = 0; m < 4; ++m) { const int row = row0 + ai * 128 + m * 16, t = row & (SEQ - 1);
                const f32x4 c0 = *(const f32x4*)(COS + t * 32 + toff), c1 = *(const f32x4*)(COS + t * 32 + toff + 4), s0 = *(const f32x4*)(SIN + t * 32 + toff) * sgn, s1 = *(const f32x4*)(SIN + t * 32 + toff + 4) * sgn;
#pragma unroll
                for (int bj = 0; bj < 2; ++bj) { const f32x4 v0 = acc[ai][bj][m][0], v1 = acc[ai][bj][m][1]; f32x4 p0, p1;
#pragma unroll
                    for (int j = 0; j < 4; ++j) {
                        auto ra = __builtin_amdgcn_permlane32_swap(__float_as_uint(v0[j]), __float_as_uint(v0[j]), false, false); p0[j] = __uint_as_float(lowhalf ? ra[1] : ra[0]);
                        auto rb = __builtin_amdgcn_permlane32_swap(__float_as_uint(v1[j]), __float_as_uint(v1[j]), false, false); p1[j] = __uint_as_float(lowhalf ? rb[1] : rb[0]); }
                    const f32x4 o0 = (v0 * c0 + p0 * s0) * sc, o1 = (v1 * c1 + p1 * s1) * sc;
                    u32x4 w; w.x = pk2(o0[0], o0[1]); w.y = pk2(o0[2], o0[3]); w.z = pk2(o1[0], o1[1]); w.w = pk2(o1[2], o1[3]);
                    *(u32x4*)(base + (size_t)row * 512 + col0 + bj * 128) = w; } }
    }
    __device__ __forceinline__ void operator()(const f32x4 (&acc)[2][2][4][2], const pg8::GU& u, int wr, int wc, int fr, int fq) const {
        const int pn = u.pn; bf16_t* base; int ldc, colt, act = 0; float sc = 1.f;
        if (MK_ROPE_EPI && pn >= 5 && pn < 9 && u.pm < 256) { if (pn < 7) rope_store(acc, u, wr, wc, fr, fq, Q, (pn - 5) * 256, QSCALE); else rope_store(acc, u, wr, wc, fr, fq, K, (pn - 7) * 256, 1.0f); return; }
        if (pn < 2) { base = ZG; ldc = 512; colt = pn * 256; act = 1; }
        else if (pn < 5) { base = ZH; ldc = 768; colt = (pn - 2) * 256; }
        else if (pn < 7) { base = Q; ldc = 512; colt = (pn - 5) * 256; sc = QSCALE; }
        else if (pn < 9) { base = K; ldc = 512; colt = (pn - 7) * 256; }
        else { base = V; ldc = 512; colt = (pn - 9) * 256; }
        const int row0 = u.pm * 256 + wr * 64 + fr, col0 = colt + wc * 32 + 8 * fq;
#pragma unroll
        for (int ai = 0; ai < 2; ++ai)
#pragma unroll
            for (int m = 0; m < 4; ++m) { bf16_t* rowp = base + (size_t)(row0 + ai * 128 + m * 16) * ldc + col0;
#pragma unroll
                for (int bj = 0; bj < 2; ++bj) { f32x4 v0 = acc[ai][bj][m][0], v1 = acc[ai][bj][m][1];
                    if (act) {
#pragma unroll
                        for (int j = 0; j < 4; ++j) { v0[j] = gelu_tanh(v0[j]); v1[j] = gelu_tanh(v1[j]); } }
                    else { v0 = v0 * sc; v1 = v1 * sc; }
                    u32x4 w; w.x = pk2(v0[0], v0[1]); w.y = pk2(v0[2], v0[3]); w.z = pk2(v1[0], v1[1]); w.w = pk2(v1[2], v1[3]);
                    *(u32x4*)(rowp + bj * 128) = w; } }
    }
};

__device__ __forceinline__ void gmlp_unit(Frame& F, ArgsP a, int l, int chunk) {
    const bf16_t* ZG = (const bf16_t*)(F.ws + WS_ZG); bf16_t* YC = (bf16_t*)(F.ws + WS_YCAT);
    LAS bf16_t* vT = (LAS bf16_t*)F.lds;
    const int row0 = chunk * 128, lane = F.lane;
    __syncthreads();
    {
        const f32x4 g = *(const f32x4*)(a->in[I_GMLNG] + l * 256 + 4 * lane), bb = *(const f32x4*)(a->in[I_GMLNB] + l * 256 + 4 * lane);
        u32x2 wv[16];
#pragma unroll
        for (int i = 0; i < 16; ++i) wv[i] = *(const u32x2*)(ZG + (size_t)(row0 + F.wave + 8 * i) * 512 + 256 + 4 * lane);
#pragma unroll
        for (int i0 = 0; i0 < 16; i0 += 4) {
            f32x4 v[4]; float s[4], qq[4];
#pragma unroll
            for (int k = 0; k < 4; ++k) { const u32x2 w = wv[i0 + k]; v[k] = (f32x4){bf_lo(w.x), bf_hi(w.x), bf_lo(w.y), bf_hi(w.y)}; s[k] = (v[k].x + v[k].y) + (v[k].z + v[k].w); }
#pragma unroll
            for (int o = 1; o < 64; o <<= 1)
#pragma unroll
                for (int k = 0; k < 4; ++k) s[k] += __shfl_xor(s[k], o);
#pragma unroll
            for (int k = 0; k < 4; ++k) { v[k] = v[k] - s[k] * (1.f / 256.f); qq[k] = (v[k].x * v[k].x + v[k].y * v[k].y) + (v[k].z * v[k].z + v[k].w * v[k].w); }
#pragma unroll
            for (int o = 1; o < 64; o <<= 1)
#pragma unroll
                for (int k = 0; k < 4; ++k) qq[k] += __shfl_xor(qq[k], o);
#pragma unroll
            for (int k = 0; k < 4; ++k) { const int q = F.wave + 8 * (i0 + k); const float rstd = 1.0f / sqrtf(qq[k] * (1.f / 256.f) + LN_EPS);
                const f32x4 y = v[k] * rstd * g + bb;
                const unsigned p01 = pk2(y.x, y.y), p23 = pk2(y.z, y.w);
                vT[(4 * lane + 0) * 136 + q] = (bf16_t)(p01 & 0xffffu); vT[(4 * lane + 1) * 136 + q] = (bf16_t)(p01 >> 16);
                vT[(4 * lane + 2) * 136 + q] = (bf16_t)(p23 & 0xffffu); vT[(4 * lane + 3) * 136 + q] = (bf16_t)(p23 >> 16); }
        }
    }
    const int g = F.wave >> 1, ct = F.wave & 1, r32 = lane & 31, hi = lane >> 5;
    const bf16_t* wsb = (const bf16_t*)(F.ws + WS_WSB) + ((size_t)(l * 4 + g) * 128 + r32) * 128 + 8 * hi;
    bf16x8 Af[4][4];
#pragma unroll
    for (int ks = 0; ks < 4; ++ks)
#pragma unroll
        for (int pt = 0; pt < 4; ++pt) Af[ks][pt] = *(const bf16x8*)(wsb + (size_t)pt * 32 * 128 + 16 * ks);
    __syncthreads();
    const LAS unsigned char* vb = (const LAS unsigned char*)vT + (g * 64 + ct * 32 + r32) * 272 + 16 * hi;
    f32x16 acc[4];
#pragma unroll
    for (int pt = 0; pt < 4; ++pt) acc[pt] = (f32x16){0.f};
#pragma unroll
    for (int ks = 0; ks < 8; ++ks) { const bf16x8 B = *(const LAS bf16x8*)(vb + 32 * ks);
#pragma unroll
        for (int pt = 0; pt < 4; ++pt) { const bf16x8 A = ks < 4 ? Af[ks & 3][pt] : *(const bf16x8*)(wsb + (size_t)pt * 32 * 128 + 16 * ks); acc[pt] = __builtin_amdgcn_mfma_f32_32x32x16_bf16(A, B, acc[pt], 0, 0, 0); } }
    u32x4 uwp[8];
#pragma unroll
    for (int q = 0; q < 8; ++q) { const int it = q * NTHREADS + F.tid; uwp[q] = *(const u32x4*)(ZG + (size_t)(row0 + (it >> 5)) * 512 + (it & 31) * 8); }
    const int c = g * 64 + ct * 32 + r32;
    const float* bsr = a->in[I_GMBS] + (l * 4 + g) * 128;
    LAS bf16_t* ot = (LAS bf16_t*)(F.lds + 73728);
#pragma unroll
    for (int pt = 0; pt < 4; ++pt)
#pragma unroll
        for (int r = 0; r < 16; ++r) { const int p = 32 * pt + (r & 3) + 8 * (r >> 2) + 4 * hi;
            ot[p * 264 + c] = (bf16_t)(pk2(acc[pt][r] + bsr[p], 0.f) & 0xffffu); }
    __syncthreads();
#pragma unroll
    for (int q = 0; q < 8; ++q) { const int it = q * NTHREADS + F.tid; const int p = it >> 5, c8 = (it & 31) * 8;
        const u32x4 uw = uwp[q], ow = *(const LAS u32x4*)(ot + p * 264 + c8);
        u32x4 y; y.x = pk2(bf_lo(uw.x) * bf_lo(ow.x), bf_hi(uw.x) * bf_hi(ow.x)); y.y = pk2(bf_lo(uw.y) * bf_lo(ow.y), bf_hi(uw.y) * bf_hi(ow.y));
        y.z = pk2(bf_lo(uw.z) * bf_lo(ow.z), bf_hi(uw.z) * bf_hi(ow.z)); y.w = pk2(bf_lo(uw.w) * bf_lo(ow.w), bf_hi(uw.w) * bf_hi(ow.w));
        *(u32x4*)(YC + (size_t)(row0 + p) * 1024 + c8) = y; }
}

__device__ __forceinline__ void sconv_unit(Frame& F, ArgsP a, int l, int blk) {
    const bf16_t* ZH = (const bf16_t*)(F.ws + WS_ZH); bf16_t* X0 = (bf16_t*)(F.ws + WS_X0); bf16_t* VT = (bf16_t*)(F.ws + WS_VT);
    LAS bf16_t* vt = (LAS bf16_t*)F.lds;
    const int row0 = blk * 128; const bool lat = row0 < TL;
    const int Lseq = lat ? SEQ : CTXL, seq0 = lat ? (row0 & ~(SEQ - 1)) : TL + ((row0 - TL) & ~(CTXL - 1));
    const float* cw = a->in[I_HYCW] + (size_t)l * 3 * 768; const float* cb = a->in[I_HYCB] + (size_t)l * 768;
    __syncthreads();
    const int c = (F.tid & 31) * 8;
    float wt[3][4][8];
#pragma unroll
    for (int part = 0; part < 3; ++part)
#pragma unroll
        for (int k = 0; k < 4; ++k) { const float* s = (k < 3 ? cw + k * 768 : cb) + part * 256 + c; const f32x4 lo = *(const f32x4*)s, hi4 = *(const f32x4*)(s + 4);
#pragma unroll
            for (int j = 0; j < 4; ++j) { wt[part][k][j] = lo[j]; wt[part][k][4 + j] = hi4[j]; } }
    for (int it = F.tid; it < 128 * 32; it += NTHREADS) {
        const int rl = it >> 5, row = row0 + rl;
        const bool hasp = row > seq0, hasn = row < seq0 + Lseq - 1;
        float zc[3][8];
#pragma unroll
        for (int part = 0; part < 3; ++part) {
            const int col = part * 256 + c; const bf16_t* zp = ZH + (size_t)row * 768 + col;
            const u32x4 zero = {0u, 0u, 0u, 0u};
            const u32x4 z1 = *(const u32x4*)zp; const u32x4 z0 = hasp ? *(const u32x4*)(zp - 768) : zero; const u32x4 z2 = hasn ? *(const u32x4*)(zp + 768) : zero;
            const unsigned a0[4] = {z0.x, z0.y, z0.z, z0.w}, a1[4] = {z1.x, z1.y, z1.z, z1.w}, a2[4] = {z2.x, z2.y, z2.z, z2.w};
#pragma unroll
            for (int j = 0; j < 4; ++j) {
                zc[part][2 * j] = bf_lo(a0[j]) * wt[part][0][2 * j] + bf_lo(a1[j]) * wt[part][1][2 * j] + bf_lo(a2[j]) * wt[part][2][2 * j] + wt[part][3][2 * j];
                zc[part][2 * j + 1] = bf_hi(a0[j]) * wt[part][0][2 * j + 1] + bf_hi(a1[j]) * wt[part][1][2 * j + 1] + bf_hi(a2[j]) * wt[part][2][2 * j + 1] + wt[part][3][2 * j + 1];
            }
        }
        u32x4 o; o.x = pk2(zc[0][0], zc[0][1]); o.y = pk2(zc[0][2], zc[0][3]); o.z = pk2(zc[0][4], zc[0][5]); o.w = pk2(zc[0][6], zc[0][7]);
        *(u32x4*)(X0 + (size_t)row * 256 + c) = o;
#pragma unroll
        for (int j = 0; j < 8; ++j) vt[(c + j) * 136 + rl] = (bf16_t)(pk2(zc[2][j] * zc[1][j], 0.f) & 0xffffu);
    }
    __syncthreads();
    const size_t cstride = lat ? (size_t)TL : (size_t)TC; bf16_t* vbase = lat ? VT + row0 : VT + (size_t)256 * TL + (row0 - TL);
    for (int it = F.tid; it < 256 * 16; it += NTHREADS) {
        const int c = it >> 4, ch = it & 15;
        const u32x4 v = *(const LAS u32x4*)(vt + c * 136 + ch * 8);
        *(u32x4*)(vbase + (size_t)c * cstride + ch * 8) = v;
    }
}

__device__ __forceinline__ void rope_unit(Frame& F, int blk, const float sgn = 1.0f) {
    bf16_t* Q = (bf16_t*)(F.ws + WS_Q); bf16_t* K = (bf16_t*)(F.ws + WS_K);
    const float* COS = (const float*)(F.ws + WS_ROPE); const float* SIN = COS + 65536;
    const int row0 = blk * 128;
    for (int it = F.tid; it < 128 * 16; it += NTHREADS) {
        const int rl = it >> 4, which = (it >> 3) & 1, hm = it & 7, row = row0 + rl, t = row & (SEQ - 1);
        bf16_t* p = (which ? K : Q) + (size_t)row * 512 + hm * 64;
#pragma unroll
        for (int ax = 0; ax < 2; ++ax) {
            u32x4 x1[2], x2[2];
            x1[0] = *(const u32x4*)(p + ax * 32); x1[1] = *(const u32x4*)(p + ax * 32 + 8); x2[0] = *(const u32x4*)(p + ax * 32 + 16); x2[1] = *(const u32x4*)(p + ax * 32 + 24);
            const float* cs = COS + t * 32 + ax * 16; const float* sn = SIN + t * 32 + ax * 16;
            u32x4 o1[2], o2[2];
#pragma unroll
            for (int hh = 0; hh < 2; ++hh) {
                const unsigned a[4] = {x1[hh].x, x1[hh].y, x1[hh].z, x1[hh].w}, b[4] = {x2[hh].x, x2[hh].y, x2[hh].z, x2[hh].w}; unsigned r1[4], r2[4];
#pragma unroll
                for (int j = 0; j < 4; ++j) { const int i0 = hh * 8 + 2 * j; const float c0 = cs[i0], s0 = sgn * sn[i0], c1 = cs[i0 + 1], s1 = sgn * sn[i0 + 1];
                    const float a0 = bf_lo(a[j]), a1 = bf_hi(a[j]), b0 = bf_lo(b[j]), b1 = bf_hi(b[j]);
                    r1[j] = pk2(a0 * c0 - b0 * s0, a1 * c1 - b1 * s1); r2[j] = pk2(b0 * c0 + a0 * s0, b1 * c1 + a1 * s1); }
                o1[hh] = (u32x4){r1[0], r1[1], r1[2], r1[3]}; o2[hh] = (u32x4){r2[0], r2[1], r2[2], r2[3]};
            }
            *(u32x4*)(p + ax * 32) = o1[0]; *(u32x4*)(p + ax * 32 + 8) = o1[1]; *(u32x4*)(p + ax * 32 + 16) = o2[0]; *(u32x4*)(p + ax * 32 + 24) = o2[1];
        }
    }
}

constexpr int VX_STRIDE = 4112, PKT_OFF = 32 * VX_STRIDE;
template <int NTW>
__device__ __forceinline__ void conv_unit(Frame& F, ArgsP a, int l, int c, const float* HFsrc, const bf16_t* VTc, bf16_t* YTc) {
    constexpr int Lseq = NTW * 256, NS = Lseq / 16;
    LAS unsigned char* lds = F.lds;
    LAS unsigned* pkt = (LAS unsigned*)(lds + PKT_OFF);
    __syncthreads();
#if MK_DUP == 68 || MK_DUP == 69
    const unsigned tcv0_ = (unsigned)__builtin_amdgcn_s_memrealtime();
#endif
    const float skip = a->in[I_HYSKIP][l * 256 + c];
#pragma unroll 4
    for (int m = F.tid; m < 2 * Lseq; m += NTHREADS) {
        float r[2];
#pragma unroll
        for (int k = 0; k < 2; ++k) { const int d = Lseq - (m + k); const int ad = d < 0 ? -d : d, adc = ad < Lseq ? ad : 0;
            const float v = HFsrc[(size_t)((d < 0 ? 256 : 0) + c) * Lseq + adc]; r[k] = (ad < Lseq) ? v : 0.f; if (d == 0) r[k] += skip; }
        pkt[m] = pk2(r[0], r[1]);
    }
#if MK_DUP == 69
    asm volatile("s_waitcnt vmcnt(0) lgkmcnt(0)" ::: "memory"); if (NTW == 8 && F.tid == 0) F.MISC[110] += (unsigned)__builtin_amdgcn_s_memrealtime() - tcv0_;
#endif
#pragma unroll 8
    for (int it = F.tid; it < 32 * (Lseq / 8); it += NTHREADS) { const int b = it / (Lseq / 8), ch = it % (Lseq / 8);
        *(LAS u32x4*)(lds + b * VX_STRIDE + ch * 16) = *(const u32x4*)(VTc + (size_t)b * Lseq + ch * 8); }
    __syncthreads();
#if MK_DUP == 68
    if (NTW == 8 && F.tid == 0) F.MISC[110] += (unsigned)__builtin_amdgcn_s_memrealtime() - tcv0_;
#endif
    const int i = F.lane & 31, h = F.lane >> 5, w = F.wave;
    f32x16 acc[NTW];
#pragma unroll
    for (int ti = 0; ti < NTW; ++ti) acc[ti] = (f32x16){0.f};
    const LAS unsigned char* bbase = lds + i * VX_STRIDE + h * 16;
    const int dlo = 2 * NTW * w - (NS - 1), dhi = 2 * (NTW * w + NTW - 1);
#define CV_LOAD(AF, BF, DL) do { const int ms_ = Lseq - 16 * (DL) - i + 8 * h; u32x4 af_; af_.x = pkt[ms_]; af_.y = pkt[ms_ + 2]; af_.z = pkt[ms_ + 4]; af_.w = pkt[ms_ + 6]; AF = __builtin_bit_cast(bf16x8, af_); \
        _Pragma("unroll") for (int ti = 0; ti < NTW; ++ti) { const int sj_ = 2 * (NTW * w + ti) - (DL), sjc_ = sj_ < 0 ? 0 : (sj_ >= NS ? NS - 1 : sj_); BF[ti] = *(const LAS bf16x8*)(bbase + sjc_ * 32); } } while (0)
#define CV_MMA(AF, BF, DL) do { _Pragma("unroll") for (int ti = 0; ti < NTW; ++ti) { const int sj_ = 2 * (NTW * w + ti) - (DL); \
        if (sj_ >= 0 && sj_ < NS) acc[ti] = __builtin_amdgcn_mfma_f32_32x32x16_bf16(AF, BF[ti], acc[ti], 0, 0, 0); } } while (0)
    bf16x8 A0, A1, B0[NTW], B1[NTW];
    CV_LOAD(A0, B0, dlo);
    for (int dl = dlo; dl <= dhi; dl += 2) {
        CV_LOAD(A1, B1, dl + 1);
        CV_MMA(A0, B0, dl);
        if (dl + 2 <= dhi) CV_LOAD(A0, B0, dl + 2);
        CV_MMA(A1, B1, dl + 1);
    }
#undef CV_LOAD
#undef CV_MMA
#pragma unroll
    for (int ti = 0; ti < NTW; ++ti)
#pragma unroll
        for (int g = 0; g < 4; ++g) { const int t = 32 * (NTW * w + ti) + 8 * g + 4 * h;
            u32x2 o; o.x = pk2(acc[ti][4 * g], acc[ti][4 * g + 1]); o.y = pk2(acc[ti][4 * g + 2], acc[ti][4 * g + 3]);
            *(u32x2*)(YTc + (size_t)i * Lseq + t) = o; }
}

__device__ __forceinline__ void ytrans_unit(Frame& F, int blk) {
    const bf16_t* YT = (const bf16_t*)(F.ws + WS_YT); const bf16_t* X0 = (const bf16_t*)(F.ws + WS_X0); bf16_t* YC = (bf16_t*)(F.ws + WS_YCAT);
    LAS bf16_t* tl = (LAS bf16_t*)F.lds;
    const int row0 = blk * 128; const bool lat = row0 < TL;
    const size_t cstride = lat ? (size_t)TL : (size_t)TC; const bf16_t* ybase = lat ? YT + row0 : YT + (size_t)256 * TL + (row0 - TL);
    __syncthreads();
    for (int it = F.tid; it < 256 * 16; it += NTHREADS) { const int c = it >> 4, ch = it & 15;
        *(LAS u32x4*)(tl + c * 136 + ch * 8) = *(const u32x4*)(ybase + (size_t)c * cstride + ch * 8); }
    __syncthreads();
    for (int it = F.tid; it < 128 * 32; it += NTHREADS) {
        const int cg = it >> 7, rl = it & 127, row = row0 + rl, c = cg * 8;
        const u32x4 x = *(const u32x4*)(X0 + (size_t)row * 256 + c); const unsigned xs[4] = {x.x, x.y, x.z, x.w}; unsigned o[4];
#pragma unroll
        for (int j = 0; j < 4; ++j) o[j] = pk2(bf1(tl[(c + 2 * j) * 136 + rl]) * bf_lo(xs[j]), bf1(tl[(c + 2 * j + 1) * 136 + rl]) * bf_hi(xs[j]));
        *(u32x4*)(YC + (size_t)row * 1024 + 256 + c) = (u32x4){o[0], o[1], o[2], o[3]};
    }
}

namespace att {
#define KSWZ(row, colB) ((row) * 256 + ((colB) ^ (((row) & 7) << 4)))
__device__ __forceinline__ int crow(int r, int hi) { return (r & 3) + 8 * (r >> 2) + 4 * hi; }
__device__ __forceinline__ int v_st(int k, int c) { const int kk = (k & ~0xC) | ((k & 4) << 1) | ((k & 8) >> 1); return ((kk >> 3) * 4 + (c >> 5)) * 512 + ((kk & 7) * 32 + (c & 31)) * 2; }
__device__ __forceinline__ int v_rd_base(int lane) { return ((lane & 3) << 3) | (((lane >> 2) & 3) << 6) | (((lane >> 4) & 1) << 5) | (((lane >> 5) & 1) << 8); }
constexpr int v_rd_off(int d0, int ks, int half) { return d0 * 512 + ks * 4096 + half * 2048; }
template <int OFF> __device__ __forceinline__ s16x4 tr_read(int vb) {
    s16x4 r; asm volatile("ds_read_b64_tr_b16 %0, %1 offset:%2" : "=&v"(r) : "v"(vb), "i"(OFF) : "memory"); return r;
}
template <int D0> __device__ __forceinline__ void pv_one(f32x16& od, int vb, bf16x8 pa0, bf16x8 pa1, bf16x8 pa2, bf16x8 pa3) {
    const s16x4 l0 = tr_read<v_rd_off(D0, 0, 0)>(vb), h0 = tr_read<v_rd_off(D0, 0, 1)>(vb), l1 = tr_read<v_rd_off(D0, 1, 0)>(vb), h1 = tr_read<v_rd_off(D0, 1, 1)>(vb);
    const s16x4 l2 = tr_read<v_rd_off(D0, 2, 0)>(vb), h2 = tr_read<v_rd_off(D0, 2, 1)>(vb), l3 = tr_read<v_rd_off(D0, 3, 0)>(vb), h3 = tr_read<v_rd_off(D0, 3, 1)>(vb);
    asm volatile("s_waitcnt lgkmcnt(0)" ::: "memory"); __builtin_amdgcn_sched_barrier(0);
#define ATT_PK(L, H) (bf16x8){L[0], L[1], L[2], L[3], H[0], H[1], H[2], H[3]}
    od = __builtin_amdgcn_mfma_f32_32x32x16_bf16(pa0, ATT_PK(l0, h0), od, 0, 0, 0);
    od = __builtin_amdgcn_mfma_f32_32x32x16_bf16(pa1, ATT_PK(l1, h1), od, 0, 0, 0);
    od = __builtin_amdgcn_mfma_f32_32x32x16_bf16(pa2, ATT_PK(l2, h2), od, 0, 0, 0);
    od = __builtin_amdgcn_mfma_f32_32x32x16_bf16(pa3, ATT_PK(l3, h3), od, 0, 0, 0);
#undef ATT_PK
}
__device__ __forceinline__ void qkt2(f32x16& a0, f32x16& a1, f32x16& b0, f32x16& b1, const LAS char* Ks, const bf16x8 (&qr)[8], int r32, int hi) {
    a0 = (f32x16){0.f}; a1 = (f32x16){0.f}; b0 = (f32x16){0.f}; b1 = (f32x16){0.f};
#pragma unroll
    for (int d0 = 0; d0 < 4; ++d0) { const int cb = (d0 * 16 + hi * 8) * 2;
        const bf16x8 k0 = *(const LAS bf16x8*)(Ks + KSWZ(r32, cb)), k1 = *(const LAS bf16x8*)(Ks + KSWZ(32 + r32, cb));
        a0 = __builtin_amdgcn_mfma_f32_32x32x16_bf16(k0, qr[d0], a0, 0, 0, 0); a1 = __builtin_amdgcn_mfma_f32_32x32x16_bf16(k1, qr[d0], a1, 0, 0, 0); }
#pragma unroll
    for (int d0 = 4; d0 < 8; ++d0) { const int cb = (d0 * 16 + hi * 8) * 2;
        const bf16x8 k0 = *(const LAS bf16x8*)(Ks + KSWZ(r32, cb)), k1 = *(const LAS bf16x8*)(Ks + KSWZ(32 + r32, cb));
        b0 = __builtin_amdgcn_mfma_f32_32x32x16_bf16(k0, qr[d0], b0, 0, 0, 0); b1 = __builtin_amdgcn_mfma_f32_32x32x16_bf16(k1, qr[d0], b1, 0, 0, 0); }
}
__device__ __forceinline__ float xhalf_max(float v) { auto rr = __builtin_amdgcn_permlane32_swap(__float_as_uint(v), __float_as_uint(v), false, false); return fmaxf(__uint_as_float(rr[0]), __uint_as_float(rr[1])); }
__device__ __forceinline__ float xhalf_sum(float v) { auto rr = __builtin_amdgcn_permlane32_swap(__float_as_uint(v), __float_as_uint(v), false, false); return __uint_as_float(rr[0]) + __uint_as_float(rr[1]); }
constexpr float THR2 = 8.0f;
__device__ __forceinline__ void partialSM(f32x16& p0, f32x16& p1, float& m_reg, float& mn, float& alpha) {
    float pmax = p0[0];
#pragma unroll
    for (int r = 1; r < 16; ++r) pmax = fmaxf(pmax, p0[r]);
#pragma unroll
    for (int r = 0; r < 16; ++r) pmax = fmaxf(pmax, p1[r]);
    pmax = xhalf_max(pmax);
    if (__builtin_expect(__all(pmax - m_reg <= THR2), 1)) { mn = m_reg; alpha = 1.f; }
    else { mn = fmaxf(m_reg, pmax); alpha = fast_exp2(m_reg - mn); m_reg = mn; }
#pragma unroll
    for (int r = 0; r < 16; ++r) p0[r] -= mn;
#pragma unroll
    for (int r = 0; r < 16; ++r) p1[r] -= mn;
#pragma unroll
    for (int r = 0; r < 16; ++r) p0[r] = fast_exp2(p0[r]);
}
__device__ __forceinline__ void finishSM(f32x16& p0, f32x16& p1, float alpha, float& l_reg, bf16x8& pa0, bf16x8& pa1, bf16x8& pa2, bf16x8& pa3) {
#pragma unroll
    for (int r = 0; r < 16; ++r) p1[r] = fast_exp2(p1[r]);
    float ps = 0.f;
#pragma unroll
    for (int r = 0; r < 16; ++r) ps += p0[r];
#pragma unroll
    for (int r = 0; r < 16; ++r) ps += p1[r];
    ps = xhalf_sum(ps);
    l_reg = l_reg * alpha + ps;
#define ATT_PK4(P, BASE, OUT) do { unsigned x0_ = pk2(P[BASE + 0], P[BASE + 1]), x1_ = pk2(P[BASE + 2], P[BASE + 3]); \
        unsigned y0_ = pk2(P[BASE + 4], P[BASE + 5]), y1_ = pk2(P[BASE + 6], P[BASE + 7]); \
        auto r0_ = __builtin_amdgcn_permlane32_swap(x0_, y0_, false, false); auto r1_ = __builtin_amdgcn_permlane32_swap(x1_, y1_, false, false); \
        u32x4 w_ = {r0_[0], r1_[0], r0_[1], r1_[1]}; OUT = __builtin_bit_cast(bf16x8, w_); } while (0)
    ATT_PK4(p0, 0, pa0); ATT_PK4(p0, 8, pa1); ATT_PK4(p1, 0, pa2); ATT_PK4(p1, 8, pa3);
#undef ATT_PK4
}
__device__ __forceinline__ void qkt1(f32x16& p0, f32x16& p1, const LAS char* Ks, const bf16x8 (&qr)[4], int r32, int hi, int mcb) {
    p0 = (f32x16){0.f}; p1 = (f32x16){0.f};
#pragma unroll
    for (int d0 = 0; d0 < 4; ++d0) { const int cb = mcb + (d0 * 16 + hi * 8) * 2;
        const bf16x8 k0 = *(const LAS bf16x8*)(Ks + KSWZ(r32, cb)), k1 = *(const LAS bf16x8*)(Ks + KSWZ(32 + r32, cb));
        p0 = __builtin_amdgcn_mfma_f32_32x32x16_bf16(k0, qr[d0], p0, 0, 0, 0); p1 = __builtin_amdgcn_mfma_f32_32x32x16_bf16(k1, qr[d0], p1, 0, 0, 0); }
}
template <int KS> __device__ __forceinline__ void pv_step(f32x16 (&o)[4], int vb, bf16x8 pa) {
    const s16x4 l0 = tr_read<v_rd_off(0, KS, 0)>(vb), h0 = tr_read<v_rd_off(0, KS, 1)>(vb), l1 = tr_read<v_rd_off(1, KS, 0)>(vb), h1 = tr_read<v_rd_off(1, KS, 1)>(vb);
    const s16x4 l2 = tr_read<v_rd_off(2, KS, 0)>(vb), h2 = tr_read<v_rd_off(2, KS, 1)>(vb), l3 = tr_read<v_rd_off(3, KS, 0)>(vb), h3 = tr_read<v_rd_off(3, KS, 1)>(vb);
    asm volatile("s_waitcnt lgkmcnt(0)" ::: "memory"); __builtin_amdgcn_sched_barrier(0);
#define ATT_PK(L, H) (bf16x8){L[0], L[1], L[2], L[3], H[0], H[1], H[2], H[3]}
    o[0] = __builtin_amdgcn_mfma_f32_32x32x16_bf16(pa, ATT_PK(l0, h0), o[0], 0, 0, 0);
    o[1] = __builtin_amdgcn_mfma_f32_32x32x16_bf16(pa, ATT_PK(l1, h1), o[1], 0, 0, 0);
    o[2] = __builtin_amdgcn_mfma_f32_32x32x16_bf16(pa, ATT_PK(l2, h2), o[2], 0, 0, 0);
    o[3] = __builtin_amdgcn_mfma_f32_32x32x16_bf16(pa, ATT_PK(l3, h3), o[3], 0, 0, 0);
#undef ATT_PK
}
__device__ __forceinline__ void pv_d0(f32x16 (&o)[4], int vb, bf16x8 pa0, bf16x8 pa1, bf16x8 pa2, bf16x8 pa3) {
    pv_step<0>(o, vb, pa0); pv_step<1>(o, vb, pa1); pv_step<2>(o, vb, pa2); pv_step<3>(o, vb, pa3);
}
}

struct AttnUnit { int qrow0, h, klat0, nlat, kctx0, nt; };

constexpr int ATT_V = 0, ATT_K = 32768, ATT_WS = 65536, ATT_XCH = 65536 + 2048;
__device__ __forceinline__ void attn_unit(Frame& F, ArgsP a, int l, const AttnUnit& U, float lam, float lam_init, const AttnUnit& Un, const bool has_next, const bool first) {
    using namespace att;
    const bf16_t* Qg = (const bf16_t*)(F.ws + WS_Q); const bf16_t* Kg = (const bf16_t*)(F.ws + WS_K); const bf16_t* Vg = (const bf16_t*)(F.ws + WS_V);
    bf16_t* YC = (bf16_t*)(F.ws + WS_YCAT);
    const int tid = F.tid, wid = F.wave, lane = F.lane, r32 = lane & 31, hi = lane >> 5, mp = wid >> 2, wq = wid & 3, mcb = mp * 128;
    LAS char* V_lds = (LAS char*)F.lds + ATT_V; LAS char* K_lds = (LAS char*)F.lds + ATT_K;
    LAS float* wsf = (LAS float*)(F.lds + ATT_WS) + wid * 64; LAS float* li_l = wsf; LAS float* al_l = wsf + 32;
    float m_reg = -1e30f, l_reg = 0.f; f32x16 o[4];
#pragma unroll
    for (int d = 0; d < 4; ++d) o[d] = (f32x16){0.f};
    bf16x8 qr[4];
    { const bf16_t* Qw = Qg + (size_t)(U.qrow0 + wq * 32 + r32) * 512 + U.h * 128 + mp * 64 + hi * 8;
#pragma unroll
      for (int d0 = 0; d0 < 4; ++d0) qr[d0] = *(const bf16x8*)(Qw + d0 * 16); }
    const int sr = tid >> 4, sc = (tid & 15) * 8;
    const int kst0 = KSWZ(sr, sc * 2), kst1 = KSWZ(32 + sr, sc * 2), vst0 = v_st(sr, sc), vst1 = v_st(32 + sr, sc);
    const int hoff = U.h * 128 + sc;
    const int vb0 = (int)(uintptr_t)V_lds + v_rd_base(lane);
#define KROW(j) ((j) < U.nlat ? U.klat0 + 64 * (j) : U.kctx0 + 64 * ((j) - U.nlat))
    bf16x8 s0v0, s0v1, s0k0, s0k1, s1v0, s1v1, s1k0, s1k1;
#define SLOAD0(j) do { const int kr_ = KROW(j); const size_t g0_ = (size_t)(kr_ + sr) * 512 + hoff, g1_ = (size_t)(kr_ + 32 + sr) * 512 + hoff; \
        s0v0 = *(const bf16x8*)(Vg + g0_); s0v1 = *(const bf16x8*)(Vg + g1_); s0k0 = *(const bf16x8*)(Kg + g0_); s0k1 = *(const bf16x8*)(Kg + g1_); } while (0)
#define SLOAD1(j) do { const int kr_ = KROW(j); const size_t g0_ = (size_t)(kr_ + sr) * 512 + hoff, g1_ = (size_t)(kr_ + 32 + sr) * 512 + hoff; \
        s1v0 = *(const bf16x8*)(Vg + g0_); s1v1 = *(const bf16x8*)(Vg + g1_); s1k0 = *(const bf16x8*)(Kg + g0_); s1k1 = *(const bf16x8*)(Kg + g1_); } while (0)
#define SWRITE0(b) do { *(LAS bf16x8*)(V_lds + (b) * 16384 + vst0) = s0v0; *(LAS bf16x8*)(V_lds + (b) * 16384 + vst1) = s0v1; \
        *(LAS bf16x8*)(K_lds + (b) * 16384 + kst0) = s0k0; *(LAS bf16x8*)(K_lds + (b) * 16384 + kst1) = s0k1; } while (0)
#define SWRITE1(b) do { *(LAS bf16x8*)(V_lds + (b) * 16384 + vst0) = s1v0; *(LAS bf16x8*)(V_lds + (b) * 16384 + vst1) = s1v1; \
        *(LAS bf16x8*)(K_lds + (b) * 16384 + kst0) = s1k0; *(LAS bf16x8*)(K_lds + (b) * 16384 + kst1) = s1k1; } while (0)
#define SWAIT() asm volatile("s_waitcnt vmcnt(4)" ::: "memory")
#define SBAR() __builtin_amdgcn_sched_barrier(0)
#define LBAR() do { asm volatile("s_waitcnt lgkmcnt(0)" ::: "memory"); __builtin_amdgcn_s_barrier(); asm volatile("" ::: "memory"); } while (0)
#define RESC(av) do { if (__any((av) < 1.f)) { if (hi == 0) al_l[r32] = (av); asm volatile("s_waitcnt lgkmcnt(0)" ::: "memory"); \
        _Pragma("unroll") for (int d_ = 0; d_ < 4; ++d_) _Pragma("unroll") for (int r_ = 0; r_ < 16; ++r_) o[d_][r_] *= al_l[crow(r_, hi)]; } } while (0)
    f32x16 pA0, pA1, pB0, pB1; float mnA, mnB, alA, alB; bf16x8 pa0, pa1, pa2, pa3; const int NT = U.nt;
    __syncthreads();
    if (first) { SLOAD0(0); SLOAD1(1); asm volatile("s_waitcnt vmcnt(0)" ::: "memory"); SWRITE0(0); SWRITE1(1); __syncthreads(); }
    if (2 < NT) SLOAD0(2);
    qkt1(pA0, pA1, K_lds, qr, r32, hi, mcb); partialSM(pA0, pA1, m_reg, mnA, alA);
    for (int j = 1; j + 1 < NT; j += 2) {
        SBAR(); qkt1(pB0, pB1, K_lds + 16384, qr, r32, hi, mcb);
        finishSM(pA0, pA1, alA, l_reg, pa0, pa1, pa2, pa3); SBAR();
        SLOAD1(j + 2); SBAR();
        pv_d0(o, vb0, pa0, pa1, pa2, pa3); partialSM(pB0, pB1, m_reg, mnB, alB);
        __syncthreads(); SWAIT(); SWRITE0(0);
        RESC(alB); __syncthreads();
        SBAR(); qkt1(pA0, pA1, K_lds, qr, r32, hi, mcb);
        finishSM(pB0, pB1, alB, l_reg, pa0, pa1, pa2, pa3); SBAR();
        if (j + 3 < NT) SLOAD0(j + 3);
        SBAR();
        pv_d0(o, vb0 + 16384, pa0, pa1, pa2, pa3); partialSM(pA0, pA1, m_reg, mnA, alA);
        __syncthreads(); SWAIT(); SWRITE1(1);
        RESC(alA); __syncthreads();
    }
    SBAR(); qkt1(pB0, pB1, K_lds + 16384, qr, r32, hi, mcb);
    finishSM(pA0, pA1, alA, l_reg, pa0, pa1, pa2, pa3); SBAR();
    pv_d0(o, vb0, pa0, pa1, pa2, pa3); partialSM(pB0, pB1, m_reg, mnB, alB);
    __syncthreads(); RESC(alB);
    finishSM(pB0, pB1, alB, l_reg, pa0, pa1, pa2, pa3); SBAR();
    pv_d0(o, vb0 + 16384, pa0, pa1, pa2, pa3);
#undef KROW
#undef SLOAD0
#undef SLOAD1
#undef SWRITE0
#undef SWRITE1
#undef SWAIT
#undef SBAR
#undef LBAR
#undef RESC
#define KROWN(j) ((j) < Un.nlat ? Un.klat0 + 64 * (j) : Un.kctx0 + 64 * ((j) - Un.nlat))
    if (has_next) { const int hoffn = Un.h * 128 + sc;
        { const int kr_ = KROWN(0); const size_t g0_ = (size_t)(kr_ + sr) * 512 + hoffn, g1_ = (size_t)(kr_ + 32 + sr) * 512 + hoffn; s0v0 = *(const bf16x8*)(Vg + g0_); s0v1 = *(const bf16x8*)(Vg + g1_); s0k0 = *(const bf16x8*)(Kg + g0_); s0k1 = *(const bf16x8*)(Kg + g1_); }
        { const int kr_ = KROWN(1); const size_t g0_ = (size_t)(kr_ + sr) * 512 + hoffn, g1_ = (size_t)(kr_ + 32 + sr) * 512 + hoffn; s1v0 = *(const bf16x8*)(Vg + g0_); s1v1 = *(const bf16x8*)(Vg + g1_); s1k0 = *(const bf16x8*)(Kg + g0_); s1k1 = *(const bf16x8*)(Kg + g1_); } }
#undef KROWN
    if (hi == 0) li_l[r32] = l_reg;
    asm volatile("s_waitcnt lgkmcnt(0)" ::: "memory");
    const float fac = mp ? lam : 1.0f;
    float rli[16];
#pragma unroll
    for (int r = 0; r < 16; ++r) rli[r] = fac * fast_rcp(li_l[crow(r, hi)]);
    LAS float* xch = (LAS float*)(F.lds + ATT_XCH) + wq * 4096;
    if (mp == 1) {
#pragma unroll
        for (int r = 0; r < 16; ++r)
#pragma unroll
            for (int d = 0; d < 4; ++d) xch[crow(r, hi) * 128 + 32 * d + r32] = o[d][r] * rli[r];
    }
    __syncthreads();
    if (mp == 0) {
        const float* gn = a->in[I_DANG] + l * 128;
        float gv[4];
#pragma unroll
        for (int d = 0; d < 4; ++d) gv[d] = gn[32 * d + r32] * (1.0f - lam_init);
#pragma unroll
        for (int r = 0; r < 16; ++r) {
            float ov[4];
#pragma unroll
            for (int d = 0; d < 4; ++d) ov[d] = o[d][r] * rli[r] - xch[crow(r, hi) * 128 + 32 * d + r32];
            float ss = (ov[0] * ov[0] + ov[1] * ov[1]) + (ov[2] * ov[2] + ov[3] * ov[3]);
#pragma unroll
            for (int x = 1; x < 32; x <<= 1) ss += __shfl_xor(ss, x);
            const float inv = 1.0f / sqrtf(ss * (1.0f / 128.0f) + LN_EPS);
#pragma unroll
            for (int d = 0; d < 4; ++d) o[d][r] = ov[d] * inv * gv[d];
        }
    }
    if (has_next) { asm volatile("s_waitcnt vmcnt(0)" ::: "memory");
        *(LAS bf16x8*)(V_lds + vst0) = s0v0; *(LAS bf16x8*)(V_lds + vst1) = s0v1; *(LAS bf16x8*)(K_lds + kst0) = s0k0; *(LAS bf16x8*)(K_lds + kst1) = s0k1;
        *(LAS bf16x8*)(V_lds + 16384 + vst0) = s1v0; *(LAS bf16x8*)(V_lds + 16384 + vst1) = s1v1; *(LAS bf16x8*)(K_lds + 16384 + kst0) = s1k0; *(LAS bf16x8*)(K_lds + 16384 + kst1) = s1k1; }
    if (mp == 0) {
#pragma unroll
        for (int r = 0; r < 16; ++r) { bf16_t* yrow = YC + (size_t)(U.qrow0 + wq * 32 + crow(r, hi)) * 1024 + 512 + U.h * 128 + r32;
#pragma unroll
            for (int d = 0; d < 4; ++d) yrow[32 * d] = (bf16_t)(pk2(o[d][r], 0.f) & 0xffffu); }
    }
}
namespace att {
__device__ __forceinline__ void stats(const f32x16& x0, const f32x16& x1, float& m, float& l) {
    float t = x0[0];
#pragma unroll
    for (int r = 1; r < 16; ++r) t = fmaxf(t, x0[r]);
#pragma unroll
    for (int r = 0; r < 16; ++r) t = fmaxf(t, x1[r]);
    t = xhalf_max(t);
    const float mn = fmaxf(m, t);
    float s = 0.f;
#pragma unroll
    for (int r = 0; r < 16; ++r) s += fast_exp2(x0[r] - mn);
#pragma unroll
    for (int r = 0; r < 16; ++r) s += fast_exp2(x1[r] - mn);
    s = xhalf_sum(s);
    l = l * fast_exp2(m - mn) + s; m = mn;
}
}

__device__ __forceinline__ void attn_unit_v1(Frame& F, ArgsP a, int l, const AttnUnit& U, float lam, float lam_init) {
    using namespace att;
    const bf16_t* Qg = (const bf16_t*)(F.ws + WS_Q); const bf16_t* Kg = (const bf16_t*)(F.ws + WS_K); const bf16_t* Vg = (const bf16_t*)(F.ws + WS_V);
    bf16_t* YC = (bf16_t*)(F.ws + WS_YCAT);
    const int tid = F.tid, wid = F.wave, lane = F.lane, r32 = lane & 31, hi = lane >> 5;
    LAS char* K_lds = (LAS char*)F.lds; LAS char* V_lds = (LAS char*)F.lds + 32768;
    bf16x8 qr[8];
    { const bf16_t* Qw = Qg + (size_t)(U.qrow0 + wid * 32 + r32) * 512 + U.h * 128 + hi * 8;
#pragma unroll
      for (int d0 = 0; d0 < 8; ++d0) qr[d0] = *(const bf16x8*)(Qw + d0 * 16); }
    const int sr = tid >> 4, sc = (tid & 15) * 8;
    const int kst0 = KSWZ(sr, sc * 2), kst1 = KSWZ(32 + sr, sc * 2), vst0 = v_st(sr, sc), vst1 = v_st(32 + sr, sc);
    const int hoff = U.h * 128 + sc;
#define KROW(j) ((j) < U.nlat ? U.klat0 + 64 * (j) : U.kctx0 + 64 * ((j) - U.nlat))
    float m0 = -1e30f, l0 = 0.f, m1 = -1e30f, l1 = 0.f;
    bf16x8 ks0, ks1, vs0, vs1;
    __syncthreads();
    { const int kr = KROW(0); ks0 = *(const bf16x8*)(Kg + (size_t)(kr + sr) * 512 + hoff); ks1 = *(const bf16x8*)(Kg + (size_t)(kr + 32 + sr) * 512 + hoff); }
    *(LAS bf16x8*)(K_lds + kst0) = ks0; *(LAS bf16x8*)(K_lds + kst1) = ks1;
    __syncthreads();
    for (int j = 0; j < U.nt; ++j) {
        const bool more = j + 1 < U.nt;
        if (more) { const int kr = KROW(j + 1); ks0 = *(const bf16x8*)(Kg + (size_t)(kr + sr) * 512 + hoff); ks1 = *(const bf16x8*)(Kg + (size_t)(kr + 32 + sr) * 512 + hoff); }
        f32x16 a0, a1, b0, b1;
        qkt2(a0, a1, b0, b1, K_lds + (j & 1) * 16384, qr, r32, hi);
        stats(a0, a1, m0, l0); stats(b0, b1, m1, l1);
        if (more) { LAS char* kb = K_lds + ((j + 1) & 1) * 16384; *(LAS bf16x8*)(kb + kst0) = ks0; *(LAS bf16x8*)(kb + kst1) = ks1; }
        __syncthreads();
    }
    const float c0 = 1.0f / l0, c1 = lam / l1;
    f32x16 o[4];
#pragma unroll
    for (int d = 0; d < 4; ++d) o[d] = (f32x16){0.f};
    const int vb0 = (int)(uintptr_t)V_lds + v_rd_base(lane);
    { const int kr = KROW(0); const size_t g0 = (size_t)(kr + sr) * 512 + hoff, g1 = (size_t)(kr + 32 + sr) * 512 + hoff;
      ks0 = *(const bf16x8*)(Kg + g0); ks1 = *(const bf16x8*)(Kg + g1); vs0 = *(const bf16x8*)(Vg + g0); vs1 = *(const bf16x8*)(Vg + g1); }
    *(LAS bf16x8*)(K_lds + kst0) = ks0; *(LAS bf16x8*)(K_lds + kst1) = ks1; *(LAS bf16x8*)(V_lds + vst0) = vs0; *(LAS bf16x8*)(V_lds + vst1) = vs1;
    __syncthreads();
    for (int j = 0; j < U.nt; ++j) {
        const bool more = j + 1 < U.nt;
        if (more) { const int kr = KROW(j + 1); const size_t g0 = (size_t)(kr + sr) * 512 + hoff, g1 = (size_t)(kr + 32 + sr) * 512 + hoff;
            ks0 = *(const bf16x8*)(Kg + g0); ks1 = *(const bf16x8*)(Kg + g1); vs0 = *(const bf16x8*)(Vg + g0); vs1 = *(const bf16x8*)(Vg + g1); }
        f32x16 a0, a1, b0, b1;
        qkt2(a0, a1, b0, b1, K_lds + (j & 1) * 16384, qr, r32, hi);
#pragma unroll
        for (int r = 0; r < 16; ++r) { a0[r] = fast_exp2(a0[r] - m0) * c0 - fast_exp2(b0[r] - m1) * c1; a1[r] = fast_exp2(a1[r] - m0) * c0 - fast_exp2(b1[r] - m1) * c1; }
        bf16x8 pa0, pa1, pa2, pa3;
#define ATT_PK4(P, BASE, OUT) do { unsigned x0_ = pk2(P[BASE + 0], P[BASE + 1]), x1_ = pk2(P[BASE + 2], P[BASE + 3]); \
            unsigned y0_ = pk2(P[BASE + 4], P[BASE + 5]), y1_ = pk2(P[BASE + 6], P[BASE + 7]); \
            auto r0_ = __builtin_amdgcn_permlane32_swap(x0_, y0_, false, false); auto r1_ = __builtin_amdgcn_permlane32_swap(x1_, y1_, false, false); \
            u32x4 w_ = {r0_[0], r1_[0], r0_[1], r1_[1]}; OUT = __builtin_bit_cast(bf16x8, w_); } while (0)
        ATT_PK4(a0, 0, pa0); ATT_PK4(a0, 8, pa1); ATT_PK4(a1, 0, pa2); ATT_PK4(a1, 8, pa3);
#undef ATT_PK4
        const int vb = vb0 + (j & 1) * 16384;
        pv_one<0>(o[0], vb, pa0, pa1, pa2, pa3); pv_one<1>(o[1], vb, pa0, pa1, pa2, pa3); pv_one<2>(o[2], vb, pa0, pa1, pa2, pa3); pv_one<3>(o[3], vb, pa0, pa1, pa2, pa3);
        if (more) { LAS char* kb = K_lds + ((j + 1) & 1) * 16384; LAS char* vbuf = V_lds + ((j + 1) & 1) * 16384;
            *(LAS bf16x8*)(kb + kst0) = ks0; *(LAS bf16x8*)(kb + kst1) = ks1; *(LAS bf16x8*)(vbuf + vst0) = vs0; *(LAS bf16x8*)(vbuf + vst1) = vs1; }
        __syncthreads();
    }
#undef KROW
    const float* gn = a->in[I_DANG] + l * 128;
    float gv[4];
#pragma unroll
    for (int d = 0; d < 4; ++d) gv[d] = gn[32 * d + r32] * (1.0f - lam_init);
#pragma unroll
    for (int r = 0; r < 16; ++r) {
        float ss = (o[0][r] * o[0][r] + o[1][r] * o[1][r]) + (o[2][r] * o[2][r] + o[3][r] * o[3][r]);
#pragma unroll
        for (int x = 1; x < 32; x <<= 1) ss += __shfl_xor(ss, x);
        const float inv = 1.0f / sqrtf(ss * (1.0f / 128.0f) + LN_EPS);
        bf16_t* yrow = YC + (size_t)(U.qrow0 + wid * 32 + crow(r, hi)) * 1024 + 512 + U.h * 128 + r32;
#pragma unroll
        for (int d = 0; d < 4; ++d) yrow[32 * d] = (bf16_t)(pk2(o[d][r] * inv * gv[d], 0.f) & 0xffffu);
    }
}


struct SchedMerge {
    int G, c, nM; const char *HB, *YCAT, *WinT, *PT;
    __device__ __forceinline__ bool next(int i, pg8::GU& u) const {
        const int tile = i / 6, sub = i - tile * 6, L = tile * G + c; if (L >= nM * 4) return false;
        int pm, pn; pg8::grid_order(L, nM, 4, pm, pn);
        const int br = sub >> 1;
        if (sub & 1) { u.A = HB + (size_t)pm * 256 * 2048; u.B = WinT + (size_t)(OFF_GATE + br * 1024 + pn * 256) * 2048; u.K = 1024; }
        else { u.A = YCAT + (size_t)pm * 256 * 2048 + (br == 0 ? 0 : (br == 1 ? 512 : 1024)); u.B = PT + (size_t)br * 1024 * 2048 + (size_t)pn * 256 * 2048; u.K = (br == 2) ? 512 : 256; }
        u.gl = nullptr; u.kind = sub; u.pm = pm; u.pn = pn; u.e = 0; u.nvalid = 256;
        return true;
    }
};
struct EpiMerge {
    bf16_t* MERGED; bf16_t* PSCR;
    __device__ __forceinline__ void operator()(const f32x4 (&acc)[2][2][4][2], const pg8::GU& u, int wr, int wc, int fr, int fq) const {
        const int sub = u.kind;
        int ln_; asm volatile("v_mbcnt_lo_u32_b32 %0, -1, 0\n\tv_mbcnt_hi_u32_b32 %0, -1, %0" : "=v"(ln_));
        const int rq = wr * 64 + (ln_ & 15), cq = wc * 32 + 8 * (ln_ >> 4);
        const int row0 = u.pm * 256 + rq, col0 = u.pn * 256 + cq;
        const unsigned psoff = (unsigned)(((((rq >> 6) * 4 + (cq >> 5)) * 64 + ((cq >> 3) & 3) * 16 + (rq & 63)) * 16));
#pragma unroll
        for (int ai = 0; ai < 2; ++ai)
#pragma unroll
            for (int m = 0; m < 4; ++m)
#pragma unroll
                for (int bj = 0; bj < 2; ++bj) {
                    const int chunk = (ai * 4 + m) * 2 + bj; const f32x4 v0 = acc[ai][bj][m][0], v1 = acc[ai][bj][m][1];
                    unsigned po = psoff; asm volatile("" : "+v"(po)); po += chunk * 8192; u32x4* ps = (u32x4*)((char*)PSCR + po);
                    if ((sub & 1) == 0) { u32x4 w; w.x = pk2(v0[0], v0[1]); w.y = pk2(v0[2], v0[3]); w.z = pk2(v1[0], v1[1]); w.w = pk2(v1[2], v1[3]); *ps = w; }
                    else {
                        const u32x4 p = *ps; unsigned mo = (unsigned)((row0 * 1024 + col0) * 2); asm volatile("" : "+v"(mo)); mo += (unsigned)(((ai * 128 + m * 16) * 1024 + bj * 128) * 2); u32x4* mp = (u32x4*)((char*)MERGED + mo);
                        float r[8] = {sigmoidf_(v0[0]) * bf_lo(p.x), sigmoidf_(v0[1]) * bf_hi(p.x), sigmoidf_(v0[2]) * bf_lo(p.y), sigmoidf_(v0[3]) * bf_hi(p.y),
                                      sigmoidf_(v1[0]) * bf_lo(p.z), sigmoidf_(v1[1]) * bf_hi(p.z), sigmoidf_(v1[2]) * bf_lo(p.w), sigmoidf_(v1[3]) * bf_hi(p.w)};
                        if (sub != 1) { const u32x4 o = *mp; r[0] += bf_lo(o.x); r[1] += bf_hi(o.x); r[2] += bf_lo(o.y); r[3] += bf_hi(o.y); r[4] += bf_lo(o.z); r[5] += bf_hi(o.z); r[6] += bf_lo(o.w); r[7] += bf_hi(o.w); }
                        u32x4 w; w.x = pk2(r[0], r[1]); w.y = pk2(r[2], r[3]); w.z = pk2(r[4], r[5]); w.w = pk2(r[6], r[7]); *mp = w;
                    }

                }
    }
};

struct SchedGrid {
    int G, c, nM, nN, K; const char *A, *B; size_t astep, bstep;
    __device__ __forceinline__ bool next(int i, pg8::GU& u) const {
        const int L = i * G + c; if (L >= nM * nN) return false;
        int pm, pn; pg8::grid_order(L, nM, nN, pm, pn);
        u.A = A + (size_t)pm * astep; u.B = B + (size_t)pn * bstep; u.gl = nullptr; u.K = K; u.kind = 0; u.pm = pm; u.pn = pn; u.e = 0; u.nvalid = 256;
        return true;
    }
};
struct EpiOut {
    const float* xf; const float* ctxf; const bf16_t* xb; const float* mod; bf16_t* R1;
    __device__ __forceinline__ void operator()(const f32x4 (&acc)[2][2][4][2], const pg8::GU& u, int wr, int wc, int fr, int fq) const {
        const int rowt = u.pm * 256, col0 = u.pn * 256 + wc * 32 + 8 * fq;
        const float* g1 = mod + (size_t)mod_row(rowt) * 6144 + 2048 + col0;
        f32x4 gv[2][2];
#pragma unroll
        for (int bj = 0; bj < 2; ++bj) { gv[bj][0] = *(const f32x4*)(g1 + bj * 128); gv[bj][1] = *(const f32x4*)(g1 + bj * 128 + 4); }
#pragma unroll
        for (int ai = 0; ai < 2; ++ai)
#pragma unroll
            for (int m = 0; m < 4; ++m) { const int row = rowt + wr * 64 + fr + ai * 128 + m * 16;
#pragma unroll
                for (int bj = 0; bj < 2; ++bj) { const int col = col0 + bj * 128; f32x4 x0, x1;
                    if (xb) { const u32x4 w = *(const u32x4*)(xb + (size_t)row * 1024 + col); x0 = (f32x4){bf_lo(w.x), bf_hi(w.x), bf_lo(w.y), bf_hi(w.y)}; x1 = (f32x4){bf_lo(w.z), bf_hi(w.z), bf_lo(w.w), bf_hi(w.w)}; }
                    else { const float* xp = (row < TL) ? xf + (size_t)row * 1024 + col : ctxf + (size_t)(row - TL) * 1024 + col; x0 = *(const f32x4*)xp; x1 = *(const f32x4*)(xp + 4); }
                    const f32x4 r0 = x0 * DN_ALPHA + gv[bj][0] * acc[ai][bj][m][0], r1 = x1 * DN_ALPHA + gv[bj][1] * acc[ai][bj][m][1];
                    u32x4 w; w.x = pk2(r0[0], r0[1]); w.y = pk2(r0[2], r0[3]); w.z = pk2(r1[0], r1[1]); w.w = pk2(r1[2], r1[3]);
                    *(u32x4*)(R1 + (size_t)row * 1024 + col) = w; } }
    }
};

__device__ __forceinline__ void expert_weights_fp8(Frame& F, ArgsP a, int l, int first, int last, int widx, int nw) {
    unsigned char* W1T = F.ws + WS_EW1; unsigned char* W2T = F.ws + WS_EW2;
    LAS float* scr = (LAS float*)(F.lds + F.wave * 8448);
    __syncthreads();
    for (int it2 = first + widx; it2 < last; it2 += nw) {
        const int it = 2 * it2, e = it / 768; int r = it - e * 768; const size_t le = (size_t)l * 32 + e;
        if (r < 256) { tr_item2<1, true>(a->in[I_EXG] + le * 1024 * 512, 512, (bf16_t*)(W1T + (size_t)e * 1024 * 1024), 1024, scr, r, F.lane); continue; } r -= 256;
        if (r < 256) { tr_item2<2, true>(a->in[I_EXU] + le * 1024 * 512, 512, (bf16_t*)(W1T + (size_t)e * 1024 * 1024), 1024, scr, r, F.lane); continue; } r -= 256;
        tr_item2<0, true>(a->in[I_EXD] + le * 512 * 1024, 1024, (bf16_t*)(W2T + (size_t)e * 1024 * 512), 512, scr, r, F.lane);
    }
    __syncthreads();
}
constexpr int WR_STRIDE = 2064;
constexpr int WR_BYTES = 48 * WR_STRIDE, LG_STRIDE = 52;
__device__ __forceinline__ void phase_ln1_router(Frame& F, ArgsP a, int l, int nrows, const int mode, const int cfirst = 0) {
    if (mode & 1) expert_weights_fp8(F, a, l, cfirst, 32 * 384, F.gw, F.NGW);
    if (!(mode & 26)) return;
    if (mode & 24) {
        const float* we = a->in[I_MOEWE] + (size_t)l * 32768; const float* wg = a->in[I_MOEWG] + (size_t)l * 4096;
        f32x4 t[16], tg[2];
#pragma unroll
        for (int i = 0; i < 16; ++i) t[i] = *(const f32x4*)(we + (size_t)(i * NTHREADS + F.tid) * 4);
#pragma unroll
        for (int i = 0; i < 2; ++i) tg[i] = *(const f32x4*)(wg + (size_t)(i * NTHREADS + F.tid) * 4);
#pragma unroll
        for (int i = 0; i < 3; ++i) { if (mode & 16) break; const int ch = i * NTHREADS + F.tid; *(LAS u32x4*)(F.lds + (36 + (ch >> 7)) * WR_STRIDE + (ch & 127) * 16) = (u32x4){0u, 0u, 0u, 0u}; }
#pragma unroll
        for (int i = 0; i < 16; ++i) { const int idx = i * NTHREADS + F.tid, k = idx >> 3, j = idx & 7;
#pragma unroll
            for (int c = 0; c < 4; ++c) *(LAS bf16_t*)(F.lds + (4 + 4 * j + c) * WR_STRIDE + k * 2) = (bf16_t)(pk2(t[i][c], 0.f) & 0xffffu); }
#pragma unroll
        for (int i = 0; i < 2; ++i) { const int k = i * NTHREADS + F.tid;
#pragma unroll
            for (int c = 0; c < 4; ++c) *(LAS bf16_t*)(F.lds + c * WR_STRIDE + k * 2) = (bf16_t)(pk2(tg[i][c], 0.f) & 0xffffu); }
    }
    __syncthreads();
    const float* mod = (const float*)(F.ws + WS_MOD) + (size_t)l * 33 * 6144;
    const bf16_t* R1 = (const bf16_t*)(F.ws + WS_R1); bf16_t* X = (bf16_t*)(F.ws + WS_X); bf16_t* HB = (bf16_t*)(F.ws + WS_HB);
    int* LIST = (int*)(F.ws + WS_LIST); float* WT = (float*)(F.ws + WS_WTS);
    unsigned* cnt = F.ctl + CW_CNT + l * 32 * 64;
    const int lane = F.lane;
    LAS unsigned char* stg = F.lds + 36 * WR_STRIDE + F.wave * (4 * WR_STRIDE);
    LAS float* LG = (mode & 16) ? (LAS float*)stg : (LAS float*)(F.lds + WR_BYTES + F.wave * (16 * LG_STRIDE * 4));
    const float* lng = a->in[I_LN1G] + l * 1024; const float* lnb = a->in[I_LN1B] + l * 1024;
    for (int grp = F.gw; grp < nrows / 16; grp += F.NGW) {
        const int r0 = grp * 16;
        const float* mrow = mod + (size_t)mod_row(r0) * 6144;
        f32x4 lacc[3] = {(f32x4){0.f, 0.f, 0.f, 0.f}, (f32x4){0.f, 0.f, 0.f, 0.f}, (f32x4){0.f, 0.f, 0.f, 0.f}};
        if (mode & 2) {
        u32x4 nw[4][2];
#pragma unroll
        for (int q = 0; q < 4; ++q)
#pragma unroll
            for (int hh = 0; hh < 2; ++hh) nw[q][hh] = *(const u32x4*)(R1 + (size_t)(r0 + q) * 1024 + hh * 512 + 8 * lane);
#pragma unroll 1
        for (int rr = 0; rr < 16; rr += 4) {
            float v[4][16];
#pragma unroll
            for (int q = 0; q < 4; ++q)
#pragma unroll
                for (int hh = 0; hh < 2; ++hh) { const u32x4 w = nw[q][hh];
                    v[q][hh * 8 + 0] = bf_lo(w.x); v[q][hh * 8 + 1] = bf_hi(w.x); v[q][hh * 8 + 2] = bf_lo(w.y); v[q][hh * 8 + 3] = bf_hi(w.y); v[q][hh * 8 + 4] = bf_lo(w.z); v[q][hh * 8 + 5] = bf_hi(w.z); v[q][hh * 8 + 6] = bf_lo(w.w); v[q][hh * 8 + 7] = bf_hi(w.w); }
            if (rr + 4 < 16) {
#pragma unroll
                for (int q = 0; q < 4; ++q)
#pragma unroll
                    for (int hh = 0; hh < 2; ++hh) nw[q][hh] = *(const u32x4*)(R1 + (size_t)(r0 + rr + 4 + q) * 1024 + hh * 512 + 8 * lane); }
            float s[4], mean[4], qq[4], rstd[4];
#pragma unroll
            for (int q = 0; q < 4; ++q) { s[q] = 0.f;
#pragma unroll
                for (int j = 0; j < 16; ++j) s[q] += v[q][j]; }
#pragma unroll
            for (int o = 1; o < 64; o <<= 1)
#pragma unroll
                for (int q = 0; q < 4; ++q) s[q] += __shfl_xor(s[q], o);
#pragma unroll
            for (int q = 0; q < 4; ++q) { mean[q] = s[q] * (1.f / 1024.f); qq[q] = 0.f;
#pragma unroll
                for (int j = 0; j < 16; ++j) { v[q][j] -= mean[q]; qq[q] += v[q][j] * v[q][j]; } }
#pragma unroll
            for (int o = 1; o < 64; o <<= 1)
#pragma unroll
                for (int q = 0; q < 4; ++q) qq[q] += __shfl_xor(qq[q], o);
#pragma unroll
            for (int q = 0; q < 4; ++q) rstd[q] = 1.0f / sqrtf(qq[q] * (1.f / 1024.f) + LN_EPS);
#pragma unroll
            for (int hh = 0; hh < 2; ++hh) { const int c = hh * 512 + 8 * lane;
                const f32x4 sh0 = *(const f32x4*)(mrow + 3072 + c), sh1 = *(const f32x4*)(mrow + 3072 + c + 4), sc0 = *(const f32x4*)(mrow + 4096 + c), sc1 = *(const f32x4*)(mrow + 4096 + c + 4);
                const f32x4 g0 = *(const f32x4*)(lng + c), g1 = *(const f32x4*)(lng + c + 4), b0 = *(const f32x4*)(lnb + c), b1 = *(const f32x4*)(lnb + c + 4);
#pragma unroll
                for (int q = 0; q < 4; ++q) { const int row = r0 + rr + q;
                    float x1[8], h2[8];
#pragma unroll
                    for (int j = 0; j < 8; ++j) { x1[j] = v[q][hh * 8 + j] * rstd[q] * (j < 4 ? g0[j] : g1[j - 4]) + (j < 4 ? b0[j] : b1[j - 4]); const float shv = j < 4 ? sh0[j] : sh1[j - 4], scv = j < 4 ? sc0[j] : sc1[j - 4]; h2[j] = x1[j] * (1.f + scv) + shv; }
                    u32x4 w; w.x = pk2(x1[0], x1[1]); w.y = pk2(x1[2], x1[3]); w.z = pk2(x1[4], x1[5]); w.w = pk2(x1[6], x1[7]);
                    *(u32x4*)(X + (size_t)row * 1024 + c) = w;
                    u32x4 hw; hw.x = pk2(h2[0], h2[1]); hw.y = pk2(h2[2], h2[3]); hw.z = pk2(h2[4], h2[5]); hw.w = pk2(h2[6], h2[7]);
                    if (mode & 16) *(LAS u32x4*)(stg + q * WR_STRIDE + c * 2) = hw; else *(u32x4*)(HB + (size_t)row * 1024 + c) = hw;
                    *(u32x2*)(F.ws + WS_HB8 + (size_t)row * 1024 + c) = (u32x2){pk4_fp8(h2[0], h2[1], h2[2], h2[3]), pk4_fp8(h2[4], h2[5], h2[6], h2[7])}; } }
            if (mode & 16) {
                asm volatile("s_waitcnt lgkmcnt(0)" ::: "memory");
                const bool mine = ((lane & 15) >> 2) == (rr >> 2);
                const LAS unsigned char* arow = stg + (lane & 3) * WR_STRIDE + 16 * (lane >> 4);
                const LAS unsigned char* wrow = F.lds + (lane & 15) * WR_STRIDE + 16 * (lane >> 4);
#pragma unroll 2
                for (int ks = 0; ks < 32; ++ks) { bf16x8 av = *(const LAS bf16x8*)(arow + 64 * ks); if (!mine) av = (bf16x8){0, 0, 0, 0, 0, 0, 0, 0};
#pragma unroll
                    for (int nt = 0; nt < 3; ++nt) { const bf16x8 bv = *(const LAS bf16x8*)(wrow + nt * 16 * WR_STRIDE + 64 * ks); lacc[nt] = __builtin_amdgcn_mfma_f32_16x16x32_bf16(av, bv, lacc[nt], 0, 0, 0); } }
            }
        }
        if (mode & 16) {
            asm volatile("s_waitcnt lgkmcnt(0)" ::: "memory");
#pragma unroll
            for (int nt = 0; nt < 3; ++nt)
#pragma unroll
                for (int r = 0; r < 4; ++r) LG[(4 * (lane >> 4) + r) * LG_STRIDE + nt * 16 + (lane & 15)] = lacc[nt][r];
            asm volatile("s_waitcnt lgkmcnt(0)" ::: "memory");
            if (lane < 16) {
                const int row = r0 + lane; float lg[36];
#pragma unroll
                for (int q4 = 0; q4 < 9; ++q4) { const f32x4 t = *(const LAS f32x4*)(LG + lane * LG_STRIDE + 4 * q4); lg[4 * q4] = t.x; lg[4 * q4 + 1] = t.y; lg[4 * q4 + 2] = t.z; lg[4 * q4 + 3] = t.w; }
                float gl[4];
#pragma unroll
                for (int j = 0; j < 4; ++j) gl[j] = lg[j] + a->in[I_MOEBG][l * 4 + j];
                int gi = 0; float gm = gl[0];
#pragma unroll
                for (int j = 1; j < 4; ++j) if (gl[j] > gm) { gm = gl[j]; gi = j; }
                float gs = 0.f;
#pragma unroll
                for (int j = 0; j < 4; ++j) gs += expf(gl[j] - gm);
                const float gprob = 1.0f / gs;
                float el[8];
#pragma unroll
                for (int j = 0; j < 8; ++j) { float t = lg[4 + j] + a->in[I_MOEBE][l * 32 + j];
#pragma unroll
                    for (int gg = 1; gg < 4; ++gg) t = (gi == gg) ? (lg[4 + gg * 8 + j] + a->in[I_MOEBE][l * 32 + gg * 8 + j]) : t;
                    el[j] = t; }
                int i0 = 0; float v0 = el[0];
#pragma unroll
                for (int j = 1; j < 8; ++j) if (el[j] > v0) { v0 = el[j]; i0 = j; }
                int i1 = -1; float v1 = -3.0e38f;
#pragma unroll
                for (int j = 0; j < 8; ++j) if (j != i0 && el[j] > v1) { v1 = el[j]; i1 = j; }
                const float e1 = expf(v1 - v0), w0 = gprob / (1.0f + e1), w1 = gprob * e1 / (1.0f + e1);
                const int ea = gi * 8 + i0, eb = gi * 8 + i1;
                if (!(mode & 4)) {
                const unsigned pa = __hip_atomic_fetch_add(cnt + ea * 64, 1u, __ATOMIC_RELAXED, __HIP_MEMORY_SCOPE_AGENT);
                const unsigned pb = __hip_atomic_fetch_add(cnt + eb * 64, 1u, __ATOMIC_RELAXED, __HIP_MEMORY_SCOPE_AGENT);
                LIST[(size_t)ea * TA + pa] = row * 2; LIST[(size_t)eb * TA + pb] = row * 2 + 1;
                WT[(size_t)ea * TA + pa] = w0; WT[(size_t)eb * TA + pb] = w1;
                *(u32x2*)(F.ws + WS_POS + (size_t)row * 8) = (u32x2){((unsigned)ea << 24) | pa, ((unsigned)eb << 24) | pb};
                } else if (w0 + w1 + (float)(ea + eb) == -12345.0f) WT[row] = w0;
            }
            asm volatile("s_waitcnt lgkmcnt(0)" ::: "memory");
        }
        }
    }
    if (mode & 8) {
    const int ngrp = nrows / 16;
    const LAS unsigned char* wrow = F.lds + (lane & 15) * WR_STRIDE + 16 * (lane >> 4);
    bf16x8 av[32];
    { const bf16_t* hrow = HB + (size_t)((F.gw < ngrp ? F.gw : 0) * 16 + (lane & 15)) * 1024 + 8 * (lane >> 4);
#pragma unroll
      for (int ks = 0; ks < 32; ++ks) av[ks] = *(const bf16x8*)(hrow + 32 * ks); }
    for (int grp = F.gw; grp < ngrp; grp += F.NGW) {
        const int r0 = grp * 16;
        f32x4 lacc[3] = {(f32x4){0.f, 0.f, 0.f, 0.f}, (f32x4){0.f, 0.f, 0.f, 0.f}, (f32x4){0.f, 0.f, 0.f, 0.f}};
#pragma unroll
        for (int ks = 0; ks < 32; ++ks) {
#pragma unroll
            for (int nt = 0; nt < 3; ++nt) { const bf16x8 bv = *(const LAS bf16x8*)(wrow + nt * 16 * WR_STRIDE + 64 * ks); lacc[nt] = __builtin_amdgcn_mfma_f32_16x16x32_bf16(av[ks], bv, lacc[nt], 0, 0, 0); } }
        if (grp + F.NGW < ngrp) { const bf16_t* hrow = HB + (size_t)((grp + F.NGW) * 16 + (lane & 15)) * 1024 + 8 * (lane >> 4);
#pragma unroll
            for (int ks = 0; ks < 32; ++ks) av[ks] = *(const bf16x8*)(hrow + 32 * ks); }
#pragma unroll
        for (int nt = 0; nt < 3; ++nt)
#pragma unroll
            for (int r = 0; r < 4; ++r) LG[(4 * (lane >> 4) + r) * LG_STRIDE + nt * 16 + (lane & 15)] = lacc[nt][r];
        asm volatile("s_waitcnt lgkmcnt(0)" ::: "memory");
        if (lane < 16) {
            const int row = r0 + lane; float lg[36];
#pragma unroll
            for (int q4 = 0; q4 < 9; ++q4) { const f32x4 t = *(const LAS f32x4*)(LG + lane * LG_STRIDE + 4 * q4); lg[4 * q4] = t.x; lg[4 * q4 + 1] = t.y; lg[4 * q4 + 2] = t.z; lg[4 * q4 + 3] = t.w; }
            float gl[4];
#pragma unroll
            for (int j = 0; j < 4; ++j) gl[j] = lg[j] + a->in[I_MOEBG][l * 4 + j];
            int gi = 0; float gm = gl[0];
#pragma unroll
            for (int j = 1; j < 4; ++j) if (gl[j] > gm) { gm = gl[j]; gi = j; }
            float gs = 0.f;
#pragma unroll
            for (int j = 0; j < 4; ++j) gs += expf(gl[j] - gm);
            const float gprob = 1.0f / gs;
            float el[8];
#pragma unroll
            for (int j = 0; j < 8; ++j) { float t = lg[4 + j] + a->in[I_MOEBE][l * 32 + j];
#pragma unroll
                for (int gg = 1; gg < 4; ++gg) t = (gi == gg) ? (lg[4 + gg * 8 + j] + a->in[I_MOEBE][l * 32 + gg * 8 + j]) : t;
                el[j] = t; }
            int i0 = 0; float v0 = el[0];
#pragma unroll
            for (int j = 1; j < 8; ++j) if (el[j] > v0) { v0 = el[j]; i0 = j; }
            int i1 = -1; float v1 = -3.0e38f;
#pragma unroll
            for (int j = 0; j < 8; ++j) if (j != i0 && el[j] > v1) { v1 = el[j]; i1 = j; }
            const float e1 = expf(v1 - v0), w0 = gprob / (1.0f + e1), w1 = gprob * e1 / (1.0f + e1);
            const int ea = gi * 8 + i0, eb = gi * 8 + i1;
            if (!(mode & 4)) {
            const unsigned pa = __hip_atomic_fetch_add(cnt + ea * 64, 1u, __ATOMIC_RELAXED, __HIP_MEMORY_SCOPE_AGENT);
            const unsigned pb = __hip_atomic_fetch_add(cnt + eb * 64, 1u, __ATOMIC_RELAXED, __HIP_MEMORY_SCOPE_AGENT);
            LIST[(size_t)ea * TA + pa] = row * 2; LIST[(size_t)eb * TA + pb] = row * 2 + 1;
            WT[(size_t)ea * TA + pa] = w0; WT[(size_t)eb * TA + pb] = w1;
            *(u32x2*)(F.ws + WS_POS + (size_t)row * 8) = (u32x2){((unsigned)ea << 24) | pa, ((unsigned)eb << 24) | pb};
            } else if (w0 + w1 + (float)(ea + eb) == -12345.0f) WT[row] = w0;
        }
        asm volatile("s_waitcnt lgkmcnt(0)" ::: "memory");
    }
    }
    __syncthreads();
}

__device__ __forceinline__ void moe_tiles(Frame& F, int l) {
    __syncthreads();
    if (F.wave == 0) {
        const int e = F.lane & 31;
        const unsigned c = __hip_atomic_load(F.ctl + CW_CNT + (l * 32 + e) * 64, __ATOMIC_RELAXED, __HIP_MEMORY_SCOPE_AGENT);
        const int t = (int)((c + 255u) >> 8); int incl = t;
#pragma unroll
        for (int o = 1; o < 32; o <<= 1) { const int v = __shfl_up(incl, o, 32); if (e >= o) incl += v; }
        if (F.lane < 32) { F.MISC[32 + e] = (unsigned)(incl - t); F.MISC[72 + e] = c; if (e == 31) F.MISC[64] = (unsigned)incl; }
    }
    __syncthreads();
}
struct SchedMoe {
    int G, c, l, second; volatile LAS unsigned* MISC; const unsigned* cnt; const int* LIST; const char *A, *B;
    __device__ __forceinline__ bool next(int i, pg8::GU& u) const {
        const int L = i * G + c, tile = L >> 2, pn = L & 3; if (tile >= __builtin_amdgcn_readfirstlane((int)MISC[64])) return false;
        const int lj = (int)__builtin_amdgcn_mbcnt_hi(~0u, __builtin_amdgcn_mbcnt_lo(~0u, 0u)) & 31;
        const int e = __builtin_popcountll(__ballot(lj >= 1 && (int)MISC[32 + lj] <= tile) & 0xffffffffull);
        const int tl = tile - __builtin_amdgcn_readfirstlane((int)MISC[32 + e]); const int ce = __builtin_amdgcn_readfirstlane((int)MISC[72 + e]);
        u.gl = LIST + (size_t)e * TA + tl * 256; u.nvalid = ce - tl * 256 < 256 ? ce - tl * 256 : 256; u.e = e; u.pm = tile; u.pn = pn; u.kind = 0;
        if (!second) { u.A = A; u.B = B + (size_t)e * 1024 * 1024 + (size_t)pn * 256 * 1024; u.K = 1024; }
        else { u.A = A + (size_t)tile * 256 * 512; u.B = B + (size_t)e * 1024 * 512 + (size_t)pn * 256 * 512; u.K = 512; }
        return true;
    }
};
struct EpiMoe1 {
    unsigned char* HID; const float* WTS;
    __device__ __forceinline__ void operator()(const f32x4 (&acc)[2][2][4][2], const pg8::GU& u, int wr, int wc, int fr, int fq) const {
        int ln_; asm volatile("v_mbcnt_lo_u32_b32 %0, -1, 0\n\tv_mbcnt_hi_u32_b32 %0, -1, %0" : "=v"(ln_));
        const int rl0 = wr * 64 + (ln_ & 15), row0 = u.pm * 256 + rl0, hc0 = u.pn * 128 + wc * 16 + 4 * (ln_ >> 4);
        const float* wts = WTS + (u.gl - LISTB);
#if MK_DUP == 51
        for (int rep_ = 0; rep_ < 2; ++rep_) { asm volatile("" ::: "memory");
#else
        {
#endif
#pragma unroll
        for (int ai = 0; ai < 2; ++ai)
#pragma unroll
            for (int m = 0; m < 4; ++m) { const int rl = rl0 + ai * 128 + m * 16; const float wsc = wts[rl < u.nvalid ? rl : 0] * ((rl < u.nvalid) ? (H8S * W8R) : 0.f);
#pragma unroll
                for (int bj = 0; bj < 2; ++bj) { const f32x4 gt = acc[ai][bj][m][0] * W8R, up = acc[ai][bj][m][1] * wsc;
                    *(unsigned*)(HID + (size_t)(row0 + ai * 128 + m * 16) * 512 + hc0 + bj * 64) =
                        pk4_fp8(gt[0] * sigmoidf_(gt[0]) * up[0], gt[1] * sigmoidf_(gt[1]) * up[1], gt[2] * sigmoidf_(gt[2]) * up[2], gt[3] * sigmoidf_(gt[3]) * up[3]); } }
        }
    }
    const int* LISTB;
};
struct EpiMoe2 {
    unsigned char* YS;
    __device__ __forceinline__ void operator()(const f32x4 (&acc)[2][2][4][2], const pg8::GU& u, int wr, int wc, int fr, int fq) const {
        int ln_; asm volatile("v_mbcnt_lo_u32_b32 %0, -1, 0\n\tv_mbcnt_hi_u32_b32 %0, -1, %0" : "=v"(ln_));
        const int rb = wr * 64 + (ln_ & 15), cq = wc * 32 + 8 * (ln_ >> 4);
        unsigned char* dst0 = YS + (size_t)(u.pm * 256 + rb) * 1024 + u.pn * 256 + cq;
#if MK_DUP == 50
        for (int rep_ = 0; rep_ < 2; ++rep_) { asm volatile("" ::: "memory");
#else
        {
#endif
#pragma unroll
        for (int ai = 0; ai < 2; ++ai)
#pragma unroll
            for (int m = 0; m < 4; ++m) { const int r = rb + ai * 128 + m * 16;
                if (r < u.nvalid) { unsigned char* dst = dst0 + (size_t)(ai * 128 + m * 16) * 1024;
#pragma unroll
                    for (int bj = 0; bj < 2; ++bj) { const f32x4 v0 = acc[ai][bj][m][0] * W8R, v1 = acc[ai][bj][m][1] * W8R;
                        *(u32x2*)(dst + bj * 128) = (u32x2){pk4_fp8(v0[0], v0[1], v0[2], v0[3]), pk4_fp8(v1[0], v1[1], v1[2], v1[3])}; } } }
        }
    }
};

__device__ __forceinline__ void phase_ln2(Frame& F, ArgsP a, int l, int nrows) {
    const float* mod = (const float*)(F.ws + WS_MOD) + (size_t)l * 33 * 6144; const float* modn = (const float*)(F.ws + WS_MOD) + (size_t)33 * 6144;
    bf16_t* X = (bf16_t*)(F.ws + WS_X); bf16_t* HB = (bf16_t*)(F.ws + WS_HB);
    const unsigned char* YS = F.ws + WS_YS; const unsigned* POS = (const unsigned*)(F.ws + WS_POS);
    moe_tiles(F, l);
#define LN2_YROW(p) ((size_t)((int)F.MISC[32 + ((p) >> 24)] * 256 + (int)((p) & 0xFFFFFFu)) * 1024)
    const int lane = F.lane;
    f32x4 lg[2][2], lb[2][2];
#pragma unroll
    for (int hh = 0; hh < 2; ++hh) { const int c = hh * 512 + 8 * lane;
        lg[hh][0] = *(const f32x4*)(a->in[I_LN2G] + l * 1024 + c); lg[hh][1] = *(const f32x4*)(a->in[I_LN2G] + l * 1024 + c + 4); lb[hh][0] = *(const f32x4*)(a->in[I_LN2B] + l * 1024 + c); lb[hh][1] = *(const f32x4*)(a->in[I_LN2B] + l * 1024 + c + 4); }
    const int step = 2 * F.NGW;
    u32x4 pre[2][2]; u32x2 prey[2][2][2];
#pragma unroll
    for (int q = 0; q < 2; ++q)
#pragma unroll
        for (int hh = 0; hh < 2; ++hh) { const int row = F.gw + q * F.NGW; const size_t o = (size_t)row * 1024 + hh * 512 + 8 * lane; pre[q][hh] = *(const u32x4*)(X + o);
            const u32x2 p = *(const u32x2*)(POS + 2 * row); prey[q][hh][0] = *(const u32x2*)(YS + LN2_YROW(p.x) + hh * 512 + 8 * lane); prey[q][hh][1] = *(const u32x2*)(YS + LN2_YROW(p.y) + hh * 512 + 8 * lane); }
    u32x2 pp[2];
#pragma unroll
    for (int q = 0; q < 2; ++q) { const int row = F.gw + step + q * F.NGW; pp[q] = *(const u32x2*)(POS + 2 * (row < nrows ? row : 0)); }
    for (int row0 = F.gw; row0 < nrows; row0 += step) {
        float v[2][16];
#pragma unroll
        for (int q = 0; q < 2; ++q) { const int row = row0 + q * F.NGW; const float* mrow = mod + (size_t)mod_row(row) * 6144;
#pragma unroll
            for (int hh = 0; hh < 2; ++hh) { const int c = hh * 512 + 8 * lane;
                const u32x4 xw = pre[q][hh]; const u32x2 y0 = prey[q][hh][0], y1 = prey[q][hh][1];
                const f32x4 g0 = *(const f32x4*)(mrow + 5120 + c) * (1.0f / H8S), g1 = *(const f32x4*)(mrow + 5120 + c + 4) * (1.0f / H8S);
                const unsigned xs[4] = {xw.x, xw.y, xw.z, xw.w};
                float ya[8], yb[8], t4[4];
                fp8x4_to_f32(y0.x, t4); ya[0] = t4[0]; ya[1] = t4[1]; ya[2] = t4[2]; ya[3] = t4[3]; fp8x4_to_f32(y0.y, t4); ya[4] = t4[0]; ya[5] = t4[1]; ya[6] = t4[2]; ya[7] = t4[3];
                fp8x4_to_f32(y1.x, t4); yb[0] = t4[0]; yb[1] = t4[1]; yb[2] = t4[2]; yb[3] = t4[3]; fp8x4_to_f32(y1.y, t4); yb[4] = t4[0]; yb[5] = t4[1]; yb[6] = t4[2]; yb[7] = t4[3];
#pragma unroll
                for (int j = 0; j < 4; ++j) { const float ga = j < 2 ? g0[2 * j] : g1[2 * j - 4], gb = j < 2 ? g0[2 * j + 1] : g1[2 * j - 3];
                    v[q][hh * 8 + 2 * j] = DN_ALPHA * bf_lo(xs[j]) + ga * (ya[2 * j] + yb[2 * j]); v[q][hh * 8 + 2 * j + 1] = DN_ALPHA * bf_hi(xs[j]) + gb * (ya[2 * j + 1] + yb[2 * j + 1]); } } }
        if (row0 + step < nrows) {
#pragma unroll
            for (int q = 0; q < 2; ++q)
#pragma unroll
                for (int hh = 0; hh < 2; ++hh) { const size_t o = (size_t)(row0 + step + q * F.NGW) * 1024 + hh * 512 + 8 * lane; pre[q][hh] = *(const u32x4*)(X + o);
                    prey[q][hh][0] = *(const u32x2*)(YS + LN2_YROW(pp[q].x) + hh * 512 + 8 * lane); prey[q][hh][1] = *(const u32x2*)(YS + LN2_YROW(pp[q].y) + hh * 512 + 8 * lane); }
#pragma unroll
            for (int q = 0; q < 2; ++q) { const int row = row0 + 2 * step + q * F.NGW; pp[q] = *(const u32x2*)(POS + 2 * (row < nrows ? row : 0)); } }
        float s[2], mean[2], qq[2], rstd[2];
#pragma unroll
        for (int q = 0; q < 2; ++q) { s[q] = 0.f;
#pragma unroll
            for (int j = 0; j < 16; ++j) s[q] += v[q][j]; }
#pragma unroll
        for (int o = 1; o < 64; o <<= 1)
#pragma unroll
            for (int q = 0; q < 2; ++q) s[q] += __shfl_xor(s[q], o);
#pragma unroll
        for (int q = 0; q < 2; ++q) { mean[q] = s[q] * (1.f / 1024.f); qq[q] = 0.f;
#pragma unroll
            for (int j = 0; j < 16; ++j) { v[q][j] -= mean[q]; qq[q] += v[q][j] * v[q][j]; } }
#pragma unroll
        for (int o = 1; o < 64; o <<= 1)
#pragma unroll
            for (int q = 0; q < 2; ++q) qq[q] += __shfl_xor(qq[q], o);
#pragma unroll
        for (int q = 0; q < 2; ++q) rstd[q] = 1.0f / sqrtf(qq[q] * (1.f / 1024.f) + LN_EPS);
#pragma unroll
        for (int q = 0; q < 2; ++q) { const int row = row0 + q * F.NGW; const float* mn = modn + (size_t)mod_row(row) * 6144;
#pragma unroll
            for (int hh = 0; hh < 2; ++hh) { const int c = hh * 512 + 8 * lane;
                float x2[8];
#pragma unroll
                for (int j = 0; j < 8; ++j) x2[j] = v[q][hh * 8 + j] * rstd[q] * (j < 4 ? lg[hh][0][j] : lg[hh][1][j - 4]) + (j < 4 ? lb[hh][0][j] : lb[hh][1][j - 4]);
                if (l == 0) {
                    u32x4 w; w.x = pk2(x2[0], x2[1]); w.y = pk2(x2[2], x2[3]); w.z = pk2(x2[4], x2[5]); w.w = pk2(x2[6], x2[7]);
                    *(u32x4*)(X + (size_t)row * 1024 + c) = w;
                    const f32x4 sh0 = *(const f32x4*)(mn + c), sh1 = *(const f32x4*)(mn + c + 4), sc0 = *(const f32x4*)(mn + 1024 + c), sc1 = *(const f32x4*)(mn + 1024 + c + 4);
                    float hv[8];
#pragma unroll
                    for (int j = 0; j < 8; ++j) hv[j] = x2[j] * (1.f + (j < 4 ? sc0[j] : sc1[j - 4])) + (j < 4 ? sh0[j] : sh1[j - 4]);
                    u32x4 hw; hw.x = pk2(hv[0], hv[1]); hw.y = pk2(hv[2], hv[3]); hw.z = pk2(hv[4], hv[5]); hw.w = pk2(hv[6], hv[7]);
                    *(u32x4*)(HB + (size_t)row * 1024 + c) = hw;
                } else {
                    float* op = a->out + (size_t)row * 1024 + c;
                    *(f32x4*)op = (f32x4){x2[0], x2[1], x2[2], x2[3]}; *(f32x4*)(op + 4) = (f32x4){x2[4], x2[5], x2[6], x2[7]};
                }
            } }
    }
}

constexpr int NPH_L = 11, NPH = 2 + 2 * NPH_L;
__global__ void __launch_bounds__(NTHREADS, 2) mk_fwd(Args args) {
    extern __shared__ __attribute__((aligned(16))) unsigned char lds_raw[];
    Frame F;
    F.lds = (LAS unsigned char*)lds_raw;
    F.MISC = (volatile LAS unsigned*)(F.lds + MISC_OFF);
    int wave0 = __builtin_amdgcn_readfirstlane((int)threadIdx.x >> 6); asm volatile("" : "+s"(wave0));
#define LANE_ID(dst) asm volatile("v_mbcnt_lo_u32_b32 %0, -1, 0\n\tv_mbcnt_hi_u32_b32 %0, -1, %0" : "=v"(dst))
    F.wave = wave0; LANE_ID(F.lane); F.tid = wave0 * 64 + F.lane;
    F.G = gridDim.x; F.bid = blockIdx.x; F.gw = F.bid * NWAVES + F.wave; F.NGW = F.G * NWAVES;
    const int vcu = (F.G % 8 == 0) ? (F.bid % 8) * (F.G / 8) + F.bid / 8 : F.bid;
    ArgsP ap = (ArgsP)__builtin_amdgcn_kernarg_segment_ptr(); asm volatile("" : "+s"(ap));
    F.ws = ap->ws; F.ctl = (unsigned*)(F.ws + WS_CTL);
    for (int u = F.tid; u < 128; u += NTHREADS) F.MISC[u] = 0u;
    __syncthreads();
#if MK_SPLIT
#define GRID_BAR() do { } while (0)
#else
    XcdBarrier bar = xcd_barrier_post(F.ctl + CW_BAR, F.MISC + 8);
#define GRID_BAR() xcd_barrier(bar)
#endif
    const int lo = ap->ph_lo, hi = ap->ph_hi;
#ifndef MK_ATT_V1
#define MK_ATT_V1 0
#endif
#ifndef MK_PHMASK
#define MK_PHMASK 0xFFFFFF
#endif
#define PHON(p) (((MK_PHMASK) >> (p)) & 1)
#ifndef MK_DUP
#define MK_DUP -1
#endif
#define NDUP(p) ((MK_DUP) == (p) ? 2 : 1)
#define IN(k) (lo <= (k) && (k) < hi)
#define SEAM(k) do { if (IN((k) + 1)) { GRID_BAR(); if (MK_DUP == 40) GRID_BAR(); } { LANE_ID(F.lane); F.tid = wave0 * 64 + F.lane; ap = (ArgsP)__builtin_amdgcn_kernarg_segment_ptr(); asm volatile("" : "+s"(ap)); F.ws = ap->ws; F.ctl = (unsigned*)(F.ws + WS_CTL); ws = F.ws; } } while (0)
    unsigned char* ws = F.ws;

    if (PHON(0) && IN(0)) { for (int dup = 0; dup < NDUP(0); ++dup) p0a_prologue(F, ap); SEAM(0); }
    if (PHON(1) && IN(1)) { p0b_mod(F, ap); SEAM(1); }

    for (int l = 0; l < DEPTH; ++l) {
        const int pb = 2 + l * NPH_L;
        const int nrows = (l == 0) ? TA : TL;
#define wsl ((const char*)(ws + WS_WS + (size_t)l * WSL))
#define modl ((const float*)(ws + WS_MOD) + (size_t)l * 33 * 6144)
        const float lam_init = 0.8f - 0.6f * expf(-0.3f * (float)l);

        if (PHON(2) && IN(pb + 0) && l == 0) { for (int dup = 0; dup < NDUP(2); ++dup) phase_modulate0(F, ap); SEAM(pb + 0); }

        if (PHON(3) && IN(pb + 1)) {
            SchedIn S; S.G = F.G; S.c = F.bid; S.nM = nrows / 256; S.nreg = S.nM * 11; S.nctx = (l == 0) ? 0 : 128; S.A = (const char*)(ws + WS_HB); S.B = wsl;
            EpiIn E{(bf16_t*)(ws + WS_ZG), (bf16_t*)(ws + WS_ZH), (bf16_t*)(ws + WS_Q), (bf16_t*)(ws + WS_K), (bf16_t*)(ws + WS_V), (const float*)(ws + WS_ROPE)};
            for (int dup = 0; dup < NDUP(3); ++dup) pg8::gemm_phase<EpiIn, SchedIn, false>(F.lds, S, E, 2048, 2048, F.wave, F.lane);
            SEAM(pb + 1);
        }

        if (PHON(4) && IN(pb + 2)) {
            for (int dup = 0; dup < NDUP(20); ++dup) for (int u = F.bid; u < nrows / 128; u += F.G) gmlp_unit(F, ap, l, u);
            for (int dup = 0; dup < NDUP(21); ++dup) for (int u = F.bid; u < nrows / 128; u += F.G) sconv_unit(F, ap, l, u);
            if (!MK_ROPE_EPI) for (int u = F.bid; u < TL / 128; u += F.G) rope_unit(F, u);
            SEAM(pb + 2);
        }

        if (PHON(5) && IN(pb + 3)) {
            const float* HF = (const float*)(ws + WS_HF);
#ifndef MK_NOCONV
            for (int dup = 0; dup < NDUP(22); ++dup) for (int c = F.bid; c < 256; c += F.G) {
                conv_unit<8>(F, ap, l, c, HF + (size_t)l * 2048 * 512, (const bf16_t*)(ws + WS_VT) + (size_t)c * TL, (bf16_t*)(ws + WS_YT) + (size_t)c * TL);
                if (l == 0) conv_unit<1>(F, ap, l, c, HF + (size_t)2 * 2048 * 512, (const bf16_t*)(ws + WS_VT) + (size_t)256 * TL + (size_t)c * TC, (bf16_t*)(ws + WS_YT) + (size_t)256 * TL + (size_t)c * TC);
            }
#endif
#ifndef MK_NOATT
            float s1 = 0.f, s2 = 0.f;
            for (int i = 0; i < 64; ++i) { s1 += ap->in[I_LQ1][l * 64 + i] * ap->in[I_LK1][l * 64 + i]; s2 += ap->in[I_LQ2][l * 64 + i] * ap->in[I_LK2][l * 64 + i]; }
            const float lam = expf(s1) - expf(s2) + lam_init;
#if MK_ATT_V1
            for (int u = F.bid; u < 1024; u += F.G) { const int b = u >> 5, rem = u & 31; AttnUnit U; U.qrow0 = b * SEQ + (rem & 7) * 256; U.h = rem >> 3; U.klat0 = b * SEQ; U.nlat = 32; U.kctx0 = TL + b * CTXL; U.nt = 36;
                attn_unit_v1(F, ap, l, U, lam, lam_init); }
            if (l == 0) for (int u = F.bid; u < 128; u += F.G) { const int b = u >> 2; AttnUnit U; U.qrow0 = TL + b * CTXL; U.h = u & 3; U.klat0 = 0; U.nlat = 0; U.kctx0 = TL + b * CTXL; U.nt = 4;
                attn_unit_v1(F, ap, l, U, lam, lam_init); }
#else
#define ATT_LAT(Ux, ux) do { const int b_ = (ux) >> 6, rem_ = (ux) & 63; Ux.qrow0 = b_ * SEQ + (rem_ & 15) * 128; Ux.h = rem_ >> 4; Ux.klat0 = b_ * SEQ; Ux.nlat = 32; Ux.kctx0 = TL + b_ * CTXL; Ux.nt = 36; } while (0)
#define ATT_CTX(Ux, ux) do { const int b_ = (ux) >> 3; Ux.qrow0 = TL + b_ * CTXL + ((ux) & 1) * 128; Ux.h = ((ux) >> 1) & 3; Ux.klat0 = 0; Ux.nlat = 0; Ux.kctx0 = TL + b_ * CTXL; Ux.nt = 4; } while (0)
            for (int dup = 0; dup < NDUP(23); ++dup) for (int u = vcu; u < 2048; u += F.G) { const bool hn = u + F.G < 2048; AttnUnit U, Un; ATT_LAT(U, u); ATT_LAT(Un, hn ? u + F.G : u);
                attn_unit(F, ap, l, U, lam, lam_init, Un, hn, u == vcu); }
            if (l == 0) for (int u = vcu; u < 256; u += F.G) { const bool hn = u + F.G < 256; AttnUnit U, Un; ATT_CTX(U, u); ATT_CTX(Un, hn ? u + F.G : u);
                attn_unit(F, ap, l, U, lam, lam_init, Un, hn, u == vcu); }
#undef ATT_LAT
#undef ATT_CTX
#endif
#endif
            SEAM(pb + 3);
        }

        if (PHON(6) && IN(pb + 4)) { for (int dup = 0; dup < NDUP(6); ++dup) for (int u = F.bid; u < nrows / 128; u += F.G) ytrans_unit(F, u); __syncthreads(); SEAM(pb + 4); }

        if (PHON(7) && IN(pb + 5)) {
            SchedMerge S{F.G, F.bid, nrows / 256, (const char*)(ws + WS_HB), (const char*)(ws + WS_YCAT), wsl, wsl + 12 * MiB};
            EpiMerge E{(bf16_t*)(ws + WS_MERGED), (bf16_t*)(ws + WS_PSCR) + (size_t)F.bid * 65536};
            for (int dup = 0; dup < NDUP(7); ++dup) pg8::gemm_phase<EpiMerge, SchedMerge, false>(F.lds, S, E, 2048, 2048, F.wave, F.lane);
            { const int rem = (nrows / 256 * 4) % F.G;
              if (rem && F.bid >= rem) expert_weights_fp8(F, ap, l, 0, NCONV_E, (F.bid - rem) * NWAVES + F.wave, (F.G - rem) * NWAVES); }
#if MK_DUP == 70
            if (F.tid == 0) F.MISC[111] = (unsigned)__builtin_amdgcn_s_memrealtime();
#endif
            SEAM(pb + 5);
#if MK_DUP == 70
            if (F.tid == 0 && l == 0) F.MISC[110] = (unsigned)__builtin_amdgcn_s_memrealtime() - (unsigned)F.MISC[111];
#endif
        }

        if (PHON(8) && IN(pb + 6)) {
            SchedGrid S{F.G, F.bid, nrows / 256, 4, 1024, (const char*)(ws + WS_MERGED), wsl + 18 * MiB, (size_t)256 * 2048, (size_t)256 * 2048};
            EpiOut E{ap->in[I_X], ap->in[I_CTX], (l == 0) ? nullptr : (const bf16_t*)(ws + WS_X), modl, (bf16_t*)(ws + WS_R1)};
            for (int dup = 0; dup < NDUP(8); ++dup) pg8::gemm_phase<EpiOut, SchedGrid, false>(F.lds, S, E, 2048, 2048, F.wave, F.lane);
            SEAM(pb + 6);
        }

        if (PHON(9) && IN(pb + 7)) { phase_ln1_router(F, ap, l, nrows, 19, ((nrows / 256 * 4) % F.G) ? NCONV_E : 0); SEAM(pb + 7); }

        if (PHON(10) && IN(pb + 8)) {
            moe_tiles(F, l);
            SchedMoe S{F.G, vcu, l, 0, F.MISC, F.ctl + CW_CNT + l * 32 * 64, (const int*)(ws + WS_LIST), (const char*)(ws + WS_HB8), (const char*)(ws + WS_EW1)};
            EpiMoe1 E{ws + WS_HID, (const float*)(ws + WS_WTS), (const int*)(ws + WS_LIST)};
            for (int dup = 0; dup < NDUP(10); ++dup) pg8::gemm_phase<EpiMoe1, SchedMoe, true, true>(F.lds, S, E, 1024, 1024, F.wave, F.lane);
            SEAM(pb + 8);
        }

        if (PHON(11) && IN(pb + 9)) {
            moe_tiles(F, l);
            SchedMoe S{F.G, vcu, l, 1, F.MISC, F.ctl + CW_CNT + l * 32 * 64, (const int*)(ws + WS_LIST), (const char*)(ws + WS_HID), (const char*)(ws + WS_EW2)};
            EpiMoe2 E{ws + WS_YS};
            for (int dup = 0; dup < NDUP(11); ++dup) pg8::gemm_phase<EpiMoe2, SchedMoe, false, true>(F.lds, S, E, 512, 512, F.wave, F.lane);
            SEAM(pb + 9);
        }

        if (PHON(12) && IN(pb + 10)) { phase_ln2(F, ap, l, nrows); if (MK_DUP == 32 && l == 1) phase_ln2(F, ap, l, nrows); SEAM(pb + 10); }
    }
#if MK_DUP == 70
    if (F.tid == 0) __hip_atomic_store(F.ctl + 24000 + F.bid, (unsigned)F.MISC[110], __ATOMIC_RELAXED, __HIP_MEMORY_SCOPE_AGENT);
    GRID_BAR();
    if (F.bid == 0 && F.tid == 0) { F.MISC[110] = __hip_atomic_load(F.ctl + 24000 + MK_PROBE_BLOCK, __ATOMIC_RELAXED, __HIP_MEMORY_SCOPE_AGENT); }
#endif
#if MK_DUP >= 60 && MK_DUP <= 70
    if (F.bid == 0 && F.tid == 0) { const unsigned long long s_ = F.MISC[110]; const unsigned long long t0_ = __builtin_amdgcn_s_memrealtime(); while (__builtin_amdgcn_s_memrealtime() - t0_ < 4ull * s_) { __builtin_amdgcn_s_sleep(8); } }
#endif
#undef wsl
#undef modl
#undef IN
#undef SEAM
#undef GRID_BAR
}

extern "C" void kernel_launch(void* const* d_in, const int* in_sizes, int n_in, void* d_out, int out_size, void* d_ws, size_t ws_size, hipStream_t stream) {
    static int grid = 0;
    if (grid == 0) {
        if (n_in != 40 || out_size != TL * D || ws_size < WS_END) { fprintf(stderr, "kernel_launch: unexpected shapes: n_in %d out %d ws %zu (need %zu)\n", n_in, out_size, ws_size, (size_t)WS_END); grid = -1; return; }
        int dev = 0, cus = 0;
        if (hipGetDevice(&dev) != hipSuccess || hipDeviceGetAttribute(&cus, hipDeviceAttributeMultiprocessorCount, dev) != hipSuccess) { grid = -1; return; }
        if (hipFuncSetAttribute((const void*)mk_fwd, hipFuncAttributeMaxDynamicSharedMemorySize, LDS_BYTES) != hipSuccess) { fprintf(stderr, "kernel_launch: hipFuncSetAttribute failed\n"); grid = -1; return; }
        int per_cu = 0;
        if (hipOccupancyMaxActiveBlocksPerMultiprocessor(&per_cu, (const void*)mk_fwd, NTHREADS, LDS_BYTES) != hipSuccess || per_cu < 1) fprintf(stderr, "kernel_launch: occupancy query reports %d\n", per_cu);
        (void)hipGetLastError();
        grid = cus;
    }
    if (grid < 0) return;
    if (hipMemsetAsync((char*)d_ws + WS_CTL, 0, CTL_ZERO_BYTES, stream) != hipSuccess) return;
    Args a{};
    for (int i = 0; i < 40; ++i) a.in[i] = (const float*)d_in[i];
    a.out = (float*)d_out; a.ws = (unsigned char*)d_ws;
#if MK_SPLIT
    for (int p = 0; p < NPH; ++p) { a.ph_lo = p; a.ph_hi = p + 1; hipLaunchKernelGGL(mk_fwd, dim3(grid), dim3(NTHREADS), LDS_BYTES, stream, a); }
#else
    a.ph_lo = 0; a.ph_hi = NPH;
    hipLaunchKernelGGL(mk_fwd, dim3(grid), dim3(NTHREADS), LDS_BYTES, stream, a);
#endif
}
```

```cpp
#include <hip/hip_runtime.h>
#include <cstdio>
#include <cstdint>

#ifndef MK_SPLIT
#define MK_SPLIT 0
#endif

#ifndef MK_F8BUILTIN
#define MK_F8BUILTIN 0
#endif
#ifndef MK_PROBE_BLOCK
#define MK_PROBE_BLOCK 255
#endif
#ifndef MK_DUP
#define MK_DUP -1
#endif
#ifndef MK_ROPE_EPI
#define MK_ROPE_EPI 1
#endif
#define GAS __attribute__((address_space(1)))
#define LAS __attribute__((address_space(3)))
typedef unsigned short bf16_t;
typedef short bf16x8 __attribute__((ext_vector_type(8)));
typedef short s16x4 __attribute__((ext_vector_type(4)));
typedef float f32x2 __attribute__((ext_vector_type(2)));
typedef float f32x4 __attribute__((ext_vector_type(4)));
typedef float f32x16 __attribute__((ext_vector_type(16)));
typedef unsigned u32x2 __attribute__((ext_vector_type(2)));
typedef unsigned u32x4 __attribute__((ext_vector_type(4)));
typedef __bf16 bf16x2_t __attribute__((ext_vector_type(2)));

constexpr int D = 1024, BATCH = 32, SEQ = 2048, CTXL = 256, DEPTH = 2;
constexpr int TL = BATCH * SEQ, TC = BATCH * CTXL, TA = TL + TC;
constexpr int NIN = 5888, NZ = 2816;
constexpr int OFF_GM = 0, OFF_HY = 512, OFF_Q = 1280, OFF_K = 1792, OFF_V = 2304, OFF_GATE = 2816;
constexpr int NEXP = 32, MOEH = 512;
constexpr float LN_EPS = 1e-5f;
constexpr float DN_ALPHA = 1.4142135623730951f;
constexpr float QSCALE = 0.125f * 1.4426950408889634f;
constexpr int NWAVES = 8, NTHREADS = 512;

constexpr size_t MiB = 1u << 20;
constexpr size_t WS_CTL = 0, CTL_ZERO_BYTES = 1 * MiB;
constexpr size_t WS_MOD = 1 * MiB;
constexpr size_t WS_MODP = 3 * MiB;
constexpr size_t WS_ROPE = 16 * MiB;
constexpr size_t WS_HF = 17 * MiB;
constexpr size_t WS_LIST = 26 * MiB;
constexpr size_t WS_WT = 36 * MiB;
constexpr size_t WS_WTS = 988 * MiB;
constexpr size_t WS_WSB = 37 * MiB;
constexpr size_t WS_WS = 48 * MiB;
constexpr size_t WSL = 20 * MiB;
constexpr size_t WS_HB = 88 * MiB;
constexpr size_t WS_X = 232 * MiB;
constexpr size_t WS_ZG = 376 * MiB;
constexpr size_t WS_ZH = 448 * MiB;
constexpr size_t WS_Q = 556 * MiB;
constexpr size_t WS_K = 628 * MiB;
constexpr size_t WS_V = 700 * MiB;
constexpr size_t WS_YCAT = 772 * MiB;
constexpr size_t WS_HB8 = 772 * MiB;
constexpr size_t WS_VT = 916 * MiB;
constexpr size_t WS_X0 = 952 * MiB;
constexpr size_t WS_END = 997 * MiB;
constexpr size_t WS_YT = WS_ZG;
constexpr size_t WS_PSCR = WS_ZH;
constexpr size_t WS_MERGED = WS_Q;
constexpr size_t WS_R1 = WS_ZG;
constexpr size_t WS_EW1 = 700 * MiB;
constexpr size_t WS_EW2 = 732 * MiB;
constexpr size_t WS_HID = 604 * MiB;
constexpr size_t WS_YS = WS_ZG;
constexpr size_t WS_POS = 36 * MiB;
constexpr int CW_BAR = 4096;
constexpr int NCONV_E = 12288;
constexpr int CW_CNT = 16384;

constexpr int LDS_BYTES = 155648;
constexpr int MISC_OFF = LDS_BYTES - 512;

__device__ __forceinline__ unsigned pk2(float lo, float hi) { f32x2 v = {lo, hi}; bf16x2_t b = __builtin_convertvector(v, bf16x2_t); return __builtin_bit_cast(unsigned, b); }
__device__ __forceinline__ float sat8(float x) { return __builtin_amdgcn_fmed3f(x, -448.0f, 448.0f); }
__device__ __forceinline__ unsigned pk4_fp8(float a, float b, float c, float d) { int w = __builtin_amdgcn_cvt_pk_fp8_f32(sat8(a), sat8(b), 0, false); w = __builtin_amdgcn_cvt_pk_fp8_f32(sat8(c), sat8(d), w, true); return (unsigned)w; }
constexpr float H8S = 16.0f;
constexpr float W8S = 32.0f, W8R = 1.0f / 32.0f;
__device__ __forceinline__ void fp8x4_to_f32(unsigned w, float (&o)[4]) { const f32x2 a = __builtin_amdgcn_cvt_pk_f32_fp8((int)w, false), b = __builtin_amdgcn_cvt_pk_f32_fp8((int)w, true); o[0] = a.x; o[1] = a.y; o[2] = b.x; o[3] = b.y; }
__device__ __forceinline__ float bf_lo(unsigned w) { return __uint_as_float(w << 16); }
__device__ __forceinline__ float bf_hi(unsigned w) { return __uint_as_float(w & 0xffff0000u); }
__device__ __forceinline__ float bf1(bf16_t b) { return __uint_as_float(((unsigned)b) << 16); }
__device__ __forceinline__ float wave_sum(float v) {
#pragma unroll
    for (int o = 1; o < 64; o <<= 1) v += __shfl_xor(v, o);
    return v;
}
__device__ __forceinline__ float fast_exp2(float x) { return __builtin_amdgcn_exp2f(x); }
__device__ __forceinline__ float fast_rcp(float x) { return __builtin_amdgcn_rcpf(x); }
__device__ __forceinline__ float sigmoidf_(float x) { return fast_rcp(1.0f + fast_exp2(-1.4426950408889634f * x)); }
__device__ __forceinline__ float gelu_tanh(float x) {
    const float u = 0.7978845608028654f * (x + 0.044715f * x * x * x);
    return x * fast_rcp(1.0f + fast_exp2(-2.8853900817779268f * u));
}
#define XB_TMO      128
#define XB_XCNT(j)  (256  + 64 * (j))
#define XB_XSUB(j)  (1280 + 64 * (j))
#define XB_XGEN(j)  (2304 + 64 * (j))
#define XB_TOP      3328
#define XB_TOPGEN   3392
#define XCD_BAR_WORDS 3456
#define XB_SPIN_CAP (1u << 18)

__device__ __forceinline__ unsigned xb_ld(unsigned* p)              { return __hip_atomic_load(p, __ATOMIC_RELAXED, __HIP_MEMORY_SCOPE_AGENT); }
__device__ __forceinline__ unsigned xb_add(unsigned* p, unsigned v) { return __hip_atomic_fetch_add(p, v, __ATOMIC_RELAXED, __HIP_MEMORY_SCOPE_AGENT); }
__device__ __forceinline__ unsigned xb_xcc_id() { return (unsigned)__builtin_amdgcn_s_getreg((3 << 11) | 20) & 0xFu; }
#define XB_SPIN(cond, bar) do { unsigned _sp = 0; while (cond) { __builtin_amdgcn_s_sleep(1); \
    if ((++_sp & 255u) == 0u) { if (xb_ld(&(bar)[XB_TMO])) break; if (_sp > XB_SPIN_CAP) { atomicAdd(&(bar)[XB_TMO], 1u); break; } } } } while (0)

struct XcdBarrier {
    unsigned* bar; unsigned x;
    volatile LAS unsigned* st;
};

__device__ __forceinline__ XcdBarrier xcd_barrier_post(unsigned* bar, volatile LAS unsigned* st) {
    XcdBarrier b; b.bar = bar; b.x = xb_xcc_id(); b.st = st;
    if (threadIdx.x == 0) (void)xb_add(&bar[XB_XCNT(b.x)], 1u);
    return b;
}
__device__ __forceinline__ void xcd_barrier_complete(unsigned* bar, unsigned x, unsigned& nloc, unsigned& nx) {
    const unsigned G = gridDim.x * gridDim.y * gridDim.z;
    unsigned sum, cnt, mine, sp = 0u;
    for (;;) {
        sum = 0u; cnt = 0u; mine = 0u;
#pragma unroll
        for (unsigned j = 0; j < 16; ++j) { const unsigned c = xb_ld(&bar[XB_XCNT(j)]); sum += c; cnt += (c > 0u) ? 1u : 0u; mine = (j == x) ? c : mine; }
        if (sum == G) break;
        __builtin_amdgcn_s_sleep(1);
        if ((++sp & 255u) == 0u) { if (xb_ld(&bar[XB_TMO])) break; if (sp > XB_SPIN_CAP) { atomicAdd(&bar[XB_TMO], 1u); break; } }
    }
    nloc = mine > 0u ? mine : 1u; nx = cnt > 0u ? cnt : 1u;
}

__device__ __forceinline__ void xcd_barrier(const XcdBarrier& b) {
    asm volatile("s_waitcnt vmcnt(0)" ::: "memory");
    __syncthreads();
    if (threadIdx.x == 0) {
        unsigned* bar = b.bar;
        __builtin_amdgcn_s_waitcnt(0);
        unsigned nloc = b.st[0], nx = b.st[1];
        if (nloc == 0u) { xcd_barrier_complete(bar, b.x, nloc, nx); b.st[0] = nloc; b.st[1] = nx; }
        const unsigned old = xb_add(&bar[XB_XSUB(b.x)], 1u);
        const unsigned gen = old / nloc;
        if (old + 1u == (gen + 1u) * nloc) {
            __builtin_amdgcn_fence(__ATOMIC_RELEASE, "agent");
            asm volatile("s_waitcnt vmcnt(0)" ::: "memory");
            const unsigned og = xb_add(&bar[XB_TOP], 1u);
            const unsigned tg = og / nx;
            if (og + 1u == (tg + 1u) * nx) xb_add(&bar[XB_TOPGEN], 1u);
            else XB_SPIN(xb_ld(&bar[XB_TOPGEN]) == tg, bar);
            __builtin_amdgcn_fence(__ATOMIC_ACQUIRE, "agent");
            xb_add(&bar[XB_XGEN(b.x)], 1u);
            asm volatile("s_waitcnt vmcnt(0)" ::: "memory");
        } else {
            XB_SPIN(xb_ld(&bar[XB_XGEN(b.x)]) == gen, bar);
            __builtin_amdgcn_fence(__ATOMIC_ACQUIRE, "agent");
            asm volatile("s_waitcnt vmcnt(0)" ::: "memory");
        }
    }
    __syncthreads();
}


namespace pg8 {
constexpr int BM = 256, BK = 64, HALF = 128, HTB = HALF * BK * 2, STAGE_BYTES = 8 * HTB;
__host__ __device__ __forceinline__ int lds_byte(int r, int c) { const int st = (r >> 4) * 2 + (c >> 5), rr = r & 15, cc = c & 31, ob = rr * 64 + cc * 2; return st * 1024 + (ob ^ (((ob >> 9) & 1) << 5)); }
__host__ __device__ __forceinline__ void stage_rc(int b, int& R, int& C) { const int st = b / 1024, sb = b % 1024, swz = sb ^ (((sb >> 9) & 1) << 5); R = (st >> 1) * 16 + swz / 64; C = (st & 1) * 32 + (swz % 64) / 2; }
__host__ __device__ __forceinline__ int perm32(int rho) { const int n = rho >> 4, i = rho & 15; return 8 * (i >> 2) + 4 * n + (i & 3); }

struct GU { const char* A; const char* B; const int* gl; int K, kind, pm, pn, e, nvalid; };

__device__ __forceinline__ void grid_order(int L, int nM, int nN, int& pm, int& pn) {
    const int nwg = nM * nN; int wgid = L;
    { const int q = nwg / 8, r = nwg % 8, xcd = wgid % 8, off = wgid / 8; wgid = (xcd < r ? xcd * (q + 1) : r * (q + 1) + (xcd - r) * q) + off; }
    const int nig = 8 * nN, gid = wgid / nig, fm = gid * 8, gsz = (nM - fm) < 8 ? (nM - fm) : 8;
    pm = fm + ((wgid % nig) % gsz); pn = (wgid % nig) / gsz;
}

typedef int v8i __attribute__((ext_vector_type(8)));
typedef short bf16x16_t __attribute__((ext_vector_type(16)));
template <class Epi, class Sched, bool GATHER, bool F8 = false>
__device__ __forceinline__ void gemm_phase(LAS unsigned char* lds, const Sched& S, const Epi& E, const int lda, const int ldb, const int wid, const int lane) {
    const int tid = wid * 64 + lane;
    const int wr = wid >> 2, wc = wid & 3, fr = lane & 15, fq = lane >> 4;
    unsigned voffA[2], voffB[2]; int Rr[2], Cb[2];
#pragma unroll
    for (int i = 0; i < 2; ++i) { int R, C; stage_rc(tid * 16 + i * 8192, R, C); const int Rb = (R & ~31) + perm32(R & 31);
        Rr[i] = R; Cb[i] = C * 2; voffA[i] = (unsigned)(R * lda + C * 2); voffB[i] = (unsigned)(Rb * ldb + C * 2); }
    const size_t kstep = (size_t)(BK * 2);
    const size_t hstepA = (size_t)HALF * lda, hstepB = (size_t)HALF * ldb, qstepA = (size_t)64 * lda, qstepB = (size_t)64 * ldb;
    const unsigned ldsw = (unsigned)wid * 1024u;
    const int aoff = lds_byte(wr * 64 + fr, fq * 8), boff = lds_byte(wc * 32 + fr, fq * 8);
#define PG8_SA(b, h) (((b) * 2 + (h)) * HTB)
#define PG8_SB(b, h) ((4 + (b) * 2 + (h)) * HTB)
#define PG8_STAGE(bufoff, gbase, voff) do { _Pragma("unroll") for (int _i = 0; _i < 2; ++_i) \
        __builtin_amdgcn_global_load_lds((const unsigned*)((const char*)(gbase) + (voff)[_i]), (LAS unsigned*)(lds + (bufoff) + ldsw + _i * 8192), 16, 0, 0); } while (0)
#define PG8_STAGE1(bufoff, gbase, voff0, qstep) do { _Pragma("unroll") for (int _i = 0; _i < 2; ++_i) \
        __builtin_amdgcn_global_load_lds((const unsigned*)((const char*)(gbase) + (size_t)_i * (qstep) + (voff0)), (LAS unsigned*)(lds + (bufoff) + ldsw + _i * 8192), 16, 0, 0); } while (0)
#define PG8_STAGE_A(b, h, kp) do { if constexpr (GATHER) { if ((h) == 0) PG8_STAGE(PG8_SA(b, h), kp, gA0); else PG8_STAGE(PG8_SA(b, h), kp, gA1); } \
        else PG8_STAGE1(PG8_SA(b, h), (kp) + (h) * hstepA, voffA[0], qstepA); } while (0)
#define PG8_STAGE_B(b, h, kp) PG8_STAGE1(PG8_SB(b, h), (kp) + (h) * hstepB, voffB[0], qstepB)
#define PG8_LDA(dst, b, h) do { _Pragma("unroll") for (int m = 0; m < 4; ++m) _Pragma("unroll") for (int k = 0; k < 2; ++k) dst[m][k] = *(const LAS bf16x8*)(lds + PG8_SA(b, h) + aoff + m * 2048 + k * 1024); } while (0)
#define PG8_LDB(dst, b, h) do { _Pragma("unroll") for (int n = 0; n < 2; ++n) _Pragma("unroll") for (int k = 0; k < 2; ++k) dst[n][k] = *(const LAS bf16x8*)(lds + PG8_SB(b, h) + boff + n * 2048 + k * 1024); } while (0)
#define PG8_J8(X) __builtin_bit_cast(v8i, (bf16x16_t){X[0][0], X[0][1], X[0][2], X[0][3], X[0][4], X[0][5], X[0][6], X[0][7], X[1][0], X[1][1], X[1][2], X[1][3], X[1][4], X[1][5], X[1][6], X[1][7]})
#define PG8_MMA(ai, bj, At, Bt) do { __builtin_amdgcn_s_setprio(1); _Pragma("unroll") for (int m = 0; m < 4; ++m) _Pragma("unroll") for (int n = 0; n < 2; ++n) { \
        if constexpr (F8 && GATHER) acc[ai][bj][m][n] = __builtin_amdgcn_mfma_scale_f32_16x16x128_f8f6f4(PG8_J8(Bt[n]), PG8_J8(At[m]), acc[ai][bj][m][n], 0, 0, 0, 0x7F7F7F7F, 0, 0x7F7F7F7F); \
        else if constexpr (F8) { const v8i b8_ = PG8_J8(Bt[n]), a8_ = PG8_J8(At[m]); asm volatile("v_mfma_scale_f32_16x16x128_f8f6f4 %0, %1, %2, %0, %3, %3 op_sel_hi:[0,0,0]" : "+v"(acc[ai][bj][m][n]) : "v"(b8_), "v"(a8_), "v"(0x7F7F7F7F)); } \
        else { _Pragma("unroll") for (int k = 0; k < 2; ++k) acc[ai][bj][m][n] = __builtin_amdgcn_mfma_f32_16x16x32_bf16(Bt[n][k], At[m][k], acc[ai][bj][m][n], 0, 0, 0); } } \
        __builtin_amdgcn_s_setprio(0); } while (0)
#define PG8_WAIT_V(n) asm volatile("s_waitcnt vmcnt(" #n ")" ::: "memory")
#define PG8_WAIT_L(n) asm volatile("s_waitcnt lgkmcnt(" #n ")" ::: "memory")
#define PG8_BAR __builtin_amdgcn_s_barrier()
#define PG8_SCHED __builtin_amdgcn_sched_barrier(0)
#define PG8_GOFF(u, o0, o1) do { _Pragma("unroll") for (int _i = 0; _i < 2; ++_i) { const int _r0 = Rr[_i], _r1 = HALF + Rr[_i]; \
        const int _t0 = (_r0 < (u).nvalid) ? ((u).gl[_r0] >> 1) : 0, _t1 = (_r1 < (u).nvalid) ? ((u).gl[_r1] >> 1) : 0; \
        o0[_i] = (unsigned)_t0 * (unsigned)lda + (unsigned)Cb[_i]; o1[_i] = (unsigned)_t1 * (unsigned)lda + (unsigned)Cb[_i]; } } while (0)
    GU cur, nxt; int ui = 0;
    if (!S.next(0, cur)) return;
    f32x4 acc[2][2][4][2];
#pragma unroll
    for (int a = 0; a < 2; ++a)
#pragma unroll
        for (int b = 0; b < 2; ++b)
#pragma unroll
            for (int m = 0; m < 4; ++m)
#pragma unroll
                for (int n = 0; n < 2; ++n) acc[a][b][m][n] = (f32x4){0.f, 0.f, 0.f, 0.f};
    bf16x8 At[4][2], B0[2][2], B1[2][2];
    unsigned gA0[2] = {0u, 0u}, gA1[2] = {0u, 0u};
    if constexpr (GATHER) PG8_GOFF(cur, gA0, gA1);
    const char* cA = cur.A; const char* cB = cur.B;
    PG8_STAGE_B(0, 0, cB); PG8_STAGE_B(0, 1, cB); PG8_STAGE_A(0, 0, cA); PG8_STAGE_A(0, 1, cA);
    if (wr == 1) PG8_BAR;
    PG8_WAIT_V(2); PG8_BAR;
    PG8_STAGE_B(1, 0, cB + kstep); PG8_STAGE_A(1, 0, cA + kstep); PG8_STAGE_B(1, 1, cB + kstep);
    PG8_WAIT_V(6); PG8_BAR;
    for (;;) {
        const bool has_next = S.next(ui + 1, nxt);
        int nid[2][2] = {{0, 0}, {0, 0}};
        if constexpr (GATHER) { if (has_next) {
#pragma unroll
            for (int _i = 0; _i < 2; ++_i) { const int _r0 = Rr[_i], _r1 = HALF + Rr[_i]; nid[0][_i] = nxt.gl[_r0 < nxt.nvalid ? _r0 : 0]; nid[1][_i] = nxt.gl[_r1 < nxt.nvalid ? _r1 : 0]; } } }
        const char* nA = has_next ? nxt.A : cA; const char* nB = has_next ? nxt.B : cB;
        const int nt = F8 ? cur.K / 128 : cur.K / BK;
        for (int t = 0; t < nt; t += 2) {
            const bool last = (t == nt - 2);
            const char* a1 = cA + (size_t)(t + 1) * kstep;
            const char* a2 = last ? nA : cA + (size_t)(t + 2) * kstep; const char* b2 = last ? nB : cB + (size_t)(t + 2) * kstep;
            const char* a3 = a2 + kstep; const char* b3 = b2 + kstep;
            PG8_LDB(B0, 0, 0); PG8_LDB(B1, 0, 1); PG8_SCHED; PG8_LDA(At, 0, 0); PG8_STAGE_A(1, 1, a1);
            if constexpr (GATHER) { if (last && has_next) {
#pragma unroll
                for (int _i = 0; _i < 2; ++_i) { const int _r0 = Rr[_i], _r1 = HALF + Rr[_i];
                    const int _t0 = (_r0 < nxt.nvalid) ? (nid[0][_i] >> 1) : 0, _t1 = (_r1 < nxt.nvalid) ? (nid[1][_i] >> 1) : 0;
                    gA0[_i] = (unsigned)_t0 * (unsigned)lda + (unsigned)Cb[_i]; gA1[_i] = (unsigned)_t1 * (unsigned)lda + (unsigned)Cb[_i]; } } }
            PG8_WAIT_V(8); PG8_WAIT_L(0); PG8_BAR; PG8_MMA(0, 0, At, B0); PG8_MMA(0, 1, At, B1); PG8_BAR; PG8_SCHED;
            PG8_LDA(At, 0, 1); PG8_STAGE_B(0, 0, b2); PG8_STAGE_B(0, 1, b2); PG8_STAGE_A(0, 0, a2);
            PG8_WAIT_V(8); PG8_WAIT_L(0); PG8_BAR; PG8_MMA(1, 0, At, B0); PG8_MMA(1, 1, At, B1); PG8_BAR; PG8_SCHED;
            PG8_LDB(B0, 1, 0); PG8_LDB(B1, 1, 1); PG8_SCHED; PG8_LDA(At, 1, 0); PG8_STAGE_A(0, 1, a2);
            PG8_WAIT_V(8); PG8_WAIT_L(0); PG8_BAR; PG8_MMA(0, 0, At, B0); PG8_MMA(0, 1, At, B1); PG8_BAR; PG8_SCHED;
            PG8_LDA(At, 1, 1); PG8_STAGE_B(1, 0, b3); PG8_STAGE_B(1, 1, b3); PG8_STAGE_A(1, 0, a3);
            PG8_WAIT_V(8); PG8_WAIT_L(0); PG8_BAR; PG8_MMA(1, 0, At, B0); PG8_MMA(1, 1, At, B1); PG8_BAR; PG8_SCHED;
        }
        if (wr == 0) PG8_BAR;
        if constexpr (F8) { asm volatile("s_nop 15\n\ts_nop 15" ::: "memory"); PG8_SCHED; }
        E(acc, cur, wr, wc, fr, fq);
        if (!has_next) break;
#pragma unroll
        for (int a = 0; a < 2; ++a)
#pragma unroll
            for (int b = 0; b < 2; ++b)
#pragma unroll
                for (int m = 0; m < 4; ++m)
#pragma unroll
                    for (int n = 0; n < 2; ++n) acc[a][b][m][n] = (f32x4){0.f, 0.f, 0.f, 0.f};
        cur = nxt; cA = nA; cB = nB; ++ui;
        if (wr == 1) PG8_BAR;
    }
    PG8_WAIT_V(0);
    PG8_BAR;
#undef PG8_SA
#undef PG8_SB
#undef PG8_STAGE
#undef PG8_STAGE1
#undef PG8_STAGE_A
#undef PG8_STAGE_B
#undef PG8_LDA
#undef PG8_LDB
#undef PG8_MMA
#undef PG8_J8
#undef PG8_WAIT_V
#undef PG8_WAIT_L
#undef PG8_BAR
#undef PG8_SCHED
#undef PG8_GOFF
}
}

struct Args { const float* in[40]; float* out; unsigned char* ws; int ph_lo, ph_hi; };
typedef const __attribute__((address_space(4))) Args* ArgsP;
enum InIdx { I_X = 0, I_C, I_CTX, I_CCTX, I_ADAW, I_ADAB, I_WIN, I_GMLNG, I_GMLNB, I_GMWS, I_GMBS, I_HYCW, I_HYCB, I_HYW1, I_HYB1, I_HYW2, I_HYB2, I_HYW3, I_HYB3, I_HYSKIP,
             I_LQ1, I_LK1, I_LQ2, I_LK2, I_DANG, I_PA, I_PB, I_PC, I_WOUT, I_LN1G, I_LN1B, I_MOEWG, I_MOEBG, I_MOEWE, I_MOEBE, I_EXG, I_EXU, I_EXD, I_LN2G, I_LN2B };

struct Frame {
    LAS unsigned char* lds;
    volatile LAS unsigned* MISC;
    unsigned* ctl;
    int tid, lane, wave, G, bid, gw, NGW;
    unsigned char* ws;
};

template <int MODE>
__device__ __forceinline__ void cvt_item(const float* __restrict__ W, int N, bf16_t* __restrict__ WT, int ldk, int item, int lane) {
    const int nblk = N >> 6, kb = item / nblk, nb = item - kb * nblk, n = nb * 64 + lane, k0 = kb * 64;
    int row = n; if (MODE == 1) row = 8 * (n >> 2) + (n & 3); if (MODE == 2) row = 8 * (n >> 2) + 4 + (n & 3);
    const float* src = W + (size_t)k0 * N + n;
    bf16_t* dst = WT + (size_t)row * ldk + k0;
#pragma unroll 1
    for (int q = 0; q < 8; ++q) {
        float v[8];
#pragma unroll
        for (int j = 0; j < 8; ++j) v[j] = src[(size_t)(q * 8 + j) * N];
        u32x4 o; o.x = pk2(v[0], v[1]); o.y = pk2(v[2], v[3]); o.z = pk2(v[4], v[5]); o.w = pk2(v[6], v[7]);
        *(u32x4*)(dst + q * 8) = o;
    }
}

template <int MODE, bool F8W = false>
__device__ __forceinline__ void tr_item(const float* __restrict__ W, int N, bf16_t* __restrict__ WT, int ldk, LAS float* scr, int item, int lane, int nblk = 0) {
    if (nblk == 0) nblk = N >> 5;
    const int kb = item / nblk, nb = item - kb * nblk, k0 = 64 * kb, n0 = 32 * nb;
    const float* src = W + (size_t)k0 * N + n0 + (lane & 31) + (size_t)(lane >> 5) * N;
#pragma unroll 8
    for (int i = 0; i < 32; ++i) scr[(2 * i + (lane >> 5)) * 33 + (lane & 31)] = src[(size_t)(2 * i) * N];
    asm volatile("s_waitcnt lgkmcnt(0)" ::: "memory");
    const int c = lane & 7;
#pragma unroll
    for (int j = 0; j < 4; ++j) { const int n = n0 + (lane >> 3) + 8 * j; const LAS float* s = scr + (8 * c) * 33 + (lane >> 3) + 8 * j;
        int row = n; if (MODE == 1) row = 8 * (n >> 2) + (n & 3); if (MODE == 2) row = 8 * (n >> 2) + 4 + (n & 3);
        if constexpr (F8W) { u32x2 o; o.x = pk4_fp8(s[0 * 33] * W8S, s[1 * 33] * W8S, s[2 * 33] * W8S, s[3 * 33] * W8S); o.y = pk4_fp8(s[4 * 33] * W8S, s[5 * 33] * W8S, s[6 * 33] * W8S, s[7 * 33] * W8S);
            *(u32x2*)((unsigned char*)WT + (size_t)row * ldk + k0 + 8 * c) = o; }
        else { u32x4 o; o.x = pk2(s[0 * 33], s[1 * 33]); o.y = pk2(s[2 * 33], s[3 * 33]); o.z = pk2(s[4 * 33], s[5 * 33]); o.w = pk2(s[6 * 33], s[7 * 33]);
            *(u32x4*)(WT + (size_t)row * ldk + k0 + 8 * c) = o; } }
    asm volatile("s_waitcnt lgkmcnt(0)" ::: "memory");
}

template <int MODE, bool F8W>
__device__ __forceinline__ void tr_item2(const float* __restrict__ W, int N, bf16_t* __restrict__ WT, int ldk, LAS float* scr, int item, int lane) {
    const int nblk = N >> 5;
    float v[2][32];
#pragma unroll
    for (int t = 0; t < 2; ++t) { const int it = item + t, kb = it / nblk, nb = it - kb * nblk;
        const float* src = W + (size_t)(64 * kb) * N + 32 * nb + (lane & 31) + (size_t)(lane >> 5) * N;
#pragma unroll
        for (int i = 0; i < 32; ++i) v[t][i] = src[(size_t)(2 * i) * N]; }
#pragma unroll
    for (int t = 0; t < 2; ++t) { const int it = item + t, kb = it / nblk, nb = it - kb * nblk, k0 = 64 * kb, n0 = 32 * nb;
#pragma unroll
        for (int i = 0; i < 32; ++i) scr[(2 * i + (lane >> 5)) * 33 + (lane & 31)] = v[t][i];
        asm volatile("s_waitcnt lgkmcnt(0)" ::: "memory");
        const int c = lane & 7;
#pragma unroll
        for (int j = 0; j < 4; ++j) { const int n = n0 + (lane >> 3) + 8 * j; const LAS float* s = scr + (8 * c) * 33 + (lane >> 3) + 8 * j;
            int row = n; if (MODE == 1) row = 8 * (n >> 2) + (n & 3); if (MODE == 2) row = 8 * (n >> 2) + 4 + (n & 3);
            if constexpr (F8W) { u32x2 o; o.x = pk4_fp8(s[0 * 33] * W8S, s[1 * 33] * W8S, s[2 * 33] * W8S, s[3 * 33] * W8S); o.y = pk4_fp8(s[4 * 33] * W8S, s[5 * 33] * W8S, s[6 * 33] * W8S, s[7 * 33] * W8S);
                *(u32x2*)((unsigned char*)WT + (size_t)row * ldk + k0 + 8 * c) = o; }
            else { u32x4 o; o.x = pk2(s[0 * 33], s[1 * 33]); o.y = pk2(s[2 * 33], s[3 * 33]); o.z = pk2(s[4 * 33], s[5 * 33]); o.w = pk2(s[6 * 33], s[7 * 33]);
                *(u32x4*)(WT + (size_t)row * ldk + k0 + 8 * c) = o; } }
        asm volatile("s_waitcnt lgkmcnt(0)" ::: "memory"); }
}

__device__ __forceinline__ void p0a_prologue(Frame& F, ArgsP a) {
    {
        constexpr int I_WIN_ = 16 * 184, I_PA_ = 4 * 32, I_PC_ = 8 * 32, I_WO_ = 16 * 32, PER = I_WIN_ + 2 * I_PA_ + I_PC_ + I_WO_;
        LAS float* scr = (LAS float*)(F.lds + F.wave * 8448);
        for (int it = F.gw; it < 2 * PER; it += F.NGW) {
            const int l = it / PER; int r = it - l * PER;
            bf16_t* wsl = (bf16_t*)(F.ws + WS_WS + (size_t)l * WSL);
            if (r < I_WIN_) { tr_item<0>(a->in[I_WIN] + (size_t)l * D * NIN, NIN, wsl, D, scr, r, F.lane); continue; } r -= I_WIN_;
            bf16_t* pt = wsl + 6 * MiB;
            if (r < I_PA_) { tr_item<0>(a->in[I_PA] + (size_t)l * 256 * D, D, pt, D, scr, r, F.lane); continue; } r -= I_PA_;
            if (r < I_PA_) { tr_item<0>(a->in[I_PB] + (size_t)l * 256 * D, D, pt + (size_t)D * D, D, scr, r, F.lane); continue; } r -= I_PA_;
            if (r < I_PC_) { tr_item<0>(a->in[I_PC] + (size_t)l * 512 * D, D, pt + (size_t)2 * D * D, D, scr, r, F.lane); continue; } r -= I_PC_;
            tr_item<0>(a->in[I_WOUT] + (size_t)l * D * D, D, wsl + 9 * MiB, D, scr, r, F.lane);
        }
        __syncthreads();
    }
    {
        LAS float* s = (LAS float*)F.lds;
        float* modp = (float*)(F.ws + WS_MODP);
        for (int u = F.bid; u < 192; u += F.G) {
            const int cb = u % 24, kc = u / 24, n = cb * 512 + F.tid, l = n / 6144, col = n - l * 6144;
            __syncthreads();
            for (int i = F.tid; i < 33 * 128; i += NTHREADS) { const int r = i >> 7, k = i & 127; const float c = (r < 32) ? a->in[I_C][r * D + kc * 128 + k] : a->in[I_CCTX][kc * 128 + k];
                s[i] = c * sigmoidf_(c); }
            __syncthreads();
            float acc[33];
#pragma unroll
            for (int r = 0; r < 33; ++r) acc[r] = 0.f;
            const float* w = a->in[I_ADAW] + ((size_t)l * D + kc * 128) * 6144 + col;
            for (int k = 0; k < 128; k += 4) {
                const float w0 = w[(size_t)k * 6144], w1 = w[(size_t)(k + 1) * 6144], w2 = w[(size_t)(k + 2) * 6144], w3 = w[(size_t)(k + 3) * 6144];
#pragma unroll
                for (int r = 0; r < 33; ++r) { const f32x4 sv = *(const LAS f32x4*)(s + r * 128 + k); acc[r] += sv.x * w0 + sv.y * w1 + sv.z * w2 + sv.w * w3; }
            }
#pragma unroll
            for (int r = 0; r < 33; ++r) modp[((size_t)(kc * 2 + l) * 33 + r) * 6144 + col] = acc[r];
        }
        __syncthreads();
    }
    {
        float* HF = (float*)(F.ws + WS_HF);
        for (int p = F.gw; p < 4096 + 256; p += F.NGW) {
            const bool isc = p >= 4096; const int l = isc ? 0 : (p >> 11), d = isc ? (p - 4096) : (p & 2047), L = isc ? 256 : 2048;
            const float t = (float)d / (float)(L - 1), w = 6.283185307179586f * (float)d / (float)L;
            const int lane = F.lane;
            float emb = 0.f;
            if (lane == 0) emb = t;
            else if (lane <= 32) { const int j = (lane - 1) & 15; const float f = 1e-4f + (float)j * ((15.0f - 1e-4f) / 15.0f); const float ang = f * w; emb = (lane <= 16) ? cosf(ang) : -sinf(ang); }
            const float* w1 = a->in[I_HYW1] + (size_t)l * 33 * 64; const float* w2 = a->in[I_HYW2] + (size_t)l * 64 * 64; const float* w3 = a->in[I_HYW3] + (size_t)l * 64 * 512;
            float z = a->in[I_HYB1][l * 64 + lane];
            for (int i = 0; i < 33; ++i) z += __shfl(emb, i) * w1[i * 64 + lane];
            const float h1 = sinf(z);
            z = a->in[I_HYB2][l * 64 + lane];
            for (int i = 0; i < 64; ++i) z += __shfl(h1, i) * w2[i * 64 + lane];
            const float h2 = sinf(z);
            float o[8];
#pragma unroll
            for (int m = 0; m < 8; ++m) o[m] = a->in[I_HYB3][l * 512 + lane + 64 * m];
            for (int i = 0; i < 64; ++i) { const float hv = __shfl(h2, i);
#pragma unroll
                for (int m = 0; m < 8; ++m) o[m] += hv * w3[i * 512 + lane + 64 * m]; }
            float* dst = (isc ? (HF + (size_t)2 * 2048 * 512) : (HF + (size_t)l * 2048 * 512)) + d;
            const float mind = -3.0701134573253945f, maxd = -15.350567286626973f;
#pragma unroll
            for (int m = 0; m < 8; ++m) { const int n = lane + 64 * m, c = n & 255; const float delta = fabsf(mind + (float)c * ((maxd - mind) / 255.0f));
                dst[(size_t)n * L] = o[m] * (expf(-t * delta) + 0.05f); }
        }
    }
    {
        const float* src = a->in[I_GMWS]; unsigned* dst = (unsigned*)(F.ws + WS_WSB);
        for (int i = F.bid * NTHREADS + F.tid; i < 2 * 4 * 128 * 128 / 2; i += F.G * NTHREADS) dst[i] = pk2(src[2 * i], src[2 * i + 1]);
    }
    {
        float* COS = (float*)(F.ws + WS_ROPE); float* SIN = COS + 65536;
        for (int e = F.bid * NTHREADS + F.tid; e < 65536; e += F.G * NTHREADS) {
            const int t = e >> 5, ax = (e >> 4) & 1, i = e & 15; const float pos = (float)(ax ? (t & 63) : (t >> 6));
            const float inv = powf(10000.0f, -(float)i / 16.0f), ang = pos * inv;
            COS[e] = cosf(ang); SIN[e] = sinf(ang);
        }
    }
}

__device__ __forceinline__ void p0b_mod(Frame& F, ArgsP a) {
    const float* modp = (const float*)(F.ws + WS_MODP); float* mod = (float*)(F.ws + WS_MOD);
    for (int i = F.bid * NTHREADS + F.tid; i < 2 * 33 * 6144; i += F.G * NTHREADS) {
        const int l = i / (33 * 6144), rem = i - l * 33 * 6144, r = rem / 6144, col = rem - r * 6144;
        float s = a->in[I_ADAB][l * 6144 + col];
#pragma unroll
        for (int kc = 0; kc < 8; ++kc) s += modp[((size_t)(kc * 2 + l) * 33 + r) * 6144 + col];
        mod[i] = s;
    }
}

__device__ __forceinline__ int mod_row(int row) { return row < TL ? (row >> 11) : 32; }

__device__ __forceinline__ void phase_modulate0(Frame& F, ArgsP a) {
    const float* mod = (const float*)(F.ws + WS_MOD); bf16_t* HB = (bf16_t*)(F.ws + WS_HB);
    for (int row0 = F.gw; row0 < TA; row0 += 4 * F.NGW) {
        f32x4 xv[4][4];
#pragma unroll
        for (int q = 0; q < 4; ++q) { const int row = row0 + q * F.NGW; const float* src = row < TL ? a->in[I_X] + (size_t)row * D : a->in[I_CTX] + (size_t)(row - TL) * D;
#pragma unroll
            for (int j = 0; j < 4; ++j) xv[q][j] = *(const f32x4*)(src + 4 * F.lane + 256 * j); }
#pragma unroll
        for (int q = 0; q < 4; ++q) { const int row = row0 + q * F.NGW; const float* m = mod + (size_t)mod_row(row) * 6144;
            u32x2* dst = (u32x2*)(HB + (size_t)row * D);
#pragma unroll
            for (int j = 0; j < 4; ++j) { const int c = 4 * F.lane + 256 * j; const f32x4 x = xv[q][j], sh = *(const f32x4*)(m + c), sc = *(const f32x4*)(m + 1024 + c);
                const float h0 = x.x * (1.f + sc.x) + sh.x, h1 = x.y * (1.f + sc.y) + sh.y, h2 = x.z * (1.f + sc.z) + sh.z, h3 = x.w * (1.f + sc.w) + sh.w;
                u32x2 o; o.x = pk2(h0, h1); o.y = pk2(h2, h3); dst[F.lane + 64 * j] = o; } }
    }
}

struct SchedIn {
    int G, c, nreg, nctx; const char* A; const char* B;
    int nM;
    __device__ __forceinline__ bool next(int i, pg8::GU& u) const {
        const int L = i * G + c; if (L >= nreg + nctx) return false;
        int pm, pn;
        if (L < nreg) pg8::grid_order(L, nM, 11, pm, pn);
        else { const int j = L - nreg; pm = 256 + (j >> 2); pn = 7 + (j & 3); }
        u.A = A + (size_t)pm * 256 * 2048; u.B = B + (size_t)pn * 256 * 2048; u.gl = nullptr; u.K = 1024; u.kind = 0; u.pm = pm; u.pn = pn; u.e = 0; u.nvalid = 256;
        return true;
    }
};
struct EpiIn {
    bf16_t *ZG, *ZH, *Q, *K, *V; const float* COS;
    __device__ __forceinline__ void rope_store(const f32x4 (&acc)[2][2][4][2], const pg8::GU& u, int wr, int wc, int fr, int fq, bf16_t* base, int colt, float sc) const {
        const int row0 = u.pm * 256 + wr * 64 + fr, col0 = colt + wc * 32 + 8 * fq;
        const float sgn = (fq < 2) ? -1.0f : 1.0f; const bool lowhalf = fq < 2;
        const float* SIN = COS + 65536; const int toff = (wc & 1) * 16 + 8 * (fq & 1);
#pragma unroll
        for (int ai = 0; ai < 2; ++ai)
#pragma unroll
            for (int m = 0; m < 4; ++m) { const int row = row0 + ai * 128 + m * 16, t = row & (SEQ - 1);
                const f32x4 c0 = *(const f32x4*)(COS + t * 32 + toff), c1 = *(const f32x4*)(COS + t * 32 + toff + 4), s0 = *(const f32x4*)(SIN + t * 32 + toff) * sgn, s1 = *(const f32x4*)(SIN + t * 32 + toff + 4) * sgn;
#pragma unroll
                for (int bj = 0; bj < 2; ++bj) { const f32x4 v0 = acc[ai][bj][m][0], v1 = acc[ai][bj][m][1]; f32x4 p0, p1;
#pragma unroll
                    for (int j = 0; j < 4; ++j) {
                        auto ra = __builtin_amdgcn_permlane32_swap(__float_as_uint(v0[j]), __float_as_uint(v0[j]), false, false); p0[j] = __uint_as_float(lowhalf ? ra[1] : ra[0]);
                        auto rb = __builtin_amdgcn_permlane32_swap(__float_as_uint(v1[j]), __float_as_uint(v1[j]), false, false); p1[j] = __uint_as_float(lowhalf ? rb[1] : rb[0]); }
                    const f32x4 o0 = (v0 * c0 + p0 * s0) * sc, o1 = (v1 * c1 + p1 * s1) * sc;
                    u32x4 w; w.x = pk2(o0[0], o0[1]); w.y = pk2(o0[2], o0[3]); w.z = pk2(o1[0], o1[1]); w.w = pk2(o1[2], o1[3]);
                    *(u32x4*)(base + (size_t)row * 512 + col0 + bj * 128) = w; } }
    }
    __device__ __forceinline__ void operator()(const f32x4 (&acc)[2][2][4][2], const pg8::GU& u, int wr, int wc, int fr, int fq) const {
        const int pn = u.pn; bf16_t* base; int ldc, colt, act = 0; float sc = 1.f;
        if (MK_ROPE_EPI && pn >= 5 && pn < 9 && u.pm < 256) { if (pn < 7) rope_store(acc, u, wr, wc, fr, fq, Q, (pn - 5) * 256, QSCALE); else rope_store(acc, u, wr, wc, fr, fq, K, (pn - 7) * 256, 1.0f); return; }
        if (pn < 2) { base = ZG; ldc = 512; colt = pn * 256; act = 1; }
        else if (pn < 5) { base = ZH; ldc = 768; colt = (pn - 2) * 256; }
        else if (pn < 7) { base = Q; ldc = 512; colt = (pn - 5) * 256; sc = QSCALE; }
        else if (pn < 9) { base = K; ldc = 512; colt = (pn - 7) * 256; }
        else { base = V; ldc = 512; colt = (pn - 9) * 256; }
        const int row0 = u.pm * 256 + wr * 64 + fr, col0 = colt + wc * 32 + 8 * fq;
#pragma unroll
        for (int ai = 0; ai < 2; ++ai)
#pragma unroll
            for (int m = 0; m < 4; ++m) { bf16_t* rowp = base + (size_t)(row0 + ai * 128 + m * 16) * ldc + col0;
#pragma unroll
                for (int bj = 0; bj < 2; ++bj) { f32x4 v0 = acc[ai][bj][m][0], v1 = acc[ai][bj][m][1];
                    if (act) {
#pragma unroll
                        for (int j = 0; j < 4; ++j) { v0[j] = gelu_tanh(v0[j]); v1[j] = gelu_tanh(v1[j]); } }
                    else { v0 = v0 * sc; v1 = v1 * sc; }
                    u32x4 w; w.x = pk2(v0[0], v0[1]); w.y = pk2(v0[2], v0[3]); w.z = pk2(v1[0], v1[1]); w.w = pk2(v1[2], v1[3]);
                    *(u32x4*)(rowp + bj * 128) = w; } }
    }
};

__device__ __forceinline__ void gmlp_unit(Frame& F, ArgsP a, int l, int chunk) {
    const bf16_t* ZG = (const bf16_t*)(F.ws + WS_ZG); bf16_t* YC = (bf16_t*)(F.ws + WS_YCAT);
    LAS bf16_t* vT = (LAS bf16_t*)F.lds;
    const int row0 = chunk * 128, lane = F.lane;
    __syncthreads();
    {
        const f32x4 g = *(const f32x4*)(a->in[I_GMLNG] + l * 256 + 4 * lane), bb = *(const f32x4*)(a->in[I_GMLNB] + l * 256 + 4 * lane);
        u32x2 wv[16];
#pragma unroll
        for (int i = 0; i < 16; ++i) wv[i] = *(const u32x2*)(ZG + (size_t)(row0 + F.wave + 8 * i) * 512 + 256 + 4 * lane);
#pragma unroll
        for (int i0 = 0; i0 < 16; i0 += 4) {
            f32x4 v[4]; float s[4], qq[4];
#pragma unroll
            for (int k = 0; k < 4; ++k) { const u32x2 w = wv[i0 + k]; v[k] = (f32x4){bf_lo(w.x), bf_hi(w.x), bf_lo(w.y), bf_hi(w.y)}; s[k] = (v[k].x + v[k].y) + (v[k].z + v[k].w); }
#pragma unroll
            for (int o = 1; o < 64; o <<= 1)
#pragma unroll
                for (int k = 0; k < 4; ++k) s[k] += __shfl_xor(s[k], o);
#pragma unroll
            for (int k = 0; k < 4; ++k) { v[k] = v[k] - s[k] * (1.f / 256.f); qq[k] = (v[k].x * v[k].x + v[k].y * v[k].y) + (v[k].z * v[k].z + v[k].w * v[k].w); }
#pragma unroll
            for (int o = 1; o < 64; o <<= 1)
#pragma unroll
                for (int k = 0; k < 4; ++k) qq[k] += __shfl_xor(qq[k], o);
#pragma unroll
            for (int k = 0; k < 4; ++k) { const int q = F.wave + 8 * (i0 + k); const float rstd = 1.0f / sqrtf(qq[k] * (1.f / 256.f) + LN_EPS);
                const f32x4 y = v[k] * rstd * g + bb;
                const unsigned p01 = pk2(y.x, y.y), p23 = pk2(y.z, y.w);
                vT[(4 * lane + 0) * 136 + q] = (bf16_t)(p01 & 0xffffu); vT[(4 * lane + 1) * 136 + q] = (bf16_t)(p01 >> 16);
                vT[(4 * lane + 2) * 136 + q] = (bf16_t)(p23 & 0xffffu); vT[(4 * lane + 3) * 136 + q] = (bf16_t)(p23 >> 16); }
        }
    }
    __syncthreads();
    const int g = F.wave >> 1, ct = F.wave & 1, r32 = lane & 31, hi = lane >> 5;
    const bf16_t* wsb = (const bf16_t*)(F.ws + WS_WSB) + ((size_t)(l * 4 + g) * 128 + r32) * 128 + 8 * hi;
    const LAS unsigned char* vb = (const LAS unsigned char*)vT + (g * 64 + ct * 32 + r32) * 272 + 16 * hi;
    f32x16 acc[4];
#pragma unroll
    for (int pt = 0; pt < 4; ++pt) acc[pt] = (f32x16){0.f};
#pragma unroll
    for (int ks = 0; ks < 8; ++ks) { const bf16x8 B = *(const LAS bf16x8*)(vb + 32 * ks);
#pragma unroll
        for (int pt = 0; pt < 4; ++pt) { const bf16x8 A = *(const bf16x8*)(wsb + (size_t)pt * 32 * 128 + 16 * ks); acc[pt] = __builtin_amdgcn_mfma_f32_32x32x16_bf16(A, B, acc[pt], 0, 0, 0); } }
    const int c = g * 64 + ct * 32 + r32;
    const float* bsr = a->in[I_GMBS] + (l * 4 + g) * 128;
    LAS bf16_t* ot = (LAS bf16_t*)(F.lds + 73728);
#pragma unroll
    for (int pt = 0; pt < 4; ++pt)
#pragma unroll
        for (int r = 0; r < 16; ++r) { const int p = 32 * pt + (r & 3) + 8 * (r >> 2) + 4 * hi;
            ot[p * 264 + c] = (bf16_t)(pk2(acc[pt][r] + bsr[p], 0.f) & 0xffffu); }
    __syncthreads();
    for (int it = F.tid; it < 128 * 32; it += NTHREADS) { const int p = it >> 5, c8 = (it & 31) * 8;
        const u32x4 uw = *(const u32x4*)(ZG + (size_t)(row0 + p) * 512 + c8), ow = *(const LAS u32x4*)(ot + p * 264 + c8);
        u32x4 y; y.x = pk2(bf_lo(uw.x) * bf_lo(ow.x), bf_hi(uw.x) * bf_hi(ow.x)); y.y = pk2(bf_lo(uw.y) * bf_lo(ow.y), bf_hi(uw.y) * bf_hi(ow.y));
        y.z = pk2(bf_lo(uw.z) * bf_lo(ow.z), bf_hi(uw.z) * bf_hi(ow.z)); y.w = pk2(bf_lo(uw.w) * bf_lo(ow.w), bf_hi(uw.w) * bf_hi(ow.w));
        *(u32x4*)(YC + (size_t)(row0 + p) * 1024 + c8) = y; }
}

__device__ __forceinline__ void sconv_unit(Frame& F, ArgsP a, int l, int blk) {
    const bf16_t* ZH = (const bf16_t*)(F.ws + WS_ZH); bf16_t* X0 = (bf16_t*)(F.ws + WS_X0); bf16_t* VT = (bf16_t*)(F.ws + WS_VT);
    LAS bf16_t* vt = (LAS bf16_t*)F.lds;
    const int row0 = blk * 128; const bool lat = row0 < TL;
    const int Lseq = lat ? SEQ : CTXL, seq0 = lat ? (row0 & ~(SEQ - 1)) : TL + ((row0 - TL) & ~(CTXL - 1));
    const float* cw = a->in[I_HYCW] + (size_t)l * 3 * 768; const float* cb = a->in[I_HYCB] + (size_t)l * 768;
    __syncthreads();
    const int c = (F.tid & 31) * 8;
    float wt[3][4][8];
#pragma unroll
    for (int part = 0; part < 3; ++part)
#pragma unroll
        for (int k = 0; k < 4; ++k) { const float* s = (k < 3 ? cw + k * 768 : cb) + part * 256 + c; const f32x4 lo = *(const f32x4*)s, hi4 = *(const f32x4*)(s + 4);
#pragma unroll
            for (int j = 0; j < 4; ++j) { wt[part][k][j] = lo[j]; wt[part][k][4 + j] = hi4[j]; } }
    for (int it = F.tid; it < 128 * 32; it += NTHREADS) {
        const int rl = it >> 5, row = row0 + rl;
        const bool hasp = row > seq0, hasn = row < seq0 + Lseq - 1;
        float zc[3][8];
#pragma unroll
        for (int part = 0; part < 3; ++part) {
            const int col = part * 256 + c; const bf16_t* zp = ZH + (size_t)row * 768 + col;
            const u32x4 zero = {0u, 0u, 0u, 0u};
            const u32x4 z1 = *(const u32x4*)zp; const u32x4 z0 = hasp ? *(const u32x4*)(zp - 768) : zero; const u32x4 z2 = hasn ? *(const u32x4*)(zp + 768) : zero;
            const unsigned a0[4] = {z0.x, z0.y, z0.z, z0.w}, a1[4] = {z1.x, z1.y, z1.z, z1.w}, a2[4] = {z2.x, z2.y, z2.z, z2.w};
#pragma unroll
            for (int j = 0; j < 4; ++j) {
                zc[part][2 * j] = bf_lo(a0[j]) * wt[part][0][2 * j] + bf_lo(a1[j]) * wt[part][1][2 * j] + bf_lo(a2[j]) * wt[part][2][2 * j] + wt[part][3][2 * j];
                zc[part][2 * j + 1] = bf_hi(a0[j]) * wt[part][0][2 * j + 1] + bf_hi(a1[j]) * wt[part][1][2 * j + 1] + bf_hi(a2[j]) * wt[part][2][2 * j + 1] + wt[part][3][2 * j + 1];
            }
        }
        u32x4 o; o.x = pk2(zc[0][0], zc[0][1]); o.y = pk2(zc[0][2], zc[0][3]); o.z = pk2(zc[0][4], zc[0][5]); o.w = pk2(zc[0][6], zc[0][7]);
        *(u32x4*)(X0 + (size_t)row * 256 + c) = o;
#pragma unroll
        for (int j = 0; j < 8; ++j) vt[(c + j) * 136 + rl] = (bf16_t)(pk2(zc[2][j] * zc[1][j], 0.f) & 0xffffu);
    }
    __syncthreads();
    const size_t cstride = lat ? (size_t)TL : (size_t)TC; bf16_t* vbase = lat ? VT + row0 : VT + (size_t)256 * TL + (row0 - TL);
    for (int it = F.tid; it < 256 * 16; it += NTHREADS) {
        const int c = it >> 4, ch = it & 15;
        const u32x4 v = *(const LAS u32x4*)(vt + c * 136 + ch * 8);
        *(u32x4*)(vbase + (size_t)c * cstride + ch * 8) = v;
    }
}

__device__ __forceinline__ void rope_unit(Frame& F, int blk, const float sgn = 1.0f) {
    bf16_t* Q = (bf16_t*)(F.ws + WS_Q); bf16_t* K = (bf16_t*)(F.ws + WS_K);
    const float* COS = (const float*)(F.ws + WS_ROPE); const float* SIN = COS + 65536;
    const int row0 = blk * 128;
    for (int it = F.tid; it < 128 * 16; it += NTHREADS) {
        const int rl = it >> 4, which = (it >> 3) & 1, hm = it & 7, row = row0 + rl, t = row & (SEQ - 1);
        bf16_t* p = (which ? K : Q) + (size_t)row * 512 + hm * 64;
#pragma unroll
        for (int ax = 0; ax < 2; ++ax) {
            u32x4 x1[2], x2[2];
            x1[0] = *(const u32x4*)(p + ax * 32); x1[1] = *(const u32x4*)(p + ax * 32 + 8); x2[0] = *(const u32x4*)(p + ax * 32 + 16); x2[1] = *(const u32x4*)(p + ax * 32 + 24);
            const float* cs = COS + t * 32 + ax * 16; const float* sn = SIN + t * 32 + ax * 16;
            u32x4 o1[2], o2[2];
#pragma unroll
            for (int hh = 0; hh < 2; ++hh) {
                const unsigned a[4] = {x1[hh].x, x1[hh].y, x1[hh].z, x1[hh].w}, b[4] = {x2[hh].x, x2[hh].y, x2[hh].z, x2[hh].w}; unsigned r1[4], r2[4];
#pragma unroll
                for (int j = 0; j < 4; ++j) { const int i0 = hh * 8 + 2 * j; const float c0 = cs[i0], s0 = sgn * sn[i0], c1 = cs[i0 + 1], s1 = sgn * sn[i0 + 1];
                    const float a0 = bf_lo(a[j]), a1 = bf_hi(a[j]), b0 = bf_lo(b[j]), b1 = bf_hi(b[j]);
                    r1[j] = pk2(a0 * c0 - b0 * s0, a1 * c1 - b1 * s1); r2[j] = pk2(b0 * c0 + a0 * s0, b1 * c1 + a1 * s1); }
                o1[hh] = (u32x4){r1[0], r1[1], r1[2], r1[3]}; o2[hh] = (u32x4){r2[0], r2[1], r2[2], r2[3]};
            }
            *(u32x4*)(p + ax * 32) = o1[0]; *(u32x4*)(p + ax * 32 + 8) = o1[1]; *(u32x4*)(p + ax * 32 + 16) = o2[0]; *(u32x4*)(p + ax * 32 + 24) = o2[1];
        }
    }
}

constexpr int VX_STRIDE = 4112, PKT_OFF = 32 * VX_STRIDE;
template <int NTW>
__device__ __forceinline__ void conv_unit(Frame& F, ArgsP a, int l, int c, const float* HFsrc, const bf16_t* VTc, bf16_t* YTc) {
    constexpr int Lseq = NTW * 256, NS = Lseq / 16;
    LAS unsigned char* lds = F.lds;
    LAS unsigned* pkt = (LAS unsigned*)(lds + PKT_OFF);
    __syncthreads();
#if MK_DUP == 68 || MK_DUP == 69
    const unsigned tcv0_ = (unsigned)__builtin_amdgcn_s_memrealtime();
#endif
    const float skip = a->in[I_HYSKIP][l * 256 + c];
#pragma unroll 4
    for (int m = F.tid; m < 2 * Lseq; m += NTHREADS) {
        float r[2];
#pragma unroll
        for (int k = 0; k < 2; ++k) { const int d = Lseq - (m + k); const int ad = d < 0 ? -d : d, adc = ad < Lseq ? ad : 0;
            const float v = HFsrc[(size_t)((d < 0 ? 256 : 0) + c) * Lseq + adc]; r[k] = (ad < Lseq) ? v : 0.f; if (d == 0) r[k] += skip; }
        pkt[m] = pk2(r[0], r[1]);
    }
#if MK_DUP == 69
    asm volatile("s_waitcnt vmcnt(0) lgkmcnt(0)" ::: "memory"); if (NTW == 8 && F.tid == 0) F.MISC[110] += (unsigned)__builtin_amdgcn_s_memrealtime() - tcv0_;
#endif
#pragma unroll 8
    for (int it = F.tid; it < 32 * (Lseq / 8); it += NTHREADS) { const int b = it / (Lseq / 8), ch = it % (Lseq / 8);
        *(LAS u32x4*)(lds + b * VX_STRIDE + ch * 16) = *(const u32x4*)(VTc + (size_t)b * Lseq + ch * 8); }
    __syncthreads();
#if MK_DUP == 68
    if (NTW == 8 && F.tid == 0) F.MISC[110] += (unsigned)__builtin_amdgcn_s_memrealtime() - tcv0_;
#endif
    const int i = F.lane & 31, h = F.lane >> 5, w = F.wave;
    f32x16 acc[NTW];
#pragma unroll
    for (int ti = 0; ti < NTW; ++ti) acc[ti] = (f32x16){0.f};
    const LAS unsigned char* bbase = lds + i * VX_STRIDE + h * 16;
    const int dlo = 2 * NTW * w - (NS - 1), dhi = 2 * (NTW * w + NTW - 1);
#define CV_LOAD(AF, BF, DL) do { const int ms_ = Lseq - 16 * (DL) - i + 8 * h; u32x4 af_; af_.x = pkt[ms_]; af_.y = pkt[ms_ + 2]; af_.z = pkt[ms_ + 4]; af_.w = pkt[ms_ + 6]; AF = __builtin_bit_cast(bf16x8, af_); \
        _Pragma("unroll") for (int ti = 0; ti < NTW; ++ti) { const int sj_ = 2 * (NTW * w + ti) - (DL), sjc_ = sj_ < 0 ? 0 : (sj_ >= NS ? NS - 1 : sj_); BF[ti] = *(const LAS bf16x8*)(bbase + sjc_ * 32); } } while (0)
#define CV_MMA(AF, BF, DL) do { _Pragma("unroll") for (int ti = 0; ti < NTW; ++ti) { const int sj_ = 2 * (NTW * w + ti) - (DL); \
        if (sj_ >= 0 && sj_ < NS) acc[ti] = __builtin_amdgcn_mfma_f32_32x32x16_bf16(AF, BF[ti], acc[ti], 0, 0, 0); } } while (0)
    bf16x8 A0, A1, B0[NTW], B1[NTW];
    CV_LOAD(A0, B0, dlo);
    for (int dl = dlo; dl <= dhi; dl += 2) {
        CV_LOAD(A1, B1, dl + 1);
        CV_MMA(A0, B0, dl);
        if (dl + 2 <= dhi) CV_LOAD(A0, B0, dl + 2);
        CV_MMA(A1, B1, dl + 1);
    }
#undef CV_LOAD
#undef CV_MMA
#pragma unroll
    for (int ti = 0; ti < NTW; ++ti)
#pragma unroll
        for (int g = 0; g < 4; ++g) { const int t = 32 * (NTW * w + ti) + 8 * g + 4 * h;
            u32x2 o; o.x = pk2(acc[ti][4 * g], acc[ti][4 * g + 1]); o.y = pk2(acc[ti][4 * g + 2], acc[ti][4 * g + 3]);
            *(u32x2*)(YTc + (size_t)i * Lseq + t) = o; }
}

__device__ __forceinline__ void ytrans_unit(Frame& F, int blk) {
    const bf16_t* YT = (const bf16_t*)(F.ws + WS_YT); const bf16_t* X0 = (const bf16_t*)(F.ws + WS_X0); bf16_t* YC = (bf16_t*)(F.ws + WS_YCAT);
    LAS bf16_t* tl = (LAS bf16_t*)F.lds;
    const int row0 = blk * 128; const bool lat = row0 < TL;
    const size_t cstride = lat ? (size_t)TL : (size_t)TC; const bf16_t* ybase = lat ? YT + row0 : YT + (size_t)256 * TL + (row0 - TL);
    __syncthreads();
    for (int it = F.tid; it < 256 * 16; it += NTHREADS) { const int c = it >> 4, ch = it & 15;
        *(LAS u32x4*)(tl + c * 136 + ch * 8) = *(const u32x4*)(ybase + (size_t)c * cstride + ch * 8); }
    __syncthreads();
    for (int it = F.tid; it < 128 * 32; it += NTHREADS) {
        const int cg = it >> 7, rl = it & 127, row = row0 + rl, c = cg * 8;
        const u32x4 x = *(const u32x4*)(X0 + (size_t)row * 256 + c); const unsigned xs[4] = {x.x, x.y, x.z, x.w}; unsigned o[4];
#pragma unroll
        for (int j = 0; j < 4; ++j) o[j] = pk2(bf1(tl[(c + 2 * j) * 136 + rl]) * bf_lo(xs[j]), bf1(tl[(c + 2 * j + 1) * 136 + rl]) * bf_hi(xs[j]));
        *(u32x4*)(YC + (size_t)row * 1024 + 256 + c) = (u32x4){o[0], o[1], o[2], o[3]};
    }
}

namespace att {
#define KSWZ(row, colB) ((row) * 256 + ((colB) ^ (((row) & 7) << 4)))
__device__ __forceinline__ int crow(int r, int hi) { return (r & 3) + 8 * (r >> 2) + 4 * hi; }
__device__ __forceinline__ int v_st(int k, int c) { const int kk = (k & ~0xC) | ((k & 4) << 1) | ((k & 8) >> 1); return ((kk >> 3) * 4 + (c >> 5)) * 512 + ((kk & 7) * 32 + (c & 31)) * 2; }
__device__ __forceinline__ int v_rd_base(int lane) { return ((lane & 3) << 3) | (((lane >> 2) & 3) << 6) | (((lane >> 4) & 1) << 5) | (((lane >> 5) & 1) << 8); }
constexpr int v_rd_off(int d0, int ks, int half) { return d0 * 512 + ks * 4096 + half * 2048; }
template <int OFF> __device__ __forceinline__ s16x4 tr_read(int vb) {
    s16x4 r; asm volatile("ds_read_b64_tr_b16 %0, %1 offset:%2" : "=&v"(r) : "v"(vb), "i"(OFF) : "memory"); return r;
}
template <int D0> __device__ __forceinline__ void pv_one(f32x16& od, int vb, bf16x8 pa0, bf16x8 pa1, bf16x8 pa2, bf16x8 pa3) {
    const s16x4 l0 = tr_read<v_rd_off(D0, 0, 0)>(vb), h0 = tr_read<v_rd_off(D0, 0, 1)>(vb), l1 = tr_read<v_rd_off(D0, 1, 0)>(vb), h1 = tr_read<v_rd_off(D0, 1, 1)>(vb);
    const s16x4 l2 = tr_read<v_rd_off(D0, 2, 0)>(vb), h2 = tr_read<v_rd_off(D0, 2, 1)>(vb), l3 = tr_read<v_rd_off(D0, 3, 0)>(vb), h3 = tr_read<v_rd_off(D0, 3, 1)>(vb);
    asm volatile("s_waitcnt lgkmcnt(0)" ::: "memory"); __builtin_amdgcn_sched_barrier(0);
#define ATT_PK(L, H) (bf16x8){L[0], L[1], L[2], L[3], H[0], H[1], H[2], H[3]}
    od = __builtin_amdgcn_mfma_f32_32x32x16_bf16(pa0, ATT_PK(l0, h0), od, 0, 0, 0);
    od = __builtin_amdgcn_mfma_f32_32x32x16_bf16(pa1, ATT_PK(l1, h1), od, 0, 0, 0);
    od = __builtin_amdgcn_mfma_f32_32x32x16_bf16(pa2, ATT_PK(l2, h2), od, 0, 0, 0);
    od = __builtin_amdgcn_mfma_f32_32x32x16_bf16(pa3, ATT_PK(l3, h3), od, 0, 0, 0);
#undef ATT_PK
}
__device__ __forceinline__ void qkt2(f32x16& a0, f32x16& a1, f32x16& b0, f32x16& b1, const LAS char* Ks, const bf16x8 (&qr)[8], int r32, int hi) {
    a0 = (f32x16){0.f}; a1 = (f32x16){0.f}; b0 = (f32x16){0.f}; b1 = (f32x16){0.f};
#pragma unroll
    for (int d0 = 0; d0 < 4; ++d0) { const int cb = (d0 * 16 + hi * 8) * 2;
        const bf16x8 k0 = *(const LAS bf16x8*)(Ks + KSWZ(r32, cb)), k1 = *(const LAS bf16x8*)(Ks + KSWZ(32 + r32, cb));
        a0 = __builtin_amdgcn_mfma_f32_32x32x16_bf16(k0, qr[d0], a0, 0, 0, 0); a1 = __builtin_amdgcn_mfma_f32_32x32x16_bf16(k1, qr[d0], a1, 0, 0, 0); }
#pragma unroll
    for (int d0 = 4; d0 < 8; ++d0) { const int cb = (d0 * 16 + hi * 8) * 2;
        const bf16x8 k0 = *(const LAS bf16x8*)(Ks + KSWZ(r32, cb)), k1 = *(const LAS bf16x8*)(Ks + KSWZ(32 + r32, cb));
        b0 = __builtin_amdgcn_mfma_f32_32x32x16_bf16(k0, qr[d0], b0, 0, 0, 0); b1 = __builtin_amdgcn_mfma_f32_32x32x16_bf16(k1, qr[d0], b1, 0, 0, 0); }
}
__device__ __forceinline__ float xhalf_max(float v) { auto rr = __builtin_amdgcn_permlane32_swap(__float_as_uint(v), __float_as_uint(v), false, false); return fmaxf(__uint_as_float(rr[0]), __uint_as_float(rr[1])); }
__device__ __forceinline__ float xhalf_sum(float v) { auto rr = __builtin_amdgcn_permlane32_swap(__float_as_uint(v), __float_as_uint(v), false, false); return __uint_as_float(rr[0]) + __uint_as_float(rr[1]); }
constexpr float THR2 = 8.0f;
__device__ __forceinline__ void partialSM(f32x16& p0, f32x16& p1, float& m_reg, float& mn, float& alpha) {
    float pmax = p0[0];
#pragma unroll
    for (int r = 1; r < 16; ++r) pmax = fmaxf(pmax, p0[r]);
#pragma unroll
    for (int r = 0; r < 16; ++r) pmax = fmaxf(pmax, p1[r]);
    pmax = xhalf_max(pmax);
    if (__builtin_expect(__all(pmax - m_reg <= THR2), 1)) { mn = m_reg; alpha = 1.f; }
    else { mn = fmaxf(m_reg, pmax); alpha = fast_exp2(m_reg - mn); m_reg = mn; }
#pragma unroll
    for (int r = 0; r < 16; ++r) p0[r] -= mn;
#pragma unroll
    for (int r = 0; r < 16; ++r) p1[r] -= mn;
#pragma unroll
    for (int r = 0; r < 16; ++r) p0[r] = fast_exp2(p0[r]);
}
__device__ __forceinline__ void finishSM(f32x16& p0, f32x16& p1, float alpha, float& l_reg, bf16x8& pa0, bf16x8& pa1, bf16x8& pa2, bf16x8& pa3) {
#pragma unroll
    for (int r = 0; r < 16; ++r) p1[r] = fast_exp2(p1[r]);
    float ps = 0.f;
#pragma unroll
    for (int r = 0; r < 16; ++r) ps += p0[r];
#pragma unroll
    for (int r = 0; r < 16; ++r) ps += p1[r];
    ps = xhalf_sum(ps);
    l_reg = l_reg * alpha + ps;
#define ATT_PK4(P, BASE, OUT) do { unsigned x0_ = pk2(P[BASE + 0], P[BASE + 1]), x1_ = pk2(P[BASE + 2], P[BASE + 3]); \
        unsigned y0_ = pk2(P[BASE + 4], P[BASE + 5]), y1_ = pk2(P[BASE + 6], P[BASE + 7]); \
        auto r0_ = __builtin_amdgcn_permlane32_swap(x0_, y0_, false, false); auto r1_ = __builtin_amdgcn_permlane32_swap(x1_, y1_, false, false); \
        u32x4 w_ = {r0_[0], r1_[0], r0_[1], r1_[1]}; OUT = __builtin_bit_cast(bf16x8, w_); } while (0)
    ATT_PK4(p0, 0, pa0); ATT_PK4(p0, 8, pa1); ATT_PK4(p1, 0, pa2); ATT_PK4(p1, 8, pa3);
#undef ATT_PK4
}
__device__ __forceinline__ void qkt1(f32x16& p0, f32x16& p1, const LAS char* Ks, const bf16x8 (&qr)[4], int r32, int hi, int mcb) {
    p0 = (f32x16){0.f}; p1 = (f32x16){0.f};
#pragma unroll
    for (int d0 = 0; d0 < 4; ++d0) { const int cb = mcb + (d0 * 16 + hi * 8) * 2;
        const bf16x8 k0 = *(const LAS bf16x8*)(Ks + KSWZ(r32, cb)), k1 = *(const LAS bf16x8*)(Ks + KSWZ(32 + r32, cb));
        p0 = __builtin_amdgcn_mfma_f32_32x32x16_bf16(k0, qr[d0], p0, 0, 0, 0); p1 = __builtin_amdgcn_mfma_f32_32x32x16_bf16(k1, qr[d0], p1, 0, 0, 0); }
}
template <int KS> __device__ __forceinline__ void pv_step(f32x16 (&o)[4], int vb, bf16x8 pa) {
    const s16x4 l0 = tr_read<v_rd_off(0, KS, 0)>(vb), h0 = tr_read<v_rd_off(0, KS, 1)>(vb), l1 = tr_read<v_rd_off(1, KS, 0)>(vb), h1 = tr_read<v_rd_off(1, KS, 1)>(vb);
    const s16x4 l2 = tr_read<v_rd_off(2, KS, 0)>(vb), h2 = tr_read<v_rd_off(2, KS, 1)>(vb), l3 = tr_read<v_rd_off(3, KS, 0)>(vb), h3 = tr_read<v_rd_off(3, KS, 1)>(vb);
    asm volatile("s_waitcnt lgkmcnt(0)" ::: "memory"); __builtin_amdgcn_sched_barrier(0);
#define ATT_PK(L, H) (bf16x8){L[0], L[1], L[2], L[3], H[0], H[1], H[2], H[3]}
    o[0] = __builtin_amdgcn_mfma_f32_32x32x16_bf16(pa, ATT_PK(l0, h0), o[0], 0, 0, 0);
    o[1] = __builtin_amdgcn_mfma_f32_32x32x16_bf16(pa, ATT_PK(l1, h1), o[1], 0, 0, 0);
    o[2] = __builtin_amdgcn_mfma_f32_32x32x16_bf16(pa, ATT_PK(l2, h2), o[2], 0, 0, 0);
    o[3] = __builtin_amdgcn_mfma_f32_32x32x16_bf16(pa, ATT_PK(l3, h3), o[3], 0, 0, 0);
#undef ATT_PK
}
__device__ __forceinline__ void pv_d0(f32x16 (&o)[4], int vb, bf16x8 pa0, bf16x8 pa1, bf16x8 pa2, bf16x8 pa3) {
    pv_step<0>(o, vb, pa0); pv_step<1>(o, vb, pa1); pv_step<2>(o, vb, pa2); pv_step<3>(o, vb, pa3);
}
}

struct AttnUnit { int qrow0, h, klat0, nlat, kctx0, nt; };

constexpr int ATT_V = 0, ATT_K = 32768, ATT_WS = 65536, ATT_XCH = 65536 + 2048;
__device__ __forceinline__ void attn_unit(Frame& F, ArgsP a, int l, const AttnUnit& U, float lam, float lam_init, const AttnUnit& Un, const bool has_next, const bool first) {
    using namespace att;
    const bf16_t* Qg = (const bf16_t*)(F.ws + WS_Q); const bf16_t* Kg = (const bf16_t*)(F.ws + WS_K); const bf16_t* Vg = (const bf16_t*)(F.ws + WS_V);
    bf16_t* YC = (bf16_t*)(F.ws + WS_YCAT);
    const int tid = F.tid, wid = F.wave, lane = F.lane, r32 = lane & 31, hi = lane >> 5, mp = wid >> 2, wq = wid & 3, mcb = mp * 128;
    LAS char* V_lds = (LAS char*)F.lds + ATT_V; LAS char* K_lds = (LAS char*)F.lds + ATT_K;
    LAS float* wsf = (LAS float*)(F.lds + ATT_WS) + wid * 64; LAS float* li_l = wsf; LAS float* al_l = wsf + 32;
    float m_reg = -1e30f, l_reg = 0.f; f32x16 o[4];
#pragma unroll
    for (int d = 0; d < 4; ++d) o[d] = (f32x16){0.f};
    bf16x8 qr[4];
    { const bf16_t* Qw = Qg + (size_t)(U.qrow0 + wq * 32 + r32) * 512 + U.h * 128 + mp * 64 + hi * 8;
#pragma unroll
      for (int d0 = 0; d0 < 4; ++d0) qr[d0] = *(const bf16x8*)(Qw + d0 * 16); }
    const int sr = tid >> 4, sc = (tid & 15) * 8;
    const int kst0 = KSWZ(sr, sc * 2), kst1 = KSWZ(32 + sr, sc * 2), vst0 = v_st(sr, sc), vst1 = v_st(32 + sr, sc);
    const int hoff = U.h * 128 + sc;
    const int vb0 = (int)(uintptr_t)V_lds + v_rd_base(lane);
#define KROW(j) ((j) < U.nlat ? U.klat0 + 64 * (j) : U.kctx0 + 64 * ((j) - U.nlat))
    bf16x8 s0v0, s0v1, s0k0, s0k1, s1v0, s1v1, s1k0, s1k1;
#define SLOAD0(j) do { const int kr_ = KROW(j); const size_t g0_ = (size_t)(kr_ + sr) * 512 + hoff, g1_ = (size_t)(kr_ + 32 + sr) * 512 + hoff; \
        s0v0 = *(const bf16x8*)(Vg + g0_); s0v1 = *(const bf16x8*)(Vg + g1_); s0k0 = *(const bf16x8*)(Kg + g0_); s0k1 = *(const bf16x8*)(Kg + g1_); } while (0)
#define SLOAD1(j) do { const int kr_ = KROW(j); const size_t g0_ = (size_t)(kr_ + sr) * 512 + hoff, g1_ = (size_t)(kr_ + 32 + sr) * 512 + hoff; \
        s1v0 = *(const bf16x8*)(Vg + g0_); s1v1 = *(const bf16x8*)(Vg + g1_); s1k0 = *(const bf16x8*)(Kg + g0_); s1k1 = *(const bf16x8*)(Kg + g1_); } while (0)
#define SWRITE0(b) do { *(LAS bf16x8*)(V_lds + (b) * 16384 + vst0) = s0v0; *(LAS bf16x8*)(V_lds + (b) * 16384 + vst1) = s0v1; \
        *(LAS bf16x8*)(K_lds + (b) * 16384 + kst0) = s0k0; *(LAS bf16x8*)(K_lds + (b) * 16384 + kst1) = s0k1; } while (0)
#define SWRITE1(b) do { *(LAS bf16x8*)(V_lds + (b) * 16384 + vst0) = s1v0; *(LAS bf16x8*)(V_lds + (b) * 16384 + vst1) = s1v1; \
        *(LAS bf16x8*)(K_lds + (b) * 16384 + kst0) = s1k0; *(LAS bf16x8*)(K_lds + (b) * 16384 + kst1) = s1k1; } while (0)
#define SWAIT() asm volatile("s_waitcnt vmcnt(4)" ::: "memory")
#define SBAR() __builtin_amdgcn_sched_barrier(0)
#define LBAR() do { asm volatile("s_waitcnt lgkmcnt(0)" ::: "memory"); __builtin_amdgcn_s_barrier(); asm volatile("" ::: "memory"); } while (0)
#define RESC(av) do { if (__any((av) < 1.f)) { if (hi == 0) al_l[r32] = (av); asm volatile("s_waitcnt lgkmcnt(0)" ::: "memory"); \
        _Pragma("unroll") for (int d_ = 0; d_ < 4; ++d_) _Pragma("unroll") for (int r_ = 0; r_ < 16; ++r_) o[d_][r_] *= al_l[crow(r_, hi)]; } } while (0)
    f32x16 pA0, pA1, pB0, pB1; float mnA, mnB, alA, alB; bf16x8 pa0, pa1, pa2, pa3; const int NT = U.nt;
    __syncthreads();
    if (first) { SLOAD0(0); SLOAD1(1); asm volatile("s_waitcnt vmcnt(0)" ::: "memory"); SWRITE0(0); SWRITE1(1); __syncthreads(); }
    if (2 < NT) SLOAD0(2);
    qkt1(pA0, pA1, K_lds, qr, r32, hi, mcb); partialSM(pA0, pA1, m_reg, mnA, alA);
    for (int j = 1; j + 1 < NT; j += 2) {
        SBAR(); qkt1(pB0, pB1, K_lds + 16384, qr, r32, hi, mcb);
        finishSM(pA0, pA1, alA, l_reg, pa0, pa1, pa2, pa3); SBAR();
        SLOAD1(j + 2); SBAR();
        pv_d0(o, vb0, pa0, pa1, pa2, pa3); partialSM(pB0, pB1, m_reg, mnB, alB);
        __syncthreads(); SWAIT(); SWRITE0(0);
        RESC(alB); __syncthreads();
        SBAR(); qkt1(pA0, pA1, K_lds, qr, r32, hi, mcb);
        finishSM(pB0, pB1, alB, l_reg, pa0, pa1, pa2, pa3); SBAR();
        if (j + 3 < NT) SLOAD0(j + 3);
        SBAR();
        pv_d0(o, vb0 + 16384, pa0, pa1, pa2, pa3); partialSM(pA0, pA1, m_reg, mnA, alA);
        __syncthreads(); SWAIT(); SWRITE1(1);
        RESC(alA); __syncthreads();
    }
    SBAR(); qkt1(pB0, pB1, K_lds + 16384, qr, r32, hi, mcb);
    finishSM(pA0, pA1, alA, l_reg, pa0, pa1, pa2, pa3); SBAR();
    pv_d0(o, vb0, pa0, pa1, pa2, pa3); partialSM(pB0, pB1, m_reg, mnB, alB);
    __syncthreads(); RESC(alB);
    finishSM(pB0, pB1, alB, l_reg, pa0, pa1, pa2, pa3); SBAR();
    pv_d0(o, vb0 + 16384, pa0, pa1, pa2, pa3);
#undef KROW
#undef SLOAD0
#undef SLOAD1
#undef SWRITE0
#undef SWRITE1
#undef SWAIT
#undef SBAR
#undef LBAR
#undef RESC
#define KROWN(j) ((j) < Un.nlat ? Un.klat0 + 64 * (j) : Un.kctx0 + 64 * ((j) - Un.nlat))
    if (has_next) { const int hoffn = Un.h * 128 + sc;
        { const int kr_ = KROWN(0); const size_t g0_ = (size_t)(kr_ + sr) * 512 + hoffn, g1_ = (size_t)(kr_ + 32 + sr) * 512 + hoffn; s0v0 = *(const bf16x8*)(Vg + g0_); s0v1 = *(const bf16x8*)(Vg + g1_); s0k0 = *(const bf16x8*)(Kg + g0_); s0k1 = *(const bf16x8*)(Kg + g1_); }
        { const int kr_ = KROWN(1); const size_t g0_ = (size_t)(kr_ + sr) * 512 + hoffn, g1_ = (size_t)(kr_ + 32 + sr) * 512 + hoffn; s1v0 = *(const bf16x8*)(Vg + g0_); s1v1 = *(const bf16x8*)(Vg + g1_); s1k0 = *(const bf16x8*)(Kg + g0_); s1k1 = *(const bf16x8*)(Kg + g1_); } }
#undef KROWN
    if (hi == 0) li_l[r32] = l_reg;
    asm volatile("s_waitcnt lgkmcnt(0)" ::: "memory");
    const float fac = mp ? lam : 1.0f;
    float rli[16];
#pragma unroll
    for (int r = 0; r < 16; ++r) rli[r] = fac * fast_rcp(li_l[crow(r, hi)]);
    LAS float* xch = (LAS float*)(F.lds + ATT_XCH) + wq * 4096;
    if (mp == 1) {
#pragma unroll
        for (int r = 0; r < 16; ++r)
#pragma unroll
            for (int d = 0; d < 4; ++d) xch[crow(r, hi) * 128 + 32 * d + r32] = o[d][r] * rli[r];
    }
    __syncthreads();
    if (mp == 0) {
        const float* gn = a->in[I_DANG] + l * 128;
        float gv[4];
#pragma unroll
        for (int d = 0; d < 4; ++d) gv[d] = gn[32 * d + r32] * (1.0f - lam_init);
#pragma unroll
        for (int r = 0; r < 16; ++r) {
            float ov[4];
#pragma unroll
            for (int d = 0; d < 4; ++d) ov[d] = o[d][r] * rli[r] - xch[crow(r, hi) * 128 + 32 * d + r32];
            float ss = (ov[0] * ov[0] + ov[1] * ov[1]) + (ov[2] * ov[2] + ov[3] * ov[3]);
#pragma unroll
            for (int x = 1; x < 32; x <<= 1) ss += __shfl_xor(ss, x);
            const float inv = 1.0f / sqrtf(ss * (1.0f / 128.0f) + LN_EPS);
#pragma unroll
            for (int d = 0; d < 4; ++d) o[d][r] = ov[d] * inv * gv[d];
        }
    }
    if (has_next) { asm volatile("s_waitcnt vmcnt(0)" ::: "memory");
        *(LAS bf16x8*)(V_lds + vst0) = s0v0; *(LAS bf16x8*)(V_lds + vst1) = s0v1; *(LAS bf16x8*)(K_lds + kst0) = s0k0; *(LAS bf16x8*)(K_lds + kst1) = s0k1;
        *(LAS bf16x8*)(V_lds + 16384 + vst0) = s1v0; *(LAS bf16x8*)(V_lds + 16384 + vst1) = s1v1; *(LAS bf16x8*)(K_lds + 16384 + kst0) = s1k0; *(LAS bf16x8*)(K_lds + 16384 + kst1) = s1k1; }
    if (mp == 0) {
#pragma unroll
        for (int r = 0; r < 16; ++r) { bf16_t* yrow = YC + (size_t)(U.qrow0 + wq * 32 + crow(r, hi)) * 1024 + 512 + U.h * 128 + r32;
#pragma unroll
            for (int d = 0; d < 4; ++d) yrow[32 * d] = (bf16_t)(pk2(o[d][r], 0.f) & 0xffffu); }
    }
}
namespace att {
__device__ __forceinline__ void stats(const f32x16& x0, const f32x16& x1, float& m, float& l) {
    float t = x0[0];
#pragma unroll
    for (int r = 1; r < 16; ++r) t = fmaxf(t, x0[r]);
#pragma unroll
    for (int r = 0; r < 16; ++r) t = fmaxf(t, x1[r]);
    t = xhalf_max(t);
    const float mn = fmaxf(m, t);
    float s = 0.f;
#pragma unroll
    for (int r = 0; r < 16; ++r) s += fast_exp2(x0[r] - mn);
#pragma unroll
    for (int r = 0; r < 16; ++r) s += fast_exp2(x1[r] - mn);
    s = xhalf_sum(s);
    l = l * fast_exp2(m - mn) + s; m = mn;
}
}

__device__ __forceinline__ void attn_unit_v1(Frame& F, ArgsP a, int l, const AttnUnit& U, float lam, float lam_init) {
    using namespace att;
    const bf16_t* Qg = (const bf16_t*)(F.ws + WS_Q); const bf16_t* Kg = (const bf16_t*)(F.ws + WS_K); const bf16_t* Vg = (const bf16_t*)(F.ws + WS_V);
    bf16_t* YC = (bf16_t*)(F.ws + WS_YCAT);
    const int tid = F.tid, wid = F.wave, lane = F.lane, r32 = lane & 31, hi = lane >> 5;
    LAS char* K_lds = (LAS char*)F.lds; LAS char* V_lds = (LAS char*)F.lds + 32768;
    bf16x8 qr[8];
    { const bf16_t* Qw = Qg + (size_t)(U.qrow0 + wid * 32 + r32) * 512 + U.h * 128 + hi * 8;
#pragma unroll
      for (int d0 = 0; d0 < 8; ++d0) qr[d0] = *(const bf16x8*)(Qw + d0 * 16); }
    const int sr = tid >> 4, sc = (tid & 15) * 8;
    const int kst0 = KSWZ(sr, sc * 2), kst1 = KSWZ(32 + sr, sc * 2), vst0 = v_st(sr, sc), vst1 = v_st(32 + sr, sc);
    const int hoff = U.h * 128 + sc;
#define KROW(j) ((j) < U.nlat ? U.klat0 + 64 * (j) : U.kctx0 + 64 * ((j) - U.nlat))
    float m0 = -1e30f, l0 = 0.f, m1 = -1e30f, l1 = 0.f;
    bf16x8 ks0, ks1, vs0, vs1;
    __syncthreads();
    { const int kr = KROW(0); ks0 = *(const bf16x8*)(Kg + (size_t)(kr + sr) * 512 + hoff); ks1 = *(const bf16x8*)(Kg + (size_t)(kr + 32 + sr) * 512 + hoff); }
    *(LAS bf16x8*)(K_lds + kst0) = ks0; *(LAS bf16x8*)(K_lds + kst1) = ks1;
    __syncthreads();
    for (int j = 0; j < U.nt; ++j) {
        const bool more = j + 1 < U.nt;
        if (more) { const int kr = KROW(j + 1); ks0 = *(const bf16x8*)(Kg + (size_t)(kr + sr) * 512 + hoff); ks1 = *(const bf16x8*)(Kg + (size_t)(kr + 32 + sr) * 512 + hoff); }
        f32x16 a0, a1, b0, b1;
        qkt2(a0, a1, b0, b1, K_lds + (j & 1) * 16384, qr, r32, hi);
        stats(a0, a1, m0, l0); stats(b0, b1, m1, l1);
        if (more) { LAS char* kb = K_lds + ((j + 1) & 1) * 16384; *(LAS bf16x8*)(kb + kst0) = ks0; *(LAS bf16x8*)(kb + kst1) = ks1; }
        __syncthreads();
    }
    const float c0 = 1.0f / l0, c1 = lam / l1;
    f32x16 o[4];
#pragma unroll
    for (int d = 0; d < 4; ++d) o[d] = (f32x16){0.f};
    const int vb0 = (int)(uintptr_t)V_lds + v_rd_base(lane);
    { const int kr = KROW(0); const size_t g0 = (size_t)(kr + sr) * 512 + hoff, g1 = (size_t)(kr + 32 + sr) * 512 + hoff;
      ks0 = *(const bf16x8*)(Kg + g0); ks1 = *(const bf16x8*)(Kg + g1); vs0 = *(const bf16x8*)(Vg + g0); vs1 = *(const bf16x8*)(Vg + g1); }
    *(LAS bf16x8*)(K_lds + kst0) = ks0; *(LAS bf16x8*)(K_lds + kst1) = ks1; *(LAS bf16x8*)(V_lds + vst0) = vs0; *(LAS bf16x8*)(V_lds + vst1) = vs1;
    __syncthreads();
    for (int j = 0; j < U.nt; ++j) {
        const bool more = j + 1 < U.nt;
        if (more) { const int kr = KROW(j + 1); const size_t g0 = (size_t)(kr + sr) * 512 + hoff, g1 = (size_t)(kr + 32 + sr) * 512 + hoff;
            ks0 = *(const bf16x8*)(Kg + g0); ks1 = *(const bf16x8*)(Kg + g1); vs0 = *(const bf16x8*)(Vg + g0); vs1 = *(const bf16x8*)(Vg + g1); }
        f32x16 a0, a1, b0, b1;
        qkt2(a0, a1, b0, b1, K_lds + (j & 1) * 16384, qr, r32, hi);
#pragma unroll
        for (int r = 0; r < 16; ++r) { a0[r] = fast_exp2(a0[r] - m0) * c0 - fast_exp2(b0[r] - m1) * c1; a1[r] = fast_exp2(a1[r] - m0) * c0 - fast_exp2(b1[r] - m1) * c1; }
        bf16x8 pa0, pa1, pa2, pa3;
#define ATT_PK4(P, BASE, OUT) do { unsigned x0_ = pk2(P[BASE + 0], P[BASE + 1]), x1_ = pk2(P[BASE + 2], P[BASE + 3]); \
            unsigned y0_ = pk2(P[BASE + 4], P[BASE + 5]), y1_ = pk2(P[BASE + 6], P[BASE + 7]); \
            auto r0_ = __builtin_amdgcn_permlane32_swap(x0_, y0_, false, false); auto r1_ = __builtin_amdgcn_permlane32_swap(x1_, y1_, false, false); \
            u32x4 w_ = {r0_[0], r1_[0], r0_[1], r1_[1]}; OUT = __builtin_bit_cast(bf16x8, w_); } while (0)
        ATT_PK4(a0, 0, pa0); ATT_PK4(a0, 8, pa1); ATT_PK4(a1, 0, pa2); ATT_PK4(a1, 8, pa3);
#undef ATT_PK4
        const int vb = vb0 + (j & 1) * 16384;
        pv_one<0>(o[0], vb, pa0, pa1, pa2, pa3); pv_one<1>(o[1], vb, pa0, pa1, pa2, pa3); pv_one<2>(o[2], vb, pa0, pa1, pa2, pa3); pv_one<3>(o[3], vb, pa0, pa1, pa2, pa3);
        if (more) { LAS char* kb = K_lds + ((j + 1) & 1) * 16384; LAS char* vbuf = V_lds + ((j + 1) & 1) * 16384;
            *(LAS bf16x8*)(kb + kst0) = ks0; *(LAS bf16x8*)(kb + kst1) = ks1; *(LAS bf16x8*)(vbuf + vst0) = vs0; *(LAS bf16x8*)(vbuf + vst1) = vs1; }
        __syncthreads();
    }
#undef KROW
    const float* gn = a->in[I_DANG] + l * 128;
    float gv[4];
#pragma unroll
    for (int d = 0; d < 4; ++d) gv[d] = gn[32 * d + r32] * (1.0f - lam_init);
#pragma unroll
    for (int r = 0; r < 16; ++r) {
        float ss = (o[0][r] * o[0][r] + o[1][r] * o[1][r]) + (o[2][r] * o[2][r] + o[3][r] * o[3][r]);
#pragma unroll
        for (int x = 1; x < 32; x <<= 1) ss += __shfl_xor(ss, x);
        const float inv = 1.0f / sqrtf(ss * (1.0f / 128.0f) + LN_EPS);
        bf16_t* yrow = YC + (size_t)(U.qrow0 + wid * 32 + crow(r, hi)) * 1024 + 512 + U.h * 128 + r32;
#pragma unroll
        for (int d = 0; d < 4; ++d) yrow[32 * d] = (bf16_t)(pk2(o[d][r] * inv * gv[d], 0.f) & 0xffffu);
    }
}


struct SchedMerge {
    int G, c, nM; const char *HB, *YCAT, *WinT, *PT;
    __device__ __forceinline__ bool next(int i, pg8::GU& u) const {
        const int tile = i / 6, sub = i - tile * 6, L = tile * G + c; if (L >= nM * 4) return false;
        int pm, pn; pg8::grid_order(L, nM, 4, pm, pn);
        const int br = sub >> 1;
        if (sub & 1) { u.A = HB + (size_t)pm * 256 * 2048; u.B = WinT + (size_t)(OFF_GATE + br * 1024 + pn * 256) * 2048; u.K = 1024; }
        else { u.A = YCAT + (size_t)pm * 256 * 2048 + (br == 0 ? 0 : (br == 1 ? 512 : 1024)); u.B = PT + (size_t)br * 1024 * 2048 + (size_t)pn * 256 * 2048; u.K = (br == 2) ? 512 : 256; }
        u.gl = nullptr; u.kind = sub; u.pm = pm; u.pn = pn; u.e = 0; u.nvalid = 256;
        return true;
    }
};
struct EpiMerge {
    bf16_t* MERGED; bf16_t* PSCR;
    __device__ __forceinline__ void operator()(const f32x4 (&acc)[2][2][4][2], const pg8::GU& u, int wr, int wc, int fr, int fq) const {
        const int sub = u.kind;
        int ln_; asm volatile("v_mbcnt_lo_u32_b32 %0, -1, 0\n\tv_mbcnt_hi_u32_b32 %0, -1, %0" : "=v"(ln_));
        const int rq = wr * 64 + (ln_ & 15), cq = wc * 32 + 8 * (ln_ >> 4);
        const int row0 = u.pm * 256 + rq, col0 = u.pn * 256 + cq;
        const unsigned psoff = (unsigned)(((((rq >> 6) * 4 + (cq >> 5)) * 64 + ((cq >> 3) & 3) * 16 + (rq & 63)) * 16));
#pragma unroll
        for (int ai = 0; ai < 2; ++ai)
#pragma unroll
            for (int m = 0; m < 4; ++m)
#pragma unroll
                for (int bj = 0; bj < 2; ++bj) {
                    const int chunk = (ai * 4 + m) * 2 + bj; const f32x4 v0 = acc[ai][bj][m][0], v1 = acc[ai][bj][m][1];
                    unsigned po = psoff; asm volatile("" : "+v"(po)); po += chunk * 8192; u32x4* ps = (u32x4*)((char*)PSCR + po);
                    if ((sub & 1) == 0) { u32x4 w; w.x = pk2(v0[0], v0[1]); w.y = pk2(v0[2], v0[3]); w.z = pk2(v1[0], v1[1]); w.w = pk2(v1[2], v1[3]); *ps = w; }
                    else {
                        const u32x4 p = *ps; unsigned mo = (unsigned)((row0 * 1024 + col0) * 2); asm volatile("" : "+v"(mo)); mo += (unsigned)(((ai * 128 + m * 16) * 1024 + bj * 128) * 2); u32x4* mp = (u32x4*)((char*)MERGED + mo);
                        float r[8] = {sigmoidf_(v0[0]) * bf_lo(p.x), sigmoidf_(v0[1]) * bf_hi(p.x), sigmoidf_(v0[2]) * bf_lo(p.y), sigmoidf_(v0[3]) * bf_hi(p.y),
                                      sigmoidf_(v1[0]) * bf_lo(p.z), sigmoidf_(v1[1]) * bf_hi(p.z), sigmoidf_(v1[2]) * bf_lo(p.w), sigmoidf_(v1[3]) * bf_hi(p.w)};
                        if (sub != 1) { const u32x4 o = *mp; r[0] += bf_lo(o.x); r[1] += bf_hi(o.x); r[2] += bf_lo(o.y); r[3] += bf_hi(o.y); r[4] += bf_lo(o.z); r[5] += bf_hi(o.z); r[6] += bf_lo(o.w); r[7] += bf_hi(o.w); }
                        u32x4 w; w.x = pk2(r[0], r[1]); w.y = pk2(r[2], r[3]); w.z = pk2(r[4], r[5]); w.w = pk2(r[6], r[7]); *mp = w;
                    }

                }
    }
};

struct SchedGrid {
    int G, c, nM, nN, K; const char *A, *B; size_t astep, bstep;
    __device__ __forceinline__ bool next(int i, pg8::GU& u) const {
        const int L = i * G + c; if (L >= nM * nN) return false;
        int pm, pn; pg8::grid_order(L, nM, nN, pm, pn);
        u.A = A + (size_t)pm * astep; u.B = B + (size_t)pn * bstep; u.gl = nullptr; u.K = K; u.kind = 0; u.pm = pm; u.pn = pn; u.e = 0; u.nvalid = 256;
        return true;
    }
};
struct EpiOut {
    const float* xf; const float* ctxf; const bf16_t* xb; const float* mod; bf16_t* R1;
    __device__ __forceinline__ void operator()(const f32x4 (&acc)[2][2][4][2], const pg8::GU& u, int wr, int wc, int fr, int fq) const {
        const int rowt = u.pm * 256, col0 = u.pn * 256 + wc * 32 + 8 * fq;
        const float* g1 = mod + (size_t)mod_row(rowt) * 6144 + 2048 + col0;
        f32x4 gv[2][2];
#pragma unroll
        for (int bj = 0; bj < 2; ++bj) { gv[bj][0] = *(const f32x4*)(g1 + bj * 128); gv[bj][1] = *(const f32x4*)(g1 + bj * 128 + 4); }
#pragma unroll
        for (int ai = 0; ai < 2; ++ai)
#pragma unroll
            for (int m = 0; m < 4; ++m) { const int row = rowt + wr * 64 + fr + ai * 128 + m * 16;
#pragma unroll
                for (int bj = 0; bj < 2; ++bj) { const int col = col0 + bj * 128; f32x4 x0, x1;
                    if (xb) { const u32x4 w = *(const u32x4*)(xb + (size_t)row * 1024 + col); x0 = (f32x4){bf_lo(w.x), bf_hi(w.x), bf_lo(w.y), bf_hi(w.y)}; x1 = (f32x4){bf_lo(w.z), bf_hi(w.z), bf_lo(w.w), bf_hi(w.w)}; }
                    else { const float* xp = (row < TL) ? xf + (size_t)row * 1024 + col : ctxf + (size_t)(row - TL) * 1024 + col; x0 = *(const f32x4*)xp; x1 = *(const f32x4*)(xp + 4); }
                    const f32x4 r0 = x0 * DN_ALPHA + gv[bj][0] * acc[ai][bj][m][0], r1 = x1 * DN_ALPHA + gv[bj][1] * acc[ai][bj][m][1];
                    u32x4 w; w.x = pk2(r0[0], r0[1]); w.y = pk2(r0[2], r0[3]); w.z = pk2(r1[0], r1[1]); w.w = pk2(r1[2], r1[3]);
                    *(u32x4*)(R1 + (size_t)row * 1024 + col) = w; } }
    }
};

__device__ __forceinline__ void expert_weights_fp8(Frame& F, ArgsP a, int l, int first, int last, int widx, int nw) {
    unsigned char* W1T = F.ws + WS_EW1; unsigned char* W2T = F.ws + WS_EW2;
    LAS float* scr = (LAS float*)(F.lds + F.wave * 8448);
    __syncthreads();
    for (int it2 = first + widx; it2 < last; it2 += nw) {
        const int it = 2 * it2, e = it / 768; int r = it - e * 768; const size_t le = (size_t)l * 32 + e;
        if (r < 256) { tr_item2<1, true>(a->in[I_EXG] + le * 1024 * 512, 512, (bf16_t*)(W1T + (size_t)e * 1024 * 1024), 1024, scr, r, F.lane); continue; } r -= 256;
        if (r < 256) { tr_item2<2, true>(a->in[I_EXU] + le * 1024 * 512, 512, (bf16_t*)(W1T + (size_t)e * 1024 * 1024), 1024, scr, r, F.lane); continue; } r -= 256;
        tr_item2<0, true>(a->in[I_EXD] + le * 512 * 1024, 1024, (bf16_t*)(W2T + (size_t)e * 1024 * 512), 512, scr, r, F.lane);
    }
    __syncthreads();
}
constexpr int WR_STRIDE = 2064;
constexpr int WR_BYTES = 48 * WR_STRIDE, LG_STRIDE = 52;
__device__ __forceinline__ void phase_ln1_router(Frame& F, ArgsP a, int l, int nrows, const int mode, const int cfirst = 0) {
    if (mode & 1) expert_weights_fp8(F, a, l, cfirst, 32 * 384, F.gw, F.NGW);
    if (!(mode & 26)) return;
    if (mode & 24) {
        const float* we = a->in[I_MOEWE] + (size_t)l * 32768; const float* wg = a->in[I_MOEWG] + (size_t)l * 4096;
        f32x4 t[16], tg[2];
#pragma unroll
        for (int i = 0; i < 16; ++i) t[i] = *(const f32x4*)(we + (size_t)(i * NTHREADS + F.tid) * 4);
#pragma unroll
        for (int i = 0; i < 2; ++i) tg[i] = *(const f32x4*)(wg + (size_t)(i * NTHREADS + F.tid) * 4);
#pragma unroll
        for (int i = 0; i < 3; ++i) { if (mode & 16) break; const int ch = i * NTHREADS + F.tid; *(LAS u32x4*)(F.lds + (36 + (ch >> 7)) * WR_STRIDE + (ch & 127) * 16) = (u32x4){0u, 0u, 0u, 0u}; }
#pragma unroll
        for (int i = 0; i < 16; ++i) { const int idx = i * NTHREADS + F.tid, k = idx >> 3, j = idx & 7;
#pragma unroll
            for (int c = 0; c < 4; ++c) *(LAS bf16_t*)(F.lds + (4 + 4 * j + c) * WR_STRIDE + k * 2) = (bf16_t)(pk2(t[i][c], 0.f) & 0xffffu); }
#pragma unroll
        for (int i = 0; i < 2; ++i) { const int k = i * NTHREADS + F.tid;
#pragma unroll
            for (int c = 0; c < 4; ++c) *(LAS bf16_t*)(F.lds + c * WR_STRIDE + k * 2) = (bf16_t)(pk2(tg[i][c], 0.f) & 0xffffu); }
    }
    __syncthreads();
    const float* mod = (const float*)(F.ws + WS_MOD) + (size_t)l * 33 * 6144;
    const bf16_t* R1 = (const bf16_t*)(F.ws + WS_R1); bf16_t* X = (bf16_t*)(F.ws + WS_X); bf16_t* HB = (bf16_t*)(F.ws + WS_HB);
    int* LIST = (int*)(F.ws + WS_LIST); float* WT = (float*)(F.ws + WS_WTS);
    unsigned* cnt = F.ctl + CW_CNT + l * 32 * 64;
    const int lane = F.lane;
    LAS unsigned char* stg = F.lds + 36 * WR_STRIDE + F.wave * (4 * WR_STRIDE);
    LAS float* LG = (mode & 16) ? (LAS float*)stg : (LAS float*)(F.lds + WR_BYTES + F.wave * (16 * LG_STRIDE * 4));
    const float* lng = a->in[I_LN1G] + l * 1024; const float* lnb = a->in[I_LN1B] + l * 1024;
    for (int grp = F.gw; grp < nrows / 16; grp += F.NGW) {
        const int r0 = grp * 16;
        const float* mrow = mod + (size_t)mod_row(r0) * 6144;
        f32x4 lacc[3] = {(f32x4){0.f, 0.f, 0.f, 0.f}, (f32x4){0.f, 0.f, 0.f, 0.f}, (f32x4){0.f, 0.f, 0.f, 0.f}};
        if (mode & 2) {
        u32x4 nw[4][2];
#pragma unroll
        for (int q = 0; q < 4; ++q)
#pragma unroll
            for (int hh = 0; hh < 2; ++hh) nw[q][hh] = *(const u32x4*)(R1 + (size_t)(r0 + q) * 1024 + hh * 512 + 8 * lane);
#pragma unroll 1
        for (int rr = 0; rr < 16; rr += 4) {
            float v[4][16];
#pragma unroll
            for (int q = 0; q < 4; ++q)
#pragma unroll
                for (int hh = 0; hh < 2; ++hh) { const u32x4 w = nw[q][hh];
                    v[q][hh * 8 + 0] = bf_lo(w.x); v[q][hh * 8 + 1] = bf_hi(w.x); v[q][hh * 8 + 2] = bf_lo(w.y); v[q][hh * 8 + 3] = bf_hi(w.y); v[q][hh * 8 + 4] = bf_lo(w.z); v[q][hh * 8 + 5] = bf_hi(w.z); v[q][hh * 8 + 6] = bf_lo(w.w); v[q][hh * 8 + 7] = bf_hi(w.w); }
            if (rr + 4 < 16) {
#pragma unroll
                for (int q = 0; q < 4; ++q)
#pragma unroll
                    for (int hh = 0; hh < 2; ++hh) nw[q][hh] = *(const u32x4*)(R1 + (size_t)(r0 + rr + 4 + q) * 1024 + hh * 512 + 8 * lane); }
            float s[4], mean[4], qq[4], rstd[4];
#pragma unroll
            for (int q = 0; q < 4; ++q) { s[q] = 0.f;
#pragma unroll
                for (int j = 0; j < 16; ++j) s[q] += v[q][j]; }
#pragma unroll
            for (int o = 1; o < 64; o <<= 1)
#pragma unroll
                for (int q = 0; q < 4; ++q) s[q] += __shfl_xor(s[q], o);
#pragma unroll
            for (int q = 0; q < 4; ++q) { mean[q] = s[q] * (1.f / 1024.f); qq[q] = 0.f;
#pragma unroll
                for (int j = 0; j < 16; ++j) { v[q][j] -= mean[q]; qq[q] += v[q][j] * v[q][j]; } }
#pragma unroll
            for (int o = 1; o < 64; o <<= 1)
#pragma unroll
                for (int q = 0; q < 4; ++q) qq[q] += __shfl_xor(qq[q], o);
#pragma unroll
            for (int q = 0; q < 4; ++q) rstd[q] = 1.0f / sqrtf(qq[q] * (1.f / 1024.f) + LN_EPS);
#pragma unroll
            for (int hh = 0; hh < 2; ++hh) { const int c = hh * 512 + 8 * lane;
                const f32x4 sh0 = *(const f32x4*)(mrow + 3072 + c), sh1 = *(const f32x4*)(mrow + 3072 + c + 4), sc0 = *(const f32x4*)(mrow + 4096 + c), sc1 = *(const f32x4*)(mrow + 4096 + c + 4);
                const f32x4 g0 = *(const f32x4*)(lng + c), g1 = *(const f32x4*)(lng + c + 4), b0 = *(const f32x4*)(lnb + c), b1 = *(const f32x4*)(lnb + c + 4);
#pragma unroll
                for (int q = 0; q < 4; ++q) { const int row = r0 + rr + q;
                    float x1[8], h2[8];
#pragma unroll
                    for (int j = 0; j < 8; ++j) { x1[j] = v[q][hh * 8 + j] * rstd[q] * (j < 4 ? g0[j] : g1[j - 4]) + (j < 4 ? b0[j] : b1[j - 4]); const float shv = j < 4 ? sh0[j] : sh1[j - 4], scv = j < 4 ? sc0[j] : sc1[j - 4]; h2[j] = x1[j] * (1.f + scv) + shv; }
                    u32x4 w; w.x = pk2(x1[0], x1[1]); w.y = pk2(x1[2], x1[3]); w.z = pk2(x1[4], x1[5]); w.w = pk2(x1[6], x1[7]);
                    *(u32x4*)(X + (size_t)row * 1024 + c) = w;
                    u32x4 hw; hw.x = pk2(h2[0], h2[1]); hw.y = pk2(h2[2], h2[3]); hw.z = pk2(h2[4], h2[5]); hw.w = pk2(h2[6], h2[7]);
                    if (mode & 16) *(LAS u32x4*)(stg + q * WR_STRIDE + c * 2) = hw; else *(u32x4*)(HB + (size_t)row * 1024 + c) = hw;
                    *(u32x2*)(F.ws + WS_HB8 + (size_t)row * 1024 + c) = (u32x2){pk4_fp8(h2[0], h2[1], h2[2], h2[3]), pk4_fp8(h2[4], h2[5], h2[6], h2[7])}; } }
            if (mode & 16) {
                asm volatile("s_waitcnt lgkmcnt(0)" ::: "memory");
                const bool mine = ((lane & 15) >> 2) == (rr >> 2);
                const LAS unsigned char* arow = stg + (lane & 3) * WR_STRIDE + 16 * (lane >> 4);
                const LAS unsigned char* wrow = F.lds + (lane & 15) * WR_STRIDE + 16 * (lane >> 4);
#pragma unroll 2
                for (int ks = 0; ks < 32; ++ks) { bf16x8 av = *(const LAS bf16x8*)(arow + 64 * ks); if (!mine) av = (bf16x8){0, 0, 0, 0, 0, 0, 0, 0};
#pragma unroll
                    for (int nt = 0; nt < 3; ++nt) { const bf16x8 bv = *(const LAS bf16x8*)(wrow + nt * 16 * WR_STRIDE + 64 * ks); lacc[nt] = __builtin_amdgcn_mfma_f32_16x16x32_bf16(av, bv, lacc[nt], 0, 0, 0); } }
            }
        }
        if (mode & 16) {
            asm volatile("s_waitcnt lgkmcnt(0)" ::: "memory");
#pragma unroll
            for (int nt = 0; nt < 3; ++nt)
#pragma unroll
                for (int r = 0; r < 4; ++r) LG[(4 * (lane >> 4) + r) * LG_STRIDE + nt * 16 + (lane & 15)] = lacc[nt][r];
            asm volatile("s_waitcnt lgkmcnt(0)" ::: "memory");
            if (lane < 16) {
                const int row = r0 + lane; float lg[36];
#pragma unroll
                for (int q4 = 0; q4 < 9; ++q4) { const f32x4 t = *(const LAS f32x4*)(LG + lane * LG_STRIDE + 4 * q4); lg[4 * q4] = t.x; lg[4 * q4 + 1] = t.y; lg[4 * q4 + 2] = t.z; lg[4 * q4 + 3] = t.w; }
                float gl[4];
#pragma unroll
                for (int j = 0; j < 4; ++j) gl[j] = lg[j] + a->in[I_MOEBG][l * 4 + j];
                int gi = 0; float gm = gl[0];
#pragma unroll
                for (int j = 1; j < 4; ++j) if (gl[j] > gm) { gm = gl[j]; gi = j; }
                float gs = 0.f;
#pragma unroll
                for (int j = 0; j < 4; ++j) gs += expf(gl[j] - gm);
                const float gprob = 1.0f / gs;
                float el[8];
#pragma unroll
                for (int j = 0; j < 8; ++j) { float t = lg[4 + j] + a->in[I_MOEBE][l * 32 + j];
#pragma unroll
                    for (int gg = 1; gg < 4; ++gg) t = (gi == gg) ? (lg[4 + gg * 8 + j] + a->in[I_MOEBE][l * 32 + gg * 8 + j]) : t;
                    el[j] = t; }
                int i0 = 0; float v0 = el[0];
#pragma unroll
                for (int j = 1; j < 8; ++j) if (el[j] > v0) { v0 = el[j]; i0 = j; }
                int i1 = -1; float v1 = -3.0e38f;
#pragma unroll
                for (int j = 0; j < 8; ++j) if (j != i0 && el[j] > v1) { v1 = el[j]; i1 = j; }
                const float e1 = expf(v1 - v0), w0 = gprob / (1.0f + e1), w1 = gprob * e1 / (1.0f + e1);
                const int ea = gi * 8 + i0, eb = gi * 8 + i1;
                if (!(mode & 4)) {
                const unsigned pa = __hip_atomic_fetch_add(cnt + ea * 64, 1u, __ATOMIC_RELAXED, __HIP_MEMORY_SCOPE_AGENT);
                const unsigned pb = __hip_atomic_fetch_add(cnt + eb * 64, 1u, __ATOMIC_RELAXED, __HIP_MEMORY_SCOPE_AGENT);
                LIST[(size_t)ea * TA + pa] = row * 2; LIST[(size_t)eb * TA + pb] = row * 2 + 1;
                WT[(size_t)ea * TA + pa] = w0; WT[(size_t)eb * TA + pb] = w1;
                *(u32x2*)(F.ws + WS_POS + (size_t)row * 8) = (u32x2){((unsigned)ea << 24) | pa, ((unsigned)eb << 24) | pb};
                } else if (w0 + w1 + (float)(ea + eb) == -12345.0f) WT[row] = w0;
            }
            asm volatile("s_waitcnt lgkmcnt(0)" ::: "memory");
        }
        }
    }
    if (mode & 8) {
    const int ngrp = nrows / 16;
    const LAS unsigned char* wrow = F.lds + (lane & 15) * WR_STRIDE + 16 * (lane >> 4);
    bf16x8 av[32];
    { const bf16_t* hrow = HB + (size_t)((F.gw < ngrp ? F.gw : 0) * 16 + (lane & 15)) * 1024 + 8 * (lane >> 4);
#pragma unroll
      for (int ks = 0; ks < 32; ++ks) av[ks] = *(const bf16x8*)(hrow + 32 * ks); }
    for (int grp = F.gw; grp < ngrp; grp += F.NGW) {
        const int r0 = grp * 16;
        f32x4 lacc[3] = {(f32x4){0.f, 0.f, 0.f, 0.f}, (f32x4){0.f, 0.f, 0.f, 0.f}, (f32x4){0.f, 0.f, 0.f, 0.f}};
#pragma unroll
        for (int ks = 0; ks < 32; ++ks) {
#pragma unroll
            for (int nt = 0; nt < 3; ++nt) { const bf16x8 bv = *(const LAS bf16x8*)(wrow + nt * 16 * WR_STRIDE + 64 * ks); lacc[nt] = __builtin_amdgcn_mfma_f32_16x16x32_bf16(av[ks], bv, lacc[nt], 0, 0, 0); } }
        if (grp + F.NGW < ngrp) { const bf16_t* hrow = HB + (size_t)((grp + F.NGW) * 16 + (lane & 15)) * 1024 + 8 * (lane >> 4);
#pragma unroll
            for (int ks = 0; ks < 32; ++ks) av[ks] = *(const bf16x8*)(hrow + 32 * ks); }
#pragma unroll
        for (int nt = 0; nt < 3; ++nt)
#pragma unroll
            for (int r = 0; r < 4; ++r) LG[(4 * (lane >> 4) + r) * LG_STRIDE + nt * 16 + (lane & 15)] = lacc[nt][r];
        asm volatile("s_waitcnt lgkmcnt(0)" ::: "memory");
        if (lane < 16) {
            const int row = r0 + lane; float lg[36];
#pragma unroll
            for (int q4 = 0; q4 < 9; ++q4) { const f32x4 t = *(const LAS f32x4*)(LG + lane * LG_STRIDE + 4 * q4); lg[4 * q4] = t.x; lg[4 * q4 + 1] = t.y; lg[4 * q4 + 2] = t.z; lg[4 * q4 + 3] = t.w; }
            float gl[4];
#pragma unroll
            for (int j = 0; j < 4; ++j) gl[j] = lg[j] + a->in[I_MOEBG][l * 4 + j];
            int gi = 0; float gm = gl[0];
#pragma unroll
            for (int j = 1; j < 4; ++j) if (gl[j] > gm) { gm = gl[j]; gi = j; }
            float gs = 0.f;
#pragma unroll
            for (int j = 0; j < 4; ++j) gs += expf(gl[j] - gm);
            const float gprob = 1.0f / gs;
            float el[8];
#pragma unroll
            for (int j = 0; j < 8; ++j) { float t = lg[4 + j] + a->in[I_MOEBE][l * 32 + j];
#pragma unroll
                for (int gg = 1; gg < 4; ++gg) t = (gi == gg) ? (lg[4 + gg * 8 + j] + a->in[I_MOEBE][l * 32 + gg * 8 + j]) : t;
                el[j] = t; }
            int i0 = 0; float v0 = el[0];
#pragma unroll
            for (int j = 1; j < 8; ++j) if (el[j] > v0) { v0 = el[j]; i0 = j; }
            int i1 = -1; float v1 = -3.0e38f;
#pragma unroll
            for (int j = 0; j < 8; ++j) if (j != i0 && el[j] > v1) { v1 = el[j]; i1 = j; }
            const float e1 = expf(v1 - v0), w0 = gprob / (1.0f + e1), w1 = gprob * e1 / (1.0f + e1);
            const int ea = gi * 8 + i0, eb = gi * 8 + i1;
            if (!(mode & 4)) {
            const unsigned pa = __hip_atomic_fetch_add(cnt + ea * 64, 1u, __ATOMIC_RELAXED, __HIP_MEMORY_SCOPE_AGENT);
            const unsigned pb = __hip_atomic_fetch_add(cnt + eb * 64, 1u, __ATOMIC_RELAXED, __HIP_MEMORY_SCOPE_AGENT);
            LIST[(size_t)ea * TA + pa] = row * 2; LIST[(size_t)eb * TA + pb] = row * 2 + 1;
            WT[(size_t)ea * TA + pa] = w0; WT[(size_t)eb * TA + pb] = w1;
            *(u32x2*)(F.ws + WS_POS + (size_t)row * 8) = (u32x2){((unsigned)ea << 24) | pa, ((unsigned)eb << 24) | pb};
            } else if (w0 + w1 + (float)(ea + eb) == -12345.0f) WT[row] = w0;
        }
        asm volatile("s_waitcnt lgkmcnt(0)" ::: "memory");
    }
    }
    __syncthreads();
}

__device__ __forceinline__ void moe_tiles(Frame& F, int l) {
    __syncthreads();
    if (F.wave == 0) {
        const int e = F.lane & 31;
        const unsigned c = __hip_atomic_load(F.ctl + CW_CNT + (l * 32 + e) * 64, __ATOMIC_RELAXED, __HIP_MEMORY_SCOPE_AGENT);
        const int t = (int)((c + 255u) >> 8); int incl = t;
#pragma unroll
        for (int o = 1; o < 32; o <<= 1) { const int v = __shfl_up(incl, o, 32); if (e >= o) incl += v; }
        if (F.lane < 32) { F.MISC[32 + e] = (unsigned)(incl - t); F.MISC[72 + e] = c; if (e == 31) F.MISC[64] = (unsigned)incl; }
    }
    __syncthreads();
}
struct SchedMoe {
    int G, c, l, second; volatile LAS unsigned* MISC; const unsigned* cnt; const int* LIST; const char *A, *B;
    __device__ __forceinline__ bool next(int i, pg8::GU& u) const {
        const int L = i * G + c, tile = L >> 2, pn = L & 3; if (tile >= __builtin_amdgcn_readfirstlane((int)MISC[64])) return false;
        const int lj = (int)__builtin_amdgcn_mbcnt_hi(~0u, __builtin_amdgcn_mbcnt_lo(~0u, 0u)) & 31;
        const int e = __builtin_popcountll(__ballot(lj >= 1 && (int)MISC[32 + lj] <= tile) & 0xffffffffull);
        const int tl = tile - __builtin_amdgcn_readfirstlane((int)MISC[32 + e]); const int ce = __builtin_amdgcn_readfirstlane((int)MISC[72 + e]);
        u.gl = LIST + (size_t)e * TA + tl * 256; u.nvalid = ce - tl * 256 < 256 ? ce - tl * 256 : 256; u.e = e; u.pm = tile; u.pn = pn; u.kind = 0;
        if (!second) { u.A = A; u.B = B + (size_t)e * 1024 * 1024 + (size_t)pn * 256 * 1024; u.K = 1024; }
        else { u.A = A + (size_t)tile * 256 * 512; u.B = B + (size_t)e * 1024 * 512 + (size_t)pn * 256 * 512; u.K = 512; }
        return true;
    }
};
struct EpiMoe1 {
    unsigned char* HID; const float* WTS;
    __device__ __forceinline__ void operator()(const f32x4 (&acc)[2][2][4][2], const pg8::GU& u, int wr, int wc, int fr, int fq) const {
        int ln_; asm volatile("v_mbcnt_lo_u32_b32 %0, -1, 0\n\tv_mbcnt_hi_u32_b32 %0, -1, %0" : "=v"(ln_));
        const int rl0 = wr * 64 + (ln_ & 15), row0 = u.pm * 256 + rl0, hc0 = u.pn * 128 + wc * 16 + 4 * (ln_ >> 4);
        const float* wts = WTS + (u.gl - LISTB);
#if MK_DUP == 51
        for (int rep_ = 0; rep_ < 2; ++rep_) { asm volatile("" ::: "memory");
#else
        {
#endif
#pragma unroll
        for (int ai = 0; ai < 2; ++ai)
#pragma unroll
            for (int m = 0; m < 4; ++m) { const int rl = rl0 + ai * 128 + m * 16; const float wsc = wts[rl < u.nvalid ? rl : 0] * ((rl < u.nvalid) ? (H8S * W8R) : 0.f);
#pragma unroll
                for (int bj = 0; bj < 2; ++bj) { const f32x4 gt = acc[ai][bj][m][0] * W8R, up = acc[ai][bj][m][1] * wsc;
                    *(unsigned*)(HID + (size_t)(row0 + ai * 128 + m * 16) * 512 + hc0 + bj * 64) =
                        pk4_fp8(gt[0] * sigmoidf_(gt[0]) * up[0], gt[1] * sigmoidf_(gt[1]) * up[1], gt[2] * sigmoidf_(gt[2]) * up[2], gt[3] * sigmoidf_(gt[3]) * up[3]); } }
        }
    }
    const int* LISTB;
};
struct EpiMoe2 {
    unsigned char* YS;
    __device__ __forceinline__ void operator()(const f32x4 (&acc)[2][2][4][2], const pg8::GU& u, int wr, int wc, int fr, int fq) const {
        int ln_; asm volatile("v_mbcnt_lo_u32_b32 %0, -1, 0\n\tv_mbcnt_hi_u32_b32 %0, -1, %0" : "=v"(ln_));
        const int rb = wr * 64 + (ln_ & 15), cq = wc * 32 + 8 * (ln_ >> 4);
        unsigned char* dst0 = YS + (size_t)(u.pm * 256 + rb) * 1024 + u.pn * 256 + cq;
#if MK_DUP == 50
        for (int rep_ = 0; rep_ < 2; ++rep_) { asm volatile("" ::: "memory");
#else
        {
#endif
#pragma unroll
        for (int ai = 0; ai < 2; ++ai)
#pragma unroll
            for (int m = 0; m < 4; ++m) { const int r = rb + ai * 128 + m * 16;
                if (r < u.nvalid) { unsigned char* dst = dst0 + (size_t)(ai * 128 + m * 16) * 1024;
#pragma unroll
                    for (int bj = 0; bj < 2; ++bj) { const f32x4 v0 = acc[ai][bj][m][0] * W8R, v1 = acc[ai][bj][m][1] * W8R;
                        *(u32x2*)(dst + bj * 128) = (u32x2){pk4_fp8(v0[0], v0[1], v0[2], v0[3]), pk4_fp8(v1[0], v1[1], v1[2], v1[3])}; } } }
        }
    }
};

__device__ __forceinline__ void phase_ln2(Frame& F, ArgsP a, int l, int nrows) {
    const float* mod = (const float*)(F.ws + WS_MOD) + (size_t)l * 33 * 6144; const float* modn = (const float*)(F.ws + WS_MOD) + (size_t)33 * 6144;
    bf16_t* X = (bf16_t*)(F.ws + WS_X); bf16_t* HB = (bf16_t*)(F.ws + WS_HB);
    const unsigned char* YS = F.ws + WS_YS; const unsigned* POS = (const unsigned*)(F.ws + WS_POS);
    moe_tiles(F, l);
#define LN2_YROW(p) ((size_t)((int)F.MISC[32 + ((p) >> 24)] * 256 + (int)((p) & 0xFFFFFFu)) * 1024)
    const int lane = F.lane;
    f32x4 lg[2][2], lb[2][2];
#pragma unroll
    for (int hh = 0; hh < 2; ++hh) { const int c = hh * 512 + 8 * lane;
        lg[hh][0] = *(const f32x4*)(a->in[I_LN2G] + l * 1024 + c); lg[hh][1] = *(const f32x4*)(a->in[I_LN2G] + l * 1024 + c + 4); lb[hh][0] = *(const f32x4*)(a->in[I_LN2B] + l * 1024 + c); lb[hh][1] = *(const f32x4*)(a->in[I_LN2B] + l * 1024 + c + 4); }
    const int step = 2 * F.NGW;
    u32x4 pre[2][2]; u32x2 prey[2][2][2];
#pragma unroll
    for (int q = 0; q < 2; ++q)
#pragma unroll
        for (int hh = 0; hh < 2; ++hh) { const int row = F.gw + q * F.NGW; const size_t o = (size_t)row * 1024 + hh * 512 + 8 * lane; pre[q][hh] = *(const u32x4*)(X + o);
            const u32x2 p = *(const u32x2*)(POS + 2 * row); prey[q][hh][0] = *(const u32x2*)(YS + LN2_YROW(p.x) + hh * 512 + 8 * lane); prey[q][hh][1] = *(const u32x2*)(YS + LN2_YROW(p.y) + hh * 512 + 8 * lane); }
    u32x2 pp[2];
#pragma unroll
    for (int q = 0; q < 2; ++q) { const int row = F.gw + step + q * F.NGW; pp[q] = *(const u32x2*)(POS + 2 * (row < nrows ? row : 0)); }
    for (int row0 = F.gw; row0 < nrows; row0 += step) {
        float v[2][16];
#pragma unroll
        for (int q = 0; q < 2; ++q) { const int row = row0 + q * F.NGW; const float* mrow = mod + (size_t)mod_row(row) * 6144;
#pragma unroll
            for (int hh = 0; hh < 2; ++hh) { const int c = hh * 512 + 8 * lane;
                const u32x4 xw = pre[q][hh]; const u32x2 y0 = prey[q][hh][0], y1 = prey[q][hh][1];
                const f32x4 g0 = *(const f32x4*)(mrow + 5120 + c) * (1.0f / H8S), g1 = *(const f32x4*)(mrow + 5120 + c + 4) * (1.0f / H8S);
                const unsigned xs[4] = {xw.x, xw.y, xw.z, xw.w};
                float ya[8], yb[8], t4[4];
                fp8x4_to_f32(y0.x, t4); ya[0] = t4[0]; ya[1] = t4[1]; ya[2] = t4[2]; ya[3] = t4[3]; fp8x4_to_f32(y0.y, t4); ya[4] = t4[0]; ya[5] = t4[1]; ya[6] = t4[2]; ya[7] = t4[3];
                fp8x4_to_f32(y1.x, t4); yb[0] = t4[0]; yb[1] = t4[1]; yb[2] = t4[2]; yb[3] = t4[3]; fp8x4_to_f32(y1.y, t4); yb[4] = t4[0]; yb[5] = t4[1]; yb[6] = t4[2]; yb[7] = t4[3];
#pragma unroll
                for (int j = 0; j < 4; ++j) { const float ga = j < 2 ? g0[2 * j] : g1[2 * j - 4], gb = j < 2 ? g0[2 * j + 1] : g1[2 * j - 3];
                    v[q][hh * 8 + 2 * j] = DN_ALPHA * bf_lo(xs[j]) + ga * (ya[2 * j] + yb[2 * j]); v[q][hh * 8 + 2 * j + 1] = DN_ALPHA * bf_hi(xs[j]) + gb * (ya[2 * j + 1] + yb[2 * j + 1]); } } }
        if (row0 + step < nrows) {
#pragma unroll
            for (int q = 0; q < 2; ++q)
#pragma unroll
                for (int hh = 0; hh < 2; ++hh) { const size_t o = (size_t)(row0 + step + q * F.NGW) * 1024 + hh * 512 + 8 * lane; pre[q][hh] = *(const u32x4*)(X + o);
                    prey[q][hh][0] = *(const u32x2*)(YS + LN2_YROW(pp[q].x) + hh * 512 + 8 * lane); prey[q][hh][1] = *(const u32x2*)(YS + LN2_YROW(pp[q].y) + hh * 512 + 8 * lane); }
#pragma unroll
            for (int q = 0; q < 2; ++q) { const int row = row0 + 2 * step + q * F.NGW; pp[q] = *(const u32x2*)(POS + 2 * (row < nrows ? row : 0)); } }
        float s[2], mean[2], qq[2], rstd[2];
#pragma unroll
        for (int q = 0; q < 2; ++q) { s[q] = 0.f;
#pragma unroll
            for (int j = 0; j < 16; ++j) s[q] += v[q][j]; }
#pragma unroll
        for (int o = 1; o < 64; o <<= 1)
#pragma unroll
            for (int q = 0; q < 2; ++q) s[q] += __shfl_xor(s[q], o);
#pragma unroll
        for (int q = 0; q < 2; ++q) { mean[q] = s[q] * (1.f / 1024.f); qq[q] = 0.f;
#pragma unroll
            for (int j = 0; j < 16; ++j) { v[q][j] -= mean[q]; qq[q] += v[q][j] * v[q][j]; } }
#pragma unroll
        for (int o = 1; o < 64; o <<= 1)
#pragma unroll
            for (int q = 0; q < 2; ++q) qq[q] += __shfl_xor(qq[q], o);
#pragma unroll
        for (int q = 0; q < 2; ++q) rstd[q] = 1.0f / sqrtf(qq[q] * (1.f / 1024.f) + LN_EPS);
#pragma unroll
        for (int q = 0; q < 2; ++q) { const int row = row0 + q * F.NGW; const float* mn = modn + (size_t)mod_row(row) * 6144;
#pragma unroll
            for (int hh = 0; hh < 2; ++hh) { const int c = hh * 512 + 8 * lane;
                float x2[8];
#pragma unroll
                for (int j = 0; j < 8; ++j) x2[j] = v[q][hh * 8 + j] * rstd[q] * (j < 4 ? lg[hh][0][j] : lg[hh][1][j - 4]) + (j < 4 ? lb[hh][0][j] : lb[hh][1][j - 4]);
                if (l == 0) {
                    u32x4 w; w.x = pk2(x2[0], x2[1]); w.y = pk2(x2[2], x2[3]); w.z = pk2(x2[4], x2[5]); w.w = pk2(x2[6], x2[7]);
                    *(u32x4*)(X + (size_t)row * 1024 + c) = w;
                    const f32x4 sh0 = *(const f32x4*)(mn + c), sh1 = *(const f32x4*)(mn + c + 4), sc0 = *(const f32x4*)(mn + 1024 + c), sc1 = *(const f32x4*)(mn + 1024 + c + 4);
                    float hv[8];
#pragma unroll
                    for (int j = 0; j < 8; ++j) hv[j] = x2[j] * (1.f + (j < 4 ? sc0[j] : sc1[j - 4])) + (j < 4 ? sh0[j] : sh1[j - 4]);
                    u32x4 hw; hw.x = pk2(hv[0], hv[1]); hw.y = pk2(hv[2], hv[3]); hw.z = pk2(hv[4], hv[5]); hw.w = pk2(hv[6], hv[7]);
                    *(u32x4*)(HB + (size_t)row * 1024 + c) = hw;
                } else {
                    float* op = a->out + (size_t)row * 1024 + c;
                    *(f32x4*)op = (f32x4){x2[0], x2[1], x2[2], x2[3]}; *(f32x4*)(op + 4) = (f32x4){x2[4], x2[5], x2[6], x2[7]};
                }
            } }
    }
}

constexpr int NPH_L = 11, NPH = 2 + 2 * NPH_L;
__global__ void __launch_bounds__(NTHREADS, 2) mk_fwd(Args args) {
    extern __shared__ __attribute__((aligned(16))) unsigned char lds_raw[];
    Frame F;
    F.lds = (LAS unsigned char*)lds_raw;
    F.MISC = (volatile LAS unsigned*)(F.lds + MISC_OFF);
    int wave0 = __builtin_amdgcn_readfirstlane((int)threadIdx.x >> 6); asm volatile("" : "+s"(wave0));
#define LANE_ID(dst) asm volatile("v_mbcnt_lo_u32_b32 %0, -1, 0\n\tv_mbcnt_hi_u32_b32 %0, -1, %0" : "=v"(dst))
    F.wave = wave0; LANE_ID(F.lane); F.tid = wave0 * 64 + F.lane;
    F.G = gridDim.x; F.bid = blockIdx.x; F.gw = F.bid * NWAVES + F.wave; F.NGW = F.G * NWAVES;
    const int vcu = (F.G % 8 == 0) ? (F.bid % 8) * (F.G / 8) + F.bid / 8 : F.bid;
    ArgsP ap = (ArgsP)__builtin_amdgcn_kernarg_segment_ptr(); asm volatile("" : "+s"(ap));
    F.ws = ap->ws; F.ctl = (unsigned*)(F.ws + WS_CTL);
    for (int u = F.tid; u < 128; u += NTHREADS) F.MISC[u] = 0u;
    __syncthreads();
#if MK_SPLIT
#define GRID_BAR() do { } while (0)
#else
    XcdBarrier bar = xcd_barrier_post(F.ctl + CW_BAR, F.MISC + 8);
#define GRID_BAR() xcd_barrier(bar)
#endif
    const int lo = ap->ph_lo, hi = ap->ph_hi;
#ifndef MK_ATT_V1
#define MK_ATT_V1 0
#endif
#ifndef MK_PHMASK
#define MK_PHMASK 0xFFFFFF
#endif
#define PHON(p) (((MK_PHMASK) >> (p)) & 1)
#ifndef MK_DUP
#define MK_DUP -1
#endif
#define NDUP(p) ((MK_DUP) == (p) ? 2 : 1)
#define IN(k) (lo <= (k) && (k) < hi)
#define SEAM(k) do { if (IN((k) + 1)) { GRID_BAR(); if (MK_DUP == 40) GRID_BAR(); } { LANE_ID(F.lane); F.tid = wave0 * 64 + F.lane; ap = (ArgsP)__builtin_amdgcn_kernarg_segment_ptr(); asm volatile("" : "+s"(ap)); F.ws = ap->ws; F.ctl = (unsigned*)(F.ws + WS_CTL); ws = F.ws; } } while (0)
    unsigned char* ws = F.ws;

    if (PHON(0) && IN(0)) { for (int dup = 0; dup < NDUP(0); ++dup) p0a_prologue(F, ap); SEAM(0); }
    if (PHON(1) && IN(1)) { p0b_mod(F, ap); SEAM(1); }

    for (int l = 0; l < DEPTH; ++l) {
        const int pb = 2 + l * NPH_L;
        const int nrows = (l == 0) ? TA : TL;
#define wsl ((const char*)(ws + WS_WS + (size_t)l * WSL))
#define modl ((const float*)(ws + WS_MOD) + (size_t)l * 33 * 6144)
        const float lam_init = 0.8f - 0.6f * expf(-0.3f * (float)l);

        if (PHON(2) && IN(pb + 0) && l == 0) { for (int dup = 0; dup < NDUP(2); ++dup) phase_modulate0(F, ap); SEAM(pb + 0); }

        if (PHON(3) && IN(pb + 1)) {
            SchedIn S; S.G = F.G; S.c = F.bid; S.nM = nrows / 256; S.nreg = S.nM * 11; S.nctx = (l == 0) ? 0 : 128; S.A = (const char*)(ws + WS_HB); S.B = wsl;
            EpiIn E{(bf16_t*)(ws + WS_ZG), (bf16_t*)(ws + WS_ZH), (bf16_t*)(ws + WS_Q), (bf16_t*)(ws + WS_K), (bf16_t*)(ws + WS_V), (const float*)(ws + WS_ROPE)};
            for (int dup = 0; dup < NDUP(3); ++dup) pg8::gemm_phase<EpiIn, SchedIn, false>(F.lds, S, E, 2048, 2048, F.wave, F.lane);
            SEAM(pb + 1);
        }

        if (PHON(4) && IN(pb + 2)) {
            for (int dup = 0; dup < NDUP(20); ++dup) for (int u = F.bid; u < nrows / 128; u += F.G) gmlp_unit(F, ap, l, u);
            for (int dup = 0; dup < NDUP(21); ++dup) for (int u = F.bid; u < nrows / 128; u += F.G) sconv_unit(F, ap, l, u);
            if (!MK_ROPE_EPI) for (int u = F.bid; u < TL / 128; u += F.G) rope_unit(F, u);
            SEAM(pb + 2);
        }

        if (PHON(5) && IN(pb + 3)) {
            const float* HF = (const float*)(ws + WS_HF);
#ifndef MK_NOCONV
            for (int dup = 0; dup < NDUP(22); ++dup) for (int c = F.bid; c < 256; c += F.G) {
                conv_unit<8>(F, ap, l, c, HF + (size_t)l * 2048 * 512, (const bf16_t*)(ws + WS_VT) + (size_t)c * TL, (bf16_t*)(ws + WS_YT) + (size_t)c * TL);
                if (l == 0) conv_unit<1>(F, ap, l, c, HF + (size_t)2 * 2048 * 512, (const bf16_t*)(ws + WS_VT) + (size_t)256 * TL + (size_t)c * TC, (bf16_t*)(ws + WS_YT) + (size_t)256 * TL + (size_t)c * TC);
            }
#endif
#ifndef MK_NOATT
            float s1 = 0.f, s2 = 0.f;
            for (int i = 0; i < 64; ++i) { s1 += ap->in[I_LQ1][l * 64 + i] * ap->in[I_LK1][l * 64 + i]; s2 += ap->in[I_LQ2][l * 64 + i] * ap->in[I_LK2][l * 64 + i]; }
            const float lam = expf(s1) - expf(s2) + lam_init;
#if MK_ATT_V1
            for (int u = F.bid; u < 1024; u += F.G) { const int b = u >> 5, rem = u & 31; AttnUnit U; U.qrow0 = b * SEQ + (rem & 7) * 256; U.h = rem >> 3; U.klat0 = b * SEQ; U.nlat = 32; U.kctx0 = TL + b * CTXL; U.nt = 36;
                attn_unit_v1(F, ap, l, U, lam, lam_init); }
            if (l == 0) for (int u = F.bid; u < 128; u += F.G) { const int b = u >> 2; AttnUnit U; U.qrow0 = TL + b * CTXL; U.h = u & 3; U.klat0 = 0; U.nlat = 0; U.kctx0 = TL + b * CTXL; U.nt = 4;
                attn_unit_v1(F, ap, l, U, lam, lam_init); }
#else
#define ATT_LAT(Ux, ux) do { const int b_ = (ux) >> 6, rem_ = (ux) & 63; Ux.qrow0 = b_ * SEQ + (rem_ & 15) * 128; Ux.h = rem_ >> 4; Ux.klat0 = b_ * SEQ; Ux.nlat = 32; Ux.kctx0 = TL + b_ * CTXL; Ux.nt = 36; } while (0)
#define ATT_CTX(Ux, ux) do { const int b_ = (ux) >> 3; Ux.qrow0 = TL + b_ * CTXL + ((ux) & 1) * 128; Ux.h = ((ux) >> 1) & 3; Ux.klat0 = 0; Ux.nlat = 0; Ux.kctx0 = TL + b_ * CTXL; Ux.nt = 4; } while (0)
            for (int dup = 0; dup < NDUP(23); ++dup) for (int u = vcu; u < 2048; u += F.G) { const bool hn = u + F.G < 2048; AttnUnit U, Un; ATT_LAT(U, u); ATT_LAT(Un, hn ? u + F.G : u);
                attn_unit(F, ap, l, U, lam, lam_init, Un, hn, u == vcu); }
            if (l == 0) for (int u = vcu; u < 256; u += F.G) { const bool hn = u + F.G < 256; AttnUnit U, Un; ATT_CTX(U, u); ATT_CTX(Un, hn ? u + F.G : u);
                attn_unit(F, ap, l, U, lam, lam_init, Un, hn, u == vcu); }
#undef ATT_LAT
#undef ATT_CTX
#endif
#endif
            SEAM(pb + 3);
        }

        if (PHON(6) && IN(pb + 4)) { for (int dup = 0; dup < NDUP(6); ++dup) for (int u = F.bid; u < nrows / 128; u += F.G) ytrans_unit(F, u); __syncthreads(); SEAM(pb + 4); }

        if (PHON(7) && IN(pb + 5)) {
            SchedMerge S{F.G, F.bid, nrows / 256, (const char*)(ws + WS_HB), (const char*)(ws + WS_YCAT), wsl, wsl + 12 * MiB};
            EpiMerge E{(bf16_t*)(ws + WS_MERGED), (bf16_t*)(ws + WS_PSCR) + (size_t)F.bid * 65536};
            for (int dup = 0; dup < NDUP(7); ++dup) pg8::gemm_phase<EpiMerge, SchedMerge, false>(F.lds, S, E, 2048, 2048, F.wave, F.lane);
            { const int rem = (nrows / 256 * 4) % F.G;
              if (rem && F.bid >= rem) expert_weights_fp8(F, ap, l, 0, NCONV_E, (F.bid - rem) * NWAVES + F.wave, (F.G - rem) * NWAVES); }
#if MK_DUP == 70
            if (F.tid == 0) F.MISC[111] = (unsigned)__builtin_amdgcn_s_memrealtime();
#endif
            SEAM(pb + 5);
#if MK_DUP == 70
            if (F.tid == 0 && l == 0) F.MISC[110] = (unsigned)__builtin_amdgcn_s_memrealtime() - (unsigned)F.MISC[111];
#endif
        }

        if (PHON(8) && IN(pb + 6)) {
            SchedGrid S{F.G, F.bid, nrows / 256, 4, 1024, (const char*)(ws + WS_MERGED), wsl + 18 * MiB, (size_t)256 * 2048, (size_t)256 * 2048};
            EpiOut E{ap->in[I_X], ap->in[I_CTX], (l == 0) ? nullptr : (const bf16_t*)(ws + WS_X), modl, (bf16_t*)(ws + WS_R1)};
            for (int dup = 0; dup < NDUP(8); ++dup) pg8::gemm_phase<EpiOut, SchedGrid, false>(F.lds, S, E, 2048, 2048, F.wave, F.lane);
            SEAM(pb + 6);
        }

        if (PHON(9) && IN(pb + 7)) { phase_ln1_router(F, ap, l, nrows, 19, ((nrows / 256 * 4) % F.G) ? NCONV_E : 0); SEAM(pb + 7); }

        if (PHON(10) && IN(pb + 8)) {
            moe_tiles(F, l);
            SchedMoe S{F.G, vcu, l, 0, F.MISC, F.ctl + CW_CNT + l * 32 * 64, (const int*)(ws + WS_LIST), (const char*)(ws + WS_HB8), (const char*)(ws + WS_EW1)};
            EpiMoe1 E{ws + WS_HID, (const float*)(ws + WS_WTS), (const int*)(ws + WS_LIST)};
            for (int dup = 0; dup < NDUP(10); ++dup) pg8::gemm_phase<EpiMoe1, SchedMoe, true, true>(F.lds, S, E, 1024, 1024, F.wave, F.lane);
            SEAM(pb + 8);
        }

        if (PHON(11) && IN(pb + 9)) {
            moe_tiles(F, l);
            SchedMoe S{F.G, vcu, l, 1, F.MISC, F.ctl + CW_CNT + l * 32 * 64, (const int*)(ws + WS_LIST), (const char*)(ws + WS_HID), (const char*)(ws + WS_EW2)};
            EpiMoe2 E{ws + WS_YS};
            for (int dup = 0; dup < NDUP(11); ++dup) pg8::gemm_phase<EpiMoe2, SchedMoe, false, true>(F.lds, S, E, 512, 512, F.wave, F.lane);
            SEAM(pb + 9);
        }

        if (PHON(12) && IN(pb + 10)) { phase_ln2(F, ap, l, nrows); if (MK_DUP == 32 && l == 1) phase_ln2(F, ap, l, nrows); SEAM(pb + 10); }
    }
#if MK_DUP == 70
    if (F.tid == 0) __hip_atomic_store(F.ctl + 24000 + F.bid, (unsigned)F.MISC[110], __ATOMIC_RELAXED, __HIP_MEMORY_SCOPE_AGENT);
    GRID_BAR();
    if (F.bid == 0 && F.tid == 0) { F.MISC[110] = __hip_atomic_load(F.ctl + 24000 + MK_PROBE_BLOCK, __ATOMIC_RELAXED, __HIP_MEMORY_SCOPE_AGENT); }
#endif
#if MK_DUP >= 60 && MK_DUP <= 70
    if (F.bid == 0 && F.tid == 0) { const unsigned long long s_ = F.MISC[110]; const unsigned long long t0_ = __builtin_amdgcn_s_memrealtime(); while (__builtin_amdgcn_s_memrealtime() - t0_ < 4ull * s_) { __builtin_amdgcn_s_sleep(8); } }
#endif
#undef wsl
#undef modl
#undef IN
#undef SEAM
#undef GRID_BAR
}

extern "C" void kernel_launch(void* const* d_in, const int* in_sizes, int n_in, void* d_out, int out_size, void* d_ws, size_t ws_size, hipStream_t stream) {
    static int grid = 0;
    if (grid == 0) {
        if (n_in != 40 || out_size != TL * D || ws_size < WS_END) { fprintf(stderr, "kernel_launch: unexpected shapes: n_in %d out %d ws %zu (need %zu)\n", n_in, out_size, ws_size, (size_t)WS_END); grid = -1; return; }
        int dev = 0, cus = 0;
        if (hipGetDevice(&dev) != hipSuccess || hipDeviceGetAttribute(&cus, hipDeviceAttributeMultiprocessorCount, dev) != hipSuccess) { grid = -1; return; }
        if (hipFuncSetAttribute((const void*)mk_fwd, hipFuncAttributeMaxDynamicSharedMemorySize, LDS_BYTES) != hipSuccess) { fprintf(stderr, "kernel_launch: hipFuncSetAttribute failed\n"); grid = -1; return; }
        int per_cu = 0;
        if (hipOccupancyMaxActiveBlocksPerMultiprocessor(&per_cu, (const void*)mk_fwd, NTHREADS, LDS_BYTES) != hipSuccess || per_cu < 1) fprintf(stderr, "kernel_launch: occupancy query reports %d\n", per_cu);
        (void)hipGetLastError();
        grid = cus;
    }
    if (grid < 0) return;
    if (hipMemsetAsync((char*)d_ws + WS_CTL, 0, CTL_ZERO_BYTES, stream) != hipSuccess) return;
    Args a{};
    for (int i = 0; i < 40; ++i) a.in[i] = (const float*)d_in[i];
    a.out = (float*)d_out; a.ws = (unsigned char*)d_ws;
#if MK_SPLIT
    for (int p = 0; p < NPH; ++p) { a.ph_lo = p; a.ph_hi = p + 1; hipLaunchKernelGGL(mk_fwd, dim3(grid), dim3(NTHREADS), LDS_BYTES, stream, a); }
#else
    a.ph_lo = 0; a.ph_hi = NPH;
    hipLaunchKernelGGL(mk_fwd, dim3(grid), dim3(NTHREADS), LDS_BYTES, stream, a);
#endif
}
```
